# Optimizing an MI355X kernel written in HIP

```python
import math
import jax
import jax.numpy as jnp
from jax import lax
import numpy as np

D_MODEL = 1024
BATCH = 16
SEQ = 256
DEPTH = 2
DEC_BATCH = 8
DEC_SEQ = 1024
PAST_LEN = 512

GRID_W = 64
HEAD_DIM = 64
ROPE_BASE = 10000.0
Q_BLOCK = 128
NEG_INF = -1e30
MOD_CHUNKS = 6
GQA_HEADS = 4
GQA_KV_HEADS = 2
GQA_GROUP = GQA_HEADS // GQA_KV_HEADS
NA_HEADS = 4
NA_KH = 8
NA_KW = 16
DN_HEADS = 4
DN_DK = 64
DN_DV = 64
DN_CONV = 4
DN_CHUNK = 64
DN_QKV = DN_HEADS * (2 * DN_DK + DN_DV)
MLA_HEADS = 4
MLA_Q_LORA = 256
MLA_KV_LORA = 128
MLA_NOPE = 64
MLA_ROPE = 32
MLA_V = 64
MLA_SCALE = (MLA_NOPE + MLA_ROPE) ** -0.5

MIX_W = GQA_HEADS * HEAD_DIM + NA_HEADS * HEAD_DIM + DN_HEADS * DN_DV + MLA_HEADS * MLA_V
D_FF = -(-8 * D_MODEL // (3 * 256)) * 256
IN_SIZES = (GQA_HEADS * HEAD_DIM, GQA_KV_HEADS * HEAD_DIM, GQA_KV_HEADS * HEAD_DIM,
            NA_HEADS * HEAD_DIM, NA_HEADS * HEAD_DIM, NA_HEADS * HEAD_DIM,
            DN_QKV, DN_HEADS * DN_DV, 2 * DN_HEADS, 2 * DN_HEADS,
            MLA_Q_LORA, MLA_KV_LORA, MLA_ROPE)
IN_COLS = sum(IN_SIZES)

kernel_name = 'hybrid_flow_prefix_step'


def rms_norm(x, g, eps=1e-6):
    xf = x.astype(jnp.float32)
    y = xf * lax.rsqrt(jnp.mean(xf * xf, axis=-1, keepdims=True) + eps)
    return (y * g.astype(jnp.float32)).astype(x.dtype)


def l2_norm(x, eps=1e-6):
    xf = x.astype(jnp.float32)
    return (xf * lax.rsqrt(jnp.sum(xf * xf, axis=-1, keepdims=True) + eps)).astype(x.dtype)


def rope_axis(x, pos):
    half = x.shape[-1] // 2
    inv = ROPE_BASE ** (-jnp.arange(half, dtype=jnp.float32) / half)
    ang = pos.astype(jnp.float32)[:, None] * inv[None, :]
    cos = jnp.cos(ang)[:, None, :]
    sin = jnp.sin(ang)[:, None, :]
    xf = x.astype(jnp.float32)
    x1, x2 = xf[..., :half], xf[..., half:]
    return jnp.concatenate([x1 * cos - x2 * sin, x2 * cos + x1 * sin], axis=-1).astype(x.dtype)


def rope_2d(x):
    t = jnp.arange(x.shape[1])
    half = x.shape[-1] // 2
    return jnp.concatenate([rope_axis(x[..., :half], t // GRID_W),
                            rope_axis(x[..., half:], t % GRID_W)], axis=-1)


def block_attention(q, k, v, scale):
    b, lq = q.shape[0], q.shape[1]
    nb = lq // Q_BLOCK
    qb = jnp.swapaxes(q.reshape(b, nb, Q_BLOCK, *q.shape[2:]), 0, 1)

    def one_block(qi):
        s = jnp.einsum('bqhgd,bkhd->bhgqk', qi, k, preferred_element_type=jnp.float32) * scale
        pr = jax.nn.softmax(s, axis=-1).astype(v.dtype)
        return jnp.einsum('bhgqk,bkhd->bqhgd', pr, v)

    o = lax.map(one_block, qb)
    return jnp.swapaxes(o, 0, 1).reshape(b, lq, *o.shape[3:])


def natten_latent(q, k, v, k_ctx, v_ctx, bias):
    b, n, h, d = q.shape
    rows = n // GRID_W
    kh = min(NA_KH, rows)
    kw = NA_KW
    r = jnp.arange(rows)
    col = jnp.arange(GRID_W)
    r0 = jnp.clip(r - kh // 2, 0, rows - kh)
    band = r0[:, None] + jnp.arange(kh)[None, :]
    c0 = jnp.clip(col - kw // 2, 0, GRID_W - kw)
    allowed = (col[None, :] >= c0[:, None]) & (col[None, :] < c0[:, None] + kw)
    ri = band - r[:, None] + (NA_KH - 1)
    ci = jnp.clip(col[None, :] - col[:, None] + (kw - 1), 0, 2 * kw - 2)
    rel = bias[:, ri[:, None, :, None], ci[None, :, None, :]].astype(jnp.float32)
    rel = jnp.where(allowed[None, None, :, None, :], rel, NEG_INF)
    rel = rel.transpose(1, 0, 2, 3, 4).reshape(rows, h, GRID_W, kh * GRID_W)
    qg = q.reshape(b, rows, GRID_W, h, d)
    kb = k.reshape(b, rows, GRID_W, h, d)[:, band].reshape(b, rows, kh * GRID_W, h, d)
    vb = v.reshape(b, rows, GRID_W, h, d)[:, band].reshape(b, rows, kh * GRID_W, h, d)
    scale = d ** -0.5
    s_loc = jnp.einsum('brchd,brkhd->brhck', qg, kb, preferred_element_type=jnp.float32) * scale + rel[None]
    s_ctx = jnp.einsum('brchd,blhd->brhcl', qg, k_ctx, preferred_element_type=jnp.float32) * scale
    pr = jax.nn.softmax(jnp.concatenate([s_loc, s_ctx], axis=-1), axis=-1).astype(v.dtype)
    nloc = kh * GRID_W
    o = (jnp.einsum('brhck,brkhd->brchd', pr[..., :nloc], vb)
         + jnp.einsum('brhcl,blhd->brchd', pr[..., nloc:], v_ctx))
    return o.reshape(b, n, h * d)


def short_conv(x, w):
    return lax.conv_general_dilated(
        x, w[:, None, :].astype(x.dtype), window_strides=(1,),
        padding=[((DN_CONV - 1) // 2, DN_CONV // 2)],
        dimension_numbers=('NWC', 'WIO', 'NWC'), feature_group_count=x.shape[-1])


def gated_delta_chunked(q, k, v, beta, logd, s0):
    b, l, h, dk = q.shape
    dv = v.shape[-1]
    c = DN_CHUNK
    n = l // c

    def chunks(t):
        t = t.astype(jnp.float32).reshape(b, n, c, h, *t.shape[3:])
        return jnp.moveaxis(t, (1, 3), (0, 2))

    qc, kc, vc = chunks(q), chunks(k), chunks(v)
    bc, gc = chunks(beta), chunks(logd)
    gcum = jnp.cumsum(gc, axis=-1)
    tril = jnp.tril(jnp.ones((c, c), dtype=bool))
    strict = jnp.tril(jnp.ones((c, c), dtype=bool), -1)
    dmask = jnp.where(tril, jnp.exp(jnp.where(tril, gcum[..., :, None] - gcum[..., None, :], 0.0)), 0.0)
    kb = kc * bc[..., None]
    a = jnp.where(strict, jnp.einsum('nbhid,nbhjd->nbhij', kb, kc) * dmask, 0.0)
    rhs = jnp.concatenate([vc * bc[..., None], kb * jnp.exp(gcum)[..., None]], axis=-1)
    sol = lax.linalg.triangular_solve(a + jnp.eye(c, dtype=jnp.float32), rhs,
                                      left_side=True, lower=True, unit_diagonal=True)
    u, w = sol[..., :dv], sol[..., dv:]
    qk = jnp.where(tril, jnp.einsum('nbhid,nbhjd->nbhij', qc, kc) * dmask, 0.0)
    q_dec = qc * jnp.exp(gcum)[..., None]
    k_dec = kc * jnp.exp(gcum[..., -1:] - gcum)[..., None]
    g_last = jnp.exp(gcum[..., -1])

    def step(s, xs):
        u_i, w_i, qk_i, qd_i, kd_i, gl_i = xs
        v_new = u_i - jnp.einsum('bhcd,bhde->bhce', w_i, s)
        o_i = jnp.einsum('bhcd,bhde->bhce', qd_i, s) + jnp.einsum('bhij,bhje->bhie', qk_i, v_new)
        s = s * gl_i[..., None, None] + jnp.einsum('bhcd,bhce->bhde', kd_i, v_new)
        return s, o_i

    s_fin, o = lax.scan(step, s0.astype(jnp.float32), (u, w, qk, q_dec, k_dec, g_last))
    o = jnp.moveaxis(o, (0, 2), (1, 3)).reshape(b, l, h, dv)
    return o.astype(v.dtype), s_fin.astype(v.dtype)


def flip_seq(t):
    return jnp.flip(t, axis=1)


def deltanet_mixer(zqkv, zg, za, zb, s0, p):
    b, l, _ = zqkv.shape
    qkv = jax.nn.silu(short_conv(zqkv, p['dn_conv_w']))
    q, k, v = jnp.split(qkv, [DN_HEADS * DN_DK, 2 * DN_HEADS * DN_DK], axis=-1)
    q = l2_norm(q.reshape(b, l, DN_HEADS, DN_DK)) * (DN_DK ** -0.5)
    k = l2_norm(k.reshape(b, l, DN_HEADS, DN_DK))
    v = v.reshape(b, l, DN_HEADS, DN_DV)
    a = za.reshape(b, l, 2, DN_HEADS).astype(jnp.float32)
    beta = jax.nn.sigmoid(zb.reshape(b, l, 2, DN_HEADS).astype(jnp.float32))
    logd = -jnp.exp(p['dn_a_log'].astype(jnp.float32)) * jax.nn.softplus(a + p['dn_dt_bias'].astype(jnp.float32))
    o_f, s_f = gated_delta_chunked(q, k, v, beta[:, :, 0], logd[:, :, 0], s0[:, 0])
    o_b, s_b = gated_delta_chunked(flip_seq(q), flip_seq(k), flip_seq(v),
                                   flip_seq(beta[:, :, 1]), flip_seq(logd[:, :, 1]), s0[:, 1])
    o = o_f + flip_seq(o_b)
    o = rms_norm(o, p['dn_out_g']) * jax.nn.silu(zg.reshape(b, l, DN_HEADS, DN_DV))
    return o.reshape(b, l, DN_HEADS * DN_DV), jnp.stack([s_f, s_b], axis=1)


def gqa_qkv(zq, zk, zv, p):
    b, l, _ = zq.shape
    q = rms_norm(zq.reshape(b, l, GQA_HEADS, HEAD_DIM), p['gqa_qn_g'])
    k = rms_norm(zk.reshape(b, l, GQA_KV_HEADS, HEAD_DIM), p['gqa_kn_g'])
    v = zv.reshape(b, l, GQA_KV_HEADS, HEAD_DIM)
    return q, k, v


def gqa_attend(q, k, v):
    b, lq = q.shape[0], q.shape[1]
    qg = q.reshape(b, lq, GQA_KV_HEADS, GQA_GROUP, HEAD_DIM)
    return block_attention(qg, k, v, HEAD_DIM ** -0.5).reshape(b, lq, GQA_HEADS * HEAD_DIM)


def mla_query(zcq, p, positioned):
    b, l, _ = zcq.shape
    q = (rms_norm(zcq, p['mla_qn_g']) @ p['mla_wq_up']).reshape(b, l, MLA_HEADS, MLA_NOPE + MLA_ROPE)
    if positioned:
        q = jnp.concatenate([q[..., :MLA_NOPE], rope_2d(q[..., MLA_NOPE:])], axis=-1)
    return q


def mla_keys_values(ckv, krope, p):
    b, l, _ = ckv.shape
    kv = (ckv @ p['mla_wkv_up']).reshape(b, l, MLA_HEADS, MLA_NOPE + MLA_V)
    k_rope = jnp.broadcast_to(krope[:, :, None, :], (b, l, MLA_HEADS, MLA_ROPE))
    k = jnp.concatenate([kv[..., :MLA_NOPE], k_rope], axis=-1)
    return k, kv[..., MLA_NOPE:]


def project_in(h, p):
    z = jnp.einsum('bld,de->ble', h, p['w_in'])
    offsets = np.cumsum(IN_SIZES)[:-1].tolist()
    return jnp.split(z, offsets, axis=-1)


def mix_context(h, p):
    b, l, _ = h.shape
    (a_q, a_k, a_v, b_q, b_k, b_v, c_qkv, c_g, c_a, c_b, d_cq, d_ckv, d_kr) = project_in(h, p)
    q, k, v = gqa_qkv(a_q, a_k, a_v, p)
    o_a = gqa_attend(q, k, v)
    nq = b_q.reshape(b, l, NA_HEADS, HEAD_DIM)
    nk = b_k.reshape(b, l, NA_HEADS, HEAD_DIM)
    nv = b_v.reshape(b, l, NA_HEADS, HEAD_DIM)
    o_b = block_attention(nq[:, :, :, None], nk, nv, HEAD_DIM ** -0.5).reshape(b, l, NA_HEADS * HEAD_DIM)
    s0 = jnp.zeros((b, 2, DN_HEADS, DN_DK, DN_DV), h.dtype)
    o_c, s_dn = deltanet_mixer(c_qkv, c_g, c_a, c_b, s0, p)
    q_m = mla_query(d_cq, p, False)
    ckv = rms_norm(d_ckv, p['mla_kvn_g'])
    k_m, v_m = mla_keys_values(ckv, d_kr, p)
    o_d = block_attention(q_m[:, :, :, None], k_m, v_m, MLA_SCALE).reshape(b, l, MLA_HEADS * MLA_V)
    out = jnp.concatenate([o_a, o_b, o_c, o_d], axis=-1) @ p['w_out']
    return out, (k, v, nk, nv, s_dn, ckv, d_kr)


def mix_latent(h, ck_a, cv_a, ck_b, cv_b, s_dn, c_ckv, c_kr, p):
    b, n, _ = h.shape
    (a_q, a_k, a_v, b_q, b_k, b_v, c_qkv, c_g, c_a, c_b, d_cq, d_ckv, d_kr) = project_in(h, p)
    q, k, v = gqa_qkv(a_q, a_k, a_v, p)
    o_a = gqa_attend(rope_2d(q), jnp.concatenate([ck_a, rope_2d(k)], axis=1), jnp.concatenate([cv_a, v], axis=1))
    nq = b_q.reshape(b, n, NA_HEADS, HEAD_DIM)
    nk = b_k.reshape(b, n, NA_HEADS, HEAD_DIM)
    nv = b_v.reshape(b, n, NA_HEADS, HEAD_DIM)
    o_b = natten_latent(nq, nk, nv, ck_b, cv_b, p['na_bias'])
    o_c, _ = deltanet_mixer(c_qkv, c_g, c_a, c_b, s_dn, p)
    q_m = mla_query(d_cq, p, True)
    ckv = rms_norm(d_ckv, p['mla_kvn_g'])
    kr = rope_2d(d_kr[:, :, None, :])[:, :, 0, :]
    k_lat, v_lat = mla_keys_values(ckv, kr, p)
    k_ctx, v_ctx = mla_keys_values(c_ckv, c_kr, p)
    o_d = block_attention(q_m[:, :, :, None], jnp.concatenate([k_ctx, k_lat], axis=1),
                          jnp.concatenate([v_ctx, v_lat], axis=1), MLA_SCALE).reshape(b, n, MLA_HEADS * MLA_V)
    return jnp.concatenate([o_a, o_b, o_c, o_d], axis=-1) @ p['w_out']


def modulation(cond, p):
    m = jax.nn.silu(cond) @ p['w_mod'] + p['b_mod']
    return jnp.split(m[:, None, :], MOD_CHUNKS, axis=-1)


def modulated_norm(x, g, shift, scale):
    return rms_norm(x, g) * (1 + scale) + shift


def ffn_sublayer(x, mods, p):
    h = modulated_norm(x, p['norm2_g'], mods[3], mods[4])
    y = (jax.nn.silu(h @ p['ffn_w_gate']) * (h @ p['ffn_w_up'])) @ p['ffn_w_down']
    return x + mods[5] * y


def setup_inputs(seed: int = 0) -> dict:
    key = jax.random.key(seed)
    ks = jax.random.split(key, 32)

    def nrm(i, shape, s=1.0):
        return s * jax.random.normal(ks[i], shape, dtype=jnp.float32)

    def gain(i, shape):
        return 1.0 + 0.05 * jax.random.normal(ks[i], shape, dtype=jnp.float32)

    dt = jnp.exp(jax.random.uniform(ks[20], (DEPTH, 2, DN_HEADS), minval=math.log(1e-3), maxval=math.log(1e-1)))
    return {
        'x_prompt': nrm(0, (BATCH, SEQ, D_MODEL)),
        'x_sample': nrm(1, (DEC_BATCH, DEC_SEQ, D_MODEL)),
        'cache_gqa_k': nrm(2, (DEC_BATCH, DEPTH, PAST_LEN, GQA_KV_HEADS, HEAD_DIM)),
        'cache_gqa_v': nrm(3, (DEC_BATCH, DEPTH, PAST_LEN, GQA_KV_HEADS, HEAD_DIM)),
        'cache_na_k': nrm(4, (DEC_BATCH, DEPTH, PAST_LEN, NA_HEADS, HEAD_DIM)),
        'cache_na_v': nrm(5, (DEC_BATCH, DEPTH, PAST_LEN, NA_HEADS, HEAD_DIM)),
        'state_dn': nrm(6, (DEC_BATCH, DEPTH, 2, DN_HEADS, DN_DK, DN_DV), 0.1),
        'cache_mla_ckv': nrm(7, (DEC_BATCH, DEPTH, PAST_LEN, MLA_KV_LORA)),
        'cache_mla_krope': nrm(8, (DEC_BATCH, DEPTH, PAST_LEN, MLA_ROPE)),
        'c': nrm(9, (DEC_BATCH, D_MODEL)),
        'c_ctx': nrm(10, (D_MODEL,)),
        'norm1_g': gain(11, (DEPTH, D_MODEL)),
        'norm2_g': gain(12, (DEPTH, D_MODEL)),
        'w_mod': nrm(13, (DEPTH, D_MODEL, MOD_CHUNKS * D_MODEL), 0.5 * D_MODEL ** -0.5),
        'b_mod': nrm(14, (DEPTH, MOD_CHUNKS * D_MODEL), 0.01),
        'w_in': nrm(15, (DEPTH, D_MODEL, IN_COLS), D_MODEL ** -0.5),
        'w_out': nrm(16, (DEPTH, MIX_W, D_MODEL), MIX_W ** -0.5),
        'gqa_qn_g': gain(17, (DEPTH, HEAD_DIM)),
        'gqa_kn_g': gain(18, (DEPTH, HEAD_DIM)),
        'na_bias': nrm(19, (DEPTH, NA_HEADS, 2 * NA_KH - 1, 2 * NA_KW - 1), 0.1),
        'dn_conv_w': nrm(21, (DEPTH, DN_CONV, DN_QKV), DN_CONV ** -0.5),
        'dn_a_log': jnp.log(jax.random.uniform(ks[22], (DEPTH, 2, DN_HEADS), minval=1.0, maxval=16.0)),
        'dn_dt_bias': dt + jnp.log(-jnp.expm1(-dt)),
        'dn_out_g': gain(23, (DEPTH, DN_DV)),
        'mla_qn_g': gain(24, (DEPTH, MLA_Q_LORA)),
        'mla_wq_up': nrm(25, (DEPTH, MLA_Q_LORA, MLA_HEADS * (MLA_NOPE + MLA_ROPE)), MLA_Q_LORA ** -0.5),
        'mla_kvn_g': gain(26, (DEPTH, MLA_KV_LORA)),
        'mla_wkv_up': nrm(27, (DEPTH, MLA_KV_LORA, MLA_HEADS * (MLA_NOPE + MLA_V)), MLA_KV_LORA ** -0.5),
        'ffn_w_gate': nrm(28, (DEPTH, D_MODEL, D_FF), D_MODEL ** -0.5),
        'ffn_w_up': nrm(29, (DEPTH, D_MODEL, D_FF), D_MODEL ** -0.5),
        'ffn_w_down': nrm(30, (DEPTH, D_FF, D_MODEL), D_FF ** -0.5),
        'final_g': gain(31, (D_MODEL,)),
    }


def reference(x_prompt, x_sample, cache_gqa_k, cache_gqa_v, cache_na_k, cache_na_v, state_dn,
              cache_mla_ckv, cache_mla_krope, c, c_ctx, norm1_g, norm2_g, w_mod, b_mod, w_in, w_out,
              gqa_qn_g, gqa_kn_g, na_bias, dn_conv_w, dn_a_log, dn_dt_bias, dn_out_g, mla_qn_g,
              mla_wq_up, mla_kvn_g, mla_wkv_up, ffn_w_gate, ffn_w_up, ffn_w_down, final_g):
    stacked = {
        'norm1_g': norm1_g, 'norm2_g': norm2_g, 'w_mod': w_mod, 'b_mod': b_mod, 'w_in': w_in,
        'w_out': w_out, 'gqa_qn_g': gqa_qn_g, 'gqa_kn_g': gqa_kn_g, 'na_bias': na_bias,
        'dn_conv_w': dn_conv_w, 'dn_a_log': dn_a_log, 'dn_dt_bias': dn_dt_bias, 'dn_out_g': dn_out_g,
        'mla_qn_g': mla_qn_g, 'mla_wq_up': mla_wq_up, 'mla_kvn_g': mla_kvn_g, 'mla_wkv_up': mla_wkv_up,
        'ffn_w_gate': ffn_w_gate, 'ffn_w_up': ffn_w_up, 'ffn_w_down': ffn_w_down,
    }

    x = x_prompt
    ctx_cond = c_ctx[None, :]
    per_layer = []
    for l in range(DEPTH):
        p = {name: arr[l] for name, arr in stacked.items()}
        mods = modulation(ctx_cond, p)
        mix, st = mix_context(modulated_norm(x, p['norm1_g'], mods[0], mods[1]), p)
        x = ffn_sublayer(x + mods[2] * mix, mods, p)
        per_layer.append(st)
    y_prompt = rms_norm(x, final_g)
    new_gqa_k = jnp.stack([s[0] for s in per_layer], axis=1)
    new_gqa_v = jnp.stack([s[1] for s in per_layer], axis=1)
    new_na_k = jnp.stack([s[2] for s in per_layer], axis=1)
    new_na_v = jnp.stack([s[3] for s in per_layer], axis=1)
    new_dn_state = jnp.stack([s[4] for s in per_layer], axis=1)
    new_mla_ckv = jnp.stack([s[5] for s in per_layer], axis=1)
    new_mla_krope = jnp.stack([s[6] for s in per_layer], axis=1)

    x = x_sample
    for l in range(DEPTH):
        p = {name: arr[l] for name, arr in stacked.items()}
        mods = modulation(c, p)
        mix = mix_latent(modulated_norm(x, p['norm1_g'], mods[0], mods[1]),
                         cache_gqa_k[:, l], cache_gqa_v[:, l], cache_na_k[:, l], cache_na_v[:, l],
                         state_dn[:, l], cache_mla_ckv[:, l], cache_mla_krope[:, l], p)
        x = ffn_sublayer(x + mods[2] * mix, mods, p)
    y_sample = rms_norm(x, final_g)

    return (y_prompt, y_sample, new_gqa_k, new_gqa_v, new_na_k, new_na_v, new_dn_state, new_mla_ckv, new_mla_krope)
```

```cpp
#include <hip/hip_runtime.h>
#include <cstdio>
#include <cstdint>

#ifndef MK_PER_PHASE
#define MK_PER_PHASE 0
#endif

namespace pg8 {
#define PG8_LAS __attribute__((address_space(3)))
typedef unsigned short bf16_t;
typedef short bf16x8 __attribute__((ext_vector_type(8)));
typedef float f32x4 __attribute__((ext_vector_type(4)));
typedef unsigned u32x4 __attribute__((ext_vector_type(4)));
typedef unsigned u32x2 __attribute__((ext_vector_type(2)));
constexpr int BM = 256, BK = 64, HALF = 128, HTB = HALF * BK * 2, STAGE_BYTES = 8 * HTB, NXCD = 8, WGM = 8;

__host__ __device__ __forceinline__ int lds_byte(int r, int c) { const int st = (r >> 4) * 2 + (c >> 5), rr = r & 15, cc = c & 31, ob = rr * 64 + cc * 2; return st * 1024 + (ob ^ (((ob >> 9) & 1) << 5)); }
__host__ __device__ __forceinline__ void stage_rc(int b, int& R, int& C) { const int st = b / 1024, sb = b % 1024, swz = sb ^ (((sb >> 9) & 1) << 5); R = (st >> 1) * 16 + swz / 64; C = (st & 1) * 32 + (swz % 64) / 2; }
__host__ __device__ __forceinline__ int perm32(int rho) { const int n = rho >> 4, i = rho & 15; return 8 * (i >> 2) + 4 * n + (i & 3); }

struct Unit { int pm, pn; };
struct Gemm { const bf16_t* A; const bf16_t* Bt; int M, N, K; };

struct StaticOrder {
    int nM, nN, nwg, G, c;
    __host__ __device__ void init(int M, int N, int G_, int c_) { nM = M / BM; nN = N / BM; nwg = nM * nN; G = G_; c = c_; }
    __host__ __device__ bool next(int i, Unit& u) const {
        const long L = (long)i * G + c; if (L >= nwg) return false;
        int wgid = (int)L; { const int q = nwg / NXCD, r = nwg % NXCD, xcd = wgid % NXCD, off = wgid / NXCD; wgid = (xcd < r ? xcd * (q + 1) : r * (q + 1) + (xcd - r) * q) + off; }
        const int nig = WGM * nN, gid = wgid / nig, fm = gid * WGM, gsz = (nM - fm) < WGM ? (nM - fm) : WGM;
        u.pm = fm + ((wgid % nig) % gsz); u.pn = (wgid % nig) / gsz; return true;
    }
    __device__ __forceinline__ void a_ready(const Unit&) const {}
    __device__ __forceinline__ void done(const Unit&) const {}
};

__device__ __forceinline__ unsigned cvt_pk_bf16(float lo, float hi) { unsigned r; asm volatile("v_cvt_pk_bf16_f32 %0, %1, %2" : "=v"(r) : "v"(lo), "v"(hi)); return r; }

struct EpiBf16 {
    static constexpr bool PERM = true, AFTER_DRAIN = false;
    bf16_t* O; int ldc;
    __device__ __forceinline__ void operator()(const f32x4 (&acc)[2][2][4][2], const Unit& u, int wr, int wc, int fr, int fq) const {
        const int row0 = u.pm * BM + wr * 64 + fr; const int col0 = u.pn * BM + wc * 32 + 8 * fq;
#pragma unroll
        for (int ai = 0; ai < 2; ++ai)
#pragma unroll
            for (int m = 0; m < 4; ++m) { bf16_t* rowp = O + (size_t)(row0 + ai * HALF + m * 16) * ldc + col0;
#pragma unroll
                for (int bj = 0; bj < 2; ++bj) { const f32x4 v0 = acc[ai][bj][m][0], v1 = acc[ai][bj][m][1];
                    u32x4 w; w.x = cvt_pk_bf16(v0[0], v0[1]); w.y = cvt_pk_bf16(v0[2], v0[3]); w.z = cvt_pk_bf16(v1[0], v1[1]); w.w = cvt_pk_bf16(v1[2], v1[3]);
                    *(u32x4*)(rowp + bj * HALF) = w; } }
    }
};
struct EpiSwiglu {
    static constexpr bool PERM = true, AFTER_DRAIN = false;
    bf16_t* O; int ldc;
    __device__ __forceinline__ static float sw(float g, float u) { return g * u / (1.0f + __expf(-g)); }
    __device__ __forceinline__ void operator()(const f32x4 (&acc)[2][2][4][2], const Unit& u, int wr, int wc, int fr, int fq) const {
        const int row0 = u.pm * BM + wr * 64 + fr; const int col0 = (u.pn * BM + wc * 32 + 8 * fq) >> 1;
#pragma unroll
        for (int ai = 0; ai < 2; ++ai)
#pragma unroll
            for (int m = 0; m < 4; ++m) { bf16_t* rowp = O + (size_t)(row0 + ai * HALF + m * 16) * ldc + col0;
#pragma unroll
                for (int bj = 0; bj < 2; ++bj) { const f32x4 v0 = acc[ai][bj][m][0], v1 = acc[ai][bj][m][1];
                    u32x2 w; w.x = cvt_pk_bf16(sw(v0[0], v0[1]), sw(v0[2], v0[3])); w.y = cvt_pk_bf16(sw(v1[0], v1[1]), sw(v1[2], v1[3]));
                    *(u32x2*)(rowp + bj * (HALF / 2)) = w; } }
    }
};
struct EpiRes {
    static constexpr bool PERM = false, AFTER_DRAIN = false;
    const float* base_a; const float* base_b; float* out; const float* gate;
    __device__ __forceinline__ void operator()(const f32x4 (&acc)[2][2][4][2], const Unit& u, int wr, int wc, int fr, int fq) const {
        const int col0 = u.pn * BM + wc * 32 + 4 * fq;
        const int rmod = u.pm < 16 ? 0 : 1 + ((u.pm - 16) >> 2);
        const float* g = gate + (size_t)rmod * 6144 + col0;
        const float* bp = u.pm < 16 ? base_a + (size_t)u.pm * BM * 1024 : base_b + (size_t)(u.pm - 16) * BM * 1024;
        float* op = out + (size_t)u.pm * BM * 1024;
        f32x4 gv[2][2];
#pragma unroll
        for (int bj = 0; bj < 2; ++bj)
#pragma unroll
            for (int n = 0; n < 2; ++n) gv[bj][n] = *(const f32x4*)(g + bj * HALF + n * 16);
#pragma unroll
        for (int ai = 0; ai < 2; ++ai)
#pragma unroll
            for (int m = 0; m < 4; ++m) { const size_t off = (size_t)(ai * HALF + wr * 64 + m * 16 + fr) * 1024 + col0;
#pragma unroll
                for (int bj = 0; bj < 2; ++bj)
#pragma unroll
                    for (int n = 0; n < 2; ++n) { const f32x4 bs = *(const f32x4*)(bp + off + bj * HALF + n * 16);
                        *(f32x4*)(op + off + bj * HALF + n * 16) = bs + gv[bj][n] * acc[ai][bj][m][n]; } }
    }
};

template <class Epi, class Sched, bool ALIGN_EPI = false, bool SP2 = false>
__device__ __forceinline__ void gemm_phase(PG8_LAS unsigned char* lds, const Gemm g, const Sched& S, const Epi& E, const int tid) {
    const int wid = __builtin_amdgcn_readfirstlane(tid >> 6), lane = tid & 63, wr = wid >> 2, wc = wid & 3, fr = lane & 15, fq = lane >> 4;
    const int K = g.K, nt = K / BK;
    unsigned voffA[2], voffB[2];
#pragma unroll
    for (int i = 0; i < 2; ++i) { int R, C; stage_rc(tid * 16 + i * 8192, R, C); const int Rb = Epi::PERM ? ((R & ~31) + perm32(R & 31)) : R;
        voffA[i] = (unsigned)(R * K + C) * 2u; voffB[i] = (unsigned)(Rb * K + C) * 2u; }
    const size_t kstep = (size_t)(BK * 2);
    const size_t hstep = (size_t)HALF * K * 2;
    const size_t tstep = 2 * hstep;
    const unsigned ldsw = (unsigned)wid * 1024u;
    const int aoff = lds_byte(wr * 64 + fr, fq * 8), boff = lds_byte(wc * 32 + fr, fq * 8);
#define PG8_SA(b, h) (((b) * 2 + (h)) * HTB)
#define PG8_SB(b, h) ((4 + (b) * 2 + (h)) * HTB)
#define PG8_STAGE(bufoff, gbase, voff) do { _Pragma("unroll") for (int _i = 0; _i < 2; ++_i) \
        __builtin_amdgcn_global_load_lds((const unsigned*)((const char*)(gbase) + (voff)[_i]), (PG8_LAS unsigned*)(lds + (bufoff) + ldsw + _i * 8192), 16, 0, 0); } while (0)
#define PG8_LDA(dst, b, h) do { _Pragma("unroll") for (int m = 0; m < 4; ++m) _Pragma("unroll") for (int k = 0; k < 2; ++k) dst[m][k] = *(const PG8_LAS bf16x8*)(lds + PG8_SA(b, h) + aoff + m * 2048 + k * 1024); } while (0)
#define PG8_LDB(dst, b, h) do { _Pragma("unroll") for (int n = 0; n < 2; ++n) _Pragma("unroll") for (int k = 0; k < 2; ++k) dst[n][k] = *(const PG8_LAS bf16x8*)(lds + PG8_SB(b, h) + boff + n * 2048 + k * 1024); } while (0)
#define PG8_MMA(ai, bj, At, Bt) do { __builtin_amdgcn_s_setprio(1); _Pragma("unroll") for (int m = 0; m < 4; ++m) _Pragma("unroll") for (int n = 0; n < 2; ++n) _Pragma("unroll") for (int k = 0; k < 2; ++k) \
        acc[ai][bj][m][n] = __builtin_amdgcn_mfma_f32_16x16x32_bf16(Bt[n][k], At[m][k], acc[ai][bj][m][n], 0, 0, 0); __builtin_amdgcn_s_setprio(0); } while (0)
#define PG8_WAIT_V(n) asm volatile("s_waitcnt vmcnt(" #n ")" ::: "memory")
#define PG8_WAIT_L(n) asm volatile("s_waitcnt lgkmcnt(" #n ")" ::: "memory")
#define PG8_BAR __builtin_amdgcn_s_barrier()
#define PG8_SCHED __builtin_amdgcn_sched_barrier(0)
    Unit cur, nxt; int ui = 0;
    if (!S.next(0, cur)) return;
    f32x4 acc[2][2][4][2];
#pragma unroll
    for (int a = 0; a < 2; ++a)
#pragma unroll
        for (int b = 0; b < 2; ++b)
#pragma unroll
            for (int m = 0; m < 4; ++m)
#pragma unroll
                for (int n = 0; n < 2; ++n) acc[a][b][m][n] = (f32x4){0.f, 0.f, 0.f, 0.f};
    bf16x8 At[4][2], B0[2][2], B1[2][2];
    const char* cA = (const char*)g.A + (size_t)cur.pm * tstep; const char* cB = (const char*)g.Bt + (size_t)cur.pn * tstep;
    S.a_ready(cur);
    if constexpr (SP2) {
        PG8_STAGE(PG8_SB(0, 0), cB, voffB); PG8_STAGE(PG8_SB(0, 1), cB + hstep, voffB); PG8_STAGE(PG8_SA(0, 0), cA, voffA); PG8_STAGE(PG8_SA(0, 1), cA + hstep, voffA);
        if (wr == 1) PG8_BAR;
        PG8_WAIT_V(2); PG8_BAR;
        PG8_STAGE(PG8_SB(1, 0), cB + kstep, voffB); PG8_STAGE(PG8_SA(1, 0), cA + kstep, voffA); PG8_STAGE(PG8_SB(1, 1), cB + hstep + kstep, voffB);
        PG8_WAIT_V(6); PG8_BAR;
    } else {
        PG8_STAGE(PG8_SB(0, 0), cB, voffB); PG8_STAGE(PG8_SA(0, 0), cA, voffA); PG8_STAGE(PG8_SB(0, 1), cB + hstep, voffB); PG8_STAGE(PG8_SA(0, 1), cA + hstep, voffA);
        if (wr == 1) PG8_BAR;
        PG8_WAIT_V(4); PG8_BAR;
        PG8_STAGE(PG8_SB(1, 0), cB + kstep, voffB); PG8_STAGE(PG8_SA(1, 0), cA + kstep, voffA); PG8_STAGE(PG8_SB(1, 1), cB + hstep + kstep, voffB);
        PG8_WAIT_V(6); PG8_BAR;
    }
    for (;;) {
        const bool has_next = S.next(ui + 1, nxt);
        const char* nA = has_next ? (const char*)g.A + (size_t)nxt.pm * tstep : cA; const char* nB = has_next ? (const char*)g.Bt + (size_t)nxt.pn * tstep : cB;
        for (int t = 0; t < nt; t += 2) {
            const bool last = (t == nt - 2);
            const char* a1 = cA + (size_t)(t + 1) * kstep;
            const char* a2 = last ? nA : cA + (size_t)(t + 2) * kstep; const char* b2 = last ? nB : cB + (size_t)(t + 2) * kstep;
            const char* a3 = a2 + kstep; const char* b3 = b2 + kstep;
            if (last && has_next) S.a_ready(nxt);
            if constexpr (SP2) {
            PG8_LDB(B0, 0, 0); PG8_LDB(B1, 0, 1); PG8_SCHED; PG8_LDA(At, 0, 0); PG8_STAGE(PG8_SA(1, 1), a1 + hstep, voffA);
            PG8_WAIT_V(8); PG8_WAIT_L(0); PG8_BAR; PG8_MMA(0, 0, At, B0); PG8_MMA(0, 1, At, B1); PG8_BAR; PG8_SCHED;
            PG8_LDA(At, 0, 1); PG8_STAGE(PG8_SB(0, 0), b2, voffB); PG8_STAGE(PG8_SB(0, 1), b2 + hstep, voffB); PG8_STAGE(PG8_SA(0, 0), a2, voffA);
            PG8_WAIT_V(8); PG8_WAIT_L(0); PG8_BAR; PG8_MMA(1, 0, At, B0); PG8_MMA(1, 1, At, B1); PG8_BAR; PG8_SCHED;
            PG8_LDB(B0, 1, 0); PG8_LDB(B1, 1, 1); PG8_SCHED; PG8_LDA(At, 1, 0); PG8_STAGE(PG8_SA(0, 1), a2 + hstep, voffA);
            PG8_WAIT_V(8); PG8_WAIT_L(0); PG8_BAR; PG8_MMA(0, 0, At, B0); PG8_MMA(0, 1, At, B1); PG8_BAR; PG8_SCHED;
            PG8_LDA(At, 1, 1); PG8_STAGE(PG8_SB(1, 0), b3, voffB); PG8_STAGE(PG8_SB(1, 1), b3 + hstep, voffB); PG8_STAGE(PG8_SA(1, 0), a3, voffA);
            PG8_WAIT_V(8); PG8_WAIT_L(0); PG8_BAR; PG8_MMA(1, 0, At, B0); PG8_MMA(1, 1, At, B1); PG8_BAR; PG8_SCHED;
            } else {
            PG8_LDB(B0, 0, 0); PG8_SCHED; PG8_LDA(At, 0, 0); PG8_STAGE(PG8_SA(1, 1), a1 + hstep, voffA);
            PG8_WAIT_L(8); PG8_BAR; PG8_WAIT_L(0); PG8_MMA(0, 0, At, B0); PG8_BAR; PG8_SCHED;
            PG8_LDB(B1, 0, 1); PG8_STAGE(PG8_SB(0, 0), b2, voffB);
            PG8_BAR; PG8_WAIT_L(0); PG8_MMA(0, 1, At, B1); PG8_BAR;
            PG8_LDA(At, 0, 1); PG8_STAGE(PG8_SA(0, 0), a2, voffA);
            PG8_BAR; PG8_WAIT_L(0); PG8_MMA(1, 0, At, B0); PG8_BAR; PG8_SCHED;
            PG8_STAGE(PG8_SB(0, 1), b2 + hstep, voffB);
            PG8_WAIT_V(6); PG8_BAR; PG8_MMA(1, 1, At, B1); PG8_BAR;
            PG8_LDB(B0, 1, 0); PG8_SCHED; PG8_LDA(At, 1, 0); PG8_STAGE(PG8_SA(0, 1), a2 + hstep, voffA);
            PG8_WAIT_L(8); PG8_BAR; PG8_WAIT_L(0); PG8_MMA(0, 0, At, B0); PG8_BAR; PG8_SCHED;
            PG8_LDB(B1, 1, 1); PG8_STAGE(PG8_SB(1, 0), b3, voffB);
            PG8_BAR; PG8_WAIT_L(0); PG8_MMA(0, 1, At, B1); PG8_BAR;
            PG8_LDA(At, 1, 1); PG8_STAGE(PG8_SA(1, 0), a3, voffA);
            PG8_BAR; PG8_WAIT_L(0); PG8_MMA(1, 0, At, B0); PG8_BAR; PG8_SCHED;
            PG8_STAGE(PG8_SB(1, 1), b3 + hstep, voffB);
            PG8_WAIT_V(6); PG8_BAR; PG8_MMA(1, 1, At, B1); PG8_BAR;
            }
        }
        if constexpr (ALIGN_EPI) { if (wr == 0) PG8_BAR; }
        if constexpr (!Epi::AFTER_DRAIN) { E(acc, cur, wr, wc, fr, fq); S.done(cur); }
        if (!has_next) break;
#pragma unroll
        for (int a = 0; a < 2; ++a)
#pragma unroll
            for (int b = 0; b < 2; ++b)
#pragma unroll
                for (int m = 0; m < 4; ++m)
#pragma unroll
                    for (int n = 0; n < 2; ++n) acc[a][b][m][n] = (f32x4){0.f, 0.f, 0.f, 0.f};
        cur = nxt; cA = nA; cB = nB; ++ui;
        if constexpr (ALIGN_EPI) { if (wr == 1) PG8_BAR; }
    }
    PG8_WAIT_V(0);
    if constexpr (!ALIGN_EPI) { if (wr == 0) PG8_BAR; }
    PG8_BAR;
#undef PG8_SA
#undef PG8_SB
#undef PG8_STAGE
#undef PG8_LDA
#undef PG8_LDB
#undef PG8_MMA
#undef PG8_WAIT_V
#undef PG8_WAIT_L
#undef PG8_BAR
#undef PG8_SCHED
}
}

constexpr int NWAVES = 8, NT = 512;
constexpr int DM = 1024, M_CTX = 4096, M_LAT = 8192, MTOK = 12288, DEPTH = 2;
constexpr int ZP = 2816, FF = 2816, NGU = 5632, IN_COLS = 2736;
constexpr int Z_AQ = 0, Z_AK = 256, Z_AV = 384, Z_BQ = 512, Z_BK = 768, Z_BV = 1024, Z_CQKV = 1280, Z_CG = 2048, Z_CA = 2304, Z_CB = 2312, Z_DCQ = 2320, Z_DCKV = 2576, Z_DKR = 2704;
constexpr int NCACHE = 4096;
constexpr int KVROWS = MTOK + NCACHE;
constexpr float LOG2E = 1.4426950408889634f;
constexpr float MLA_SCALE = 0.10206207261596577f;
enum { I_XP = 0, I_XS, I_CGK, I_CGV, I_CNK, I_CNV, I_SDN, I_CCKV, I_CKR, I_C, I_CCTX, I_N1G, I_N2G, I_WMOD, I_BMOD, I_WIN, I_WOUT, I_QNG, I_KNG, I_NAB,
       I_CONV, I_ALOG, I_DTB, I_DNOG, I_MQNG, I_WQUP, I_MKVNG, I_WKVUP, I_WG, I_WU, I_WD, I_FG, N_IN };
constexpr size_t O_YP = 0, O_YS = 4194304, O_GK = 12582912, O_GV = 13631488, O_NK = 14680064, O_NV = 16777216, O_DS = 18874368, O_CKV = 19922944, O_KR = 20971520, O_END = 21233664;

constexpr size_t MiB = 1u << 20;
constexpr size_t WS_CTL = 0, CTL_ZERO_BYTES = 1 * MiB;
constexpr size_t WS_MODS = 1 * MiB;
constexpr size_t WS_ROPE = 1 * MiB + 512 * 1024;
constexpr size_t WS_W = 2 * MiB, W_LAYER = 25 * MiB;
constexpr size_t W_IN = 0, W_OUT = W_IN + (size_t)ZP * 1024 * 2, W_GU = W_OUT + (size_t)1024 * 1024 * 2, W_D = W_GU + (size_t)NGU * 1024 * 2,
                 W_Q = W_D + (size_t)1024 * FF * 2, W_KV = W_Q + (size_t)512 * 256 * 2, W_LEND = W_KV + (size_t)512 * 256 * 2;
static_assert(W_LEND <= W_LAYER, "weights per layer");
constexpr size_t WS_XN = 52 * MiB;
constexpr size_t WS_Z = 76 * MiB;
constexpr size_t WS_O = 142 * MiB;
constexpr size_t WS_QA = 166 * MiB, WS_KA = 172 * MiB, WS_VA = 176 * MiB;
constexpr size_t WS_DQ = 180 * MiB, WS_DK = 186 * MiB, WS_DV = 192 * MiB;
constexpr size_t WS_BG = 198 * MiB;
constexpr size_t WS_QN = 199 * MiB;
constexpr size_t WS_CKV = 205 * MiB;
constexpr size_t WS_KR = 213 * MiB;
constexpr size_t WS_QM = 214 * MiB;
constexpr size_t WS_KV = 226 * MiB;
constexpr size_t WS_END = 242 * MiB;
constexpr int CW_BAR = 4096;

constexpr int RING_BYTES = 131072, LDSCTL_OFF = RING_BYTES, MISC_OFF = LDSCTL_OFF + 320, LDS_BYTES = 147456;

#define GAS __attribute__((address_space(1)))
#define LAS __attribute__((address_space(3)))
typedef unsigned short bf16;
typedef unsigned v4u __attribute__((ext_vector_type(4)));
typedef unsigned v2u __attribute__((ext_vector_type(2)));
typedef float f32x4 __attribute__((ext_vector_type(4)));
__device__ __forceinline__ unsigned f2bf(float f) { unsigned u = __builtin_bit_cast(unsigned, f); return (u + 0x7fffu + ((u >> 16) & 1u)) >> 16; }
__device__ __forceinline__ unsigned pk2(float lo, float hi) { return f2bf(lo) | (f2bf(hi) << 16); }
__device__ __forceinline__ float bf2f(bf16 h) { return __uint_as_float((unsigned)h << 16); }
__device__ __forceinline__ float bflo(unsigned u) { return __uint_as_float(u << 16); }
__device__ __forceinline__ float bfhi(unsigned u) { return __uint_as_float(u & 0xffff0000u); }
#define LDS_WAIT() asm volatile("s_waitcnt lgkmcnt(0)" ::: "memory")

#define XB_TMO      128
#define XB_XCNT(j)  (256  + 64 * (j))
#define XB_XSUB(j)  (1280 + 64 * (j))
#define XB_XGEN(j)  (2304 + 64 * (j))
#define XB_TOP      3328
#define XB_TOPGEN   3392
#define XCD_BAR_WORDS 3456
#define XB_SPIN_CAP (1u << 18)
__device__ __forceinline__ unsigned xb_ld(unsigned* p)              { return __hip_atomic_load(p, __ATOMIC_RELAXED, __HIP_MEMORY_SCOPE_AGENT); }
__device__ __forceinline__ unsigned xb_add(unsigned* p, unsigned v) { return __hip_atomic_fetch_add(p, v, __ATOMIC_RELAXED, __HIP_MEMORY_SCOPE_AGENT); }
__device__ __forceinline__ unsigned xb_xcc_id() { return (unsigned)__builtin_amdgcn_s_getreg((3 << 11) | 20) & 0xFu; }
#define XB_SPIN(cond, bar) do { unsigned _sp = 0; while (cond) { __builtin_amdgcn_s_sleep(1); \
    if ((++_sp & 255u) == 0u) { if (xb_ld(&(bar)[XB_TMO])) break; if (_sp > XB_SPIN_CAP) { atomicAdd(&(bar)[XB_TMO], 1u); break; } } } } while (0)
struct XcdBarrier { unsigned* bar; unsigned x; volatile LAS unsigned* st; };
__device__ __forceinline__ XcdBarrier xcd_barrier_post(unsigned* bar, volatile LAS unsigned* st) {
    XcdBarrier b; b.bar = bar; b.x = xb_xcc_id(); b.st = st;
    if (threadIdx.x == 0) (void)xb_add(&bar[XB_XCNT(b.x)], 1u);
    return b;
}
__device__ __forceinline__ void xcd_barrier_complete(unsigned* bar, unsigned x, unsigned& nloc, unsigned& nx) {
    const unsigned G = gridDim.x * gridDim.y * gridDim.z;
    unsigned sum, cnt, mine, sp = 0u;
    for (;;) {
        sum = 0u; cnt = 0u; mine = 0u;
#pragma unroll
        for (unsigned j = 0; j < 16; ++j) { const unsigned c = xb_ld(&bar[XB_XCNT(j)]); sum += c; cnt += (c > 0u) ? 1u : 0u; mine = (j == x) ? c : mine; }
        if (sum == G) break;
        __builtin_amdgcn_s_sleep(1);
        if ((++sp & 255u) == 0u) { if (xb_ld(&bar[XB_TMO])) break; if (sp > XB_SPIN_CAP) { atomicAdd(&bar[XB_TMO], 1u); break; } }
    }
    nloc = mine > 0u ? mine : 1u; nx = cnt > 0u ? cnt : 1u;
}
__device__ __forceinline__ void xcd_barrier(const XcdBarrier& b) {
    asm volatile("s_waitcnt vmcnt(0)" ::: "memory");
    __syncthreads();
    if (threadIdx.x == 0) {
        unsigned* bar = b.bar;
        __builtin_amdgcn_s_waitcnt(0);
        unsigned nloc = b.st[0], nx = b.st[1];
        if (nloc == 0u) { xcd_barrier_complete(bar, b.x, nloc, nx); b.st[0] = nloc; b.st[1] = nx; }
        const unsigned old = xb_add(&bar[XB_XSUB(b.x)], 1u);
        const unsigned gen = old / nloc;
        if (old + 1u == (gen + 1u) * nloc) {
            __builtin_amdgcn_fence(__ATOMIC_RELEASE, "agent");
            asm volatile("s_waitcnt vmcnt(0)" ::: "memory");
            const unsigned og = xb_add(&bar[XB_TOP], 1u);
            const unsigned tg = og / nx;
            if (og + 1u == (tg + 1u) * nx) xb_add(&bar[XB_TOPGEN], 1u);
            else XB_SPIN(xb_ld(&bar[XB_TOPGEN]) == tg, bar);
            __builtin_amdgcn_fence(__ATOMIC_ACQUIRE, "agent");
            xb_add(&bar[XB_XGEN(b.x)], 1u);
            asm volatile("s_waitcnt vmcnt(0)" ::: "memory");
        } else {
            XB_SPIN(xb_ld(&bar[XB_XGEN(b.x)]) == gen, bar);
            __builtin_amdgcn_fence(__ATOMIC_ACQUIRE, "agent");
            asm volatile("s_waitcnt vmcnt(0)" ::: "memory");
        }
    }
    __syncthreads();
}

struct Args { const float* in[N_IN]; float* out; unsigned char* ws; int ph_lo, ph_hi; };
struct Frame {
    LAS unsigned char* lds;
    int tid, lane, wave, G, bid;
    const float* const* in; float* out; unsigned char* ws;
};
__device__ __forceinline__ float wave_sum(float v) {
#pragma unroll
    for (int o = 1; o < 64; o <<= 1) v += __shfl_xor(v, o);
    return v;
}
__device__ __forceinline__ float silu_f(float x) { return x / (1.0f + __expf(-x)); }

__device__ __forceinline__ void p0_transpose_item(const float* W, int K, int Nsrc, int Npad, int KP, bf16* WT, int row_off, int rmul, LAS float* scr, int item, int lane) {
    const int nblk = Npad / 32, kb = item / nblk, nb = item % nblk, k0 = 64 * kb, n0 = 32 * nb;
    const int nn = n0 + (lane & 31);
#pragma unroll 8
    for (int i = 0; i < 32; ++i) { const int kk = 2 * i + (lane >> 5); scr[kk * 33 + (lane & 31)] = (nn < Nsrc && (k0 + kk) < K) ? W[(size_t)(k0 + kk) * Nsrc + nn] : 0.f; }
    LDS_WAIT(); asm volatile("" ::: "memory");
    const int c = lane & 7;
#pragma unroll
    for (int j = 0; j < 4; ++j) { const int n = (lane >> 3) + 8 * j; const LAS float* s = scr + (8 * c) * 33 + n;
        v4u o; o.x = pk2(s[0 * 33], s[1 * 33]); o.y = pk2(s[2 * 33], s[3 * 33]); o.z = pk2(s[4 * 33], s[5 * 33]); o.w = pk2(s[6 * 33], s[7 * 33]);
        *(v4u*)(WT + (size_t)(row_off + rmul * (n0 + n)) * KP + k0 + 8 * c) = o; }
    LDS_WAIT(); asm volatile("" ::: "memory");
}
__device__ __forceinline__ void p0a(Frame& F) {
    {
        LAS float* sc = (LAS float*)(F.lds);
        LAS float* part = (LAS float*)(F.lds + 9 * 1024 * 4);
        for (int e = F.tid; e < 9 * 1024; e += NT) { const int r = e >> 10, k = e & 1023; const float c = (r == 0) ? F.in[I_CCTX][k] : F.in[I_C][(r - 1) * 1024 + k]; sc[e] = silu_f(c); }
        __syncthreads();
        for (int it = F.bid; it < 2 * 96; it += F.G) {
            const int l = it / 96, n0 = (it % 96) * 64;
            const float* w = F.in[I_WMOD] + (size_t)l * 1024 * 6144 + n0 + F.lane;
            float acc[9];
#pragma unroll
            for (int r = 0; r < 9; ++r) acc[r] = 0.f;
            const int kb = F.wave * 128;
#pragma unroll 8
            for (int k = 0; k < 128; ++k) { const float wv = w[(size_t)(kb + k) * 6144];
#pragma unroll
                for (int r = 0; r < 9; ++r) acc[r] += sc[r * 1024 + kb + k] * wv; }
#pragma unroll
            for (int r = 0; r < 9; ++r) part[(F.wave * 9 + r) * 64 + F.lane] = acc[r];
            __syncthreads();
            for (int e = F.tid; e < 9 * 64; e += NT) { const int r = e >> 6, c = e & 63; float s = 0.f;
#pragma unroll
                for (int w8 = 0; w8 < 8; ++w8) s += part[(w8 * 9 + r) * 64 + c];
                ((float*)(F.ws + WS_MODS))[(size_t)(l * 9 + r) * 6144 + n0 + c] = s + F.in[I_BMOD][l * 6144 + n0 + c]; }
            __syncthreads();
        }
    }
    if (F.bid == F.G - 1) {
        float* tab = (float*)(F.ws + WS_ROPE);
        for (int e = F.tid; e < 64 * 16 + 64 * 8; e += NT) {
            int pos, i, half; float* dst;
            if (e < 1024) { pos = e >> 4; i = e & 15; half = 16; dst = tab + 2 * e; } else { const int e2 = e - 1024; pos = e2 >> 3; i = e2 & 7; half = 8; dst = tab + 2048 + 2 * e2; }
            const float inv = exp2f(-(float)i / (float)half * 13.287712379549449f);
            const float ang = (float)pos * inv;
            const double twopi = 6.283185307179586476925; const double a = (double)ang; const double kq = __builtin_rint(a / twopi); const float rr = (float)(a - kq * twopi);
            dst[0] = __builtin_cosf(rr); dst[1] = __builtin_sinf(rr);
        }
    }
    __syncthreads();
    {
        LAS float* scr = (LAS float*)(F.lds + F.wave * 16384);
        const int gw = F.bid * NWAVES + F.wave, NGW = F.G * NWAVES;
        constexpr int I_IN = 16 * 88, I_OUT = 16 * 32, I_G = 16 * 88, I_U = 16 * 88, I_D = 44 * 32, I_Q = 4 * 16, I_KV = 4 * 16;
        constexpr int PER_L = I_IN + I_OUT + I_G + I_U + I_D + I_Q + I_KV;
        for (int it = gw; it < 2 * PER_L; it += NGW) {
            const int l = it / PER_L; int r = it % PER_L;
            unsigned char* wl = F.ws + WS_W + (size_t)l * W_LAYER;
            if (r < I_IN) { p0_transpose_item(F.in[I_WIN] + (size_t)l * 1024 * IN_COLS, 1024, IN_COLS, ZP, 1024, (bf16*)(wl + W_IN), 0, 1, scr, r, F.lane); continue; } r -= I_IN;
            if (r < I_OUT) { p0_transpose_item(F.in[I_WOUT] + (size_t)l * 1024 * 1024, 1024, 1024, 1024, 1024, (bf16*)(wl + W_OUT), 0, 1, scr, r, F.lane); continue; } r -= I_OUT;
            if (r < I_G) { p0_transpose_item(F.in[I_WG] + (size_t)l * 1024 * FF, 1024, FF, FF, 1024, (bf16*)(wl + W_GU), 0, 2, scr, r, F.lane); continue; } r -= I_G;
            if (r < I_U) { p0_transpose_item(F.in[I_WU] + (size_t)l * 1024 * FF, 1024, FF, FF, 1024, (bf16*)(wl + W_GU), 1, 2, scr, r, F.lane); continue; } r -= I_U;
            if (r < I_D) { p0_transpose_item(F.in[I_WD] + (size_t)l * FF * 1024, FF, 1024, 1024, FF, (bf16*)(wl + W_D), 0, 1, scr, r, F.lane); continue; } r -= I_D;
            if (r < I_Q) { p0_transpose_item(F.in[I_WQUP] + (size_t)l * 256 * 384, 256, 384, 512, 256, (bf16*)(wl + W_Q), 0, 1, scr, r, F.lane); continue; } r -= I_Q;
            p0_transpose_item(F.in[I_WKVUP] + (size_t)l * 128 * 512, 128, 512, 512, 256, (bf16*)(wl + W_KV), 0, 1, scr, r, F.lane);
        }
    }
}

__device__ __forceinline__ const float* xrow_ptr(Frame& F, int m, bool from_in) {
    if (from_in) return m < M_CTX ? F.in[I_XP] + (size_t)m * DM : F.in[I_XS] + (size_t)(m - M_CTX) * DM;
    return F.out + (size_t)m * DM;
}
template <int MODE> __device__ __forceinline__ void norm_rows(Frame& F, bool from_in, const float* g, const float* mods_l  , int sh_off, int sc_off) {
    const int gw = F.bid * NWAVES + F.wave, NGW = F.G * NWAVES;
    for (int m = gw; m < MTOK; m += NGW) {
        const f32x4* xr = (const f32x4*)xrow_ptr(F, m, from_in) + F.lane;
        f32x4 v[4]; float s = 0.f;
#pragma unroll
        for (int j = 0; j < 4; ++j) { v[j] = xr[64 * j]; s += (v[j].x * v[j].x + v[j].y * v[j].y) + (v[j].z * v[j].z + v[j].w * v[j].w); }
        const float rstd = 1.0f / sqrtf(wave_sum(s) * (1.f / DM) + 1e-6f);
        if (MODE == 0) {
            const int rmod = m < M_CTX ? 0 : 1 + ((m - M_CTX) >> 10);
            const float* mr = mods_l + (size_t)rmod * 6144;
            unsigned long long* o8 = (unsigned long long*)((bf16*)(F.ws + WS_XN) + (size_t)m * DM) + F.lane;
#pragma unroll
            for (int j = 0; j < 4; ++j) { const int c = 4 * F.lane + 256 * j; const f32x4 gg = *(const f32x4*)(g + c), sh = *(const f32x4*)(mr + sh_off + c), sc = *(const f32x4*)(mr + sc_off + c);
                const f32x4 y = (v[j] * rstd * gg) * (sc + 1.0f) + sh;
                o8[64 * j] = (unsigned long long)pk2(y.x, y.y) | ((unsigned long long)pk2(y.z, y.w) << 32); }
        } else {
            f32x4* yo = (f32x4*)(F.out + (size_t)m * DM) + F.lane;
#pragma unroll
            for (int j = 0; j < 4; ++j) { const int c = 4 * F.lane + 256 * j; const f32x4 gg = *(const f32x4*)(g + c); yo[64 * j] = v[j] * rstd * gg; }
        }
    }
}

__device__ __forceinline__ void prep_phase(Frame& F, int l) {
    const int gw = F.bid * NWAVES + F.wave, NGW = F.G * NWAVES, lane = F.lane;
    const bf16* Z = (const bf16*)(F.ws + WS_Z);
    bf16* QA = (bf16*)(F.ws + WS_QA); bf16* KA = (bf16*)(F.ws + WS_KA); bf16* VA = (bf16*)(F.ws + WS_VA);
    bf16* DQ = (bf16*)(F.ws + WS_DQ); bf16* DK = (bf16*)(F.ws + WS_DK); bf16* DV = (bf16*)(F.ws + WS_DV);
    float* BG = (float*)(F.ws + WS_BG);
    bf16* QN = (bf16*)(F.ws + WS_QN); bf16* CKV = (bf16*)(F.ws + WS_CKV); bf16* KR = (bf16*)(F.ws + WS_KR);
    const float* tabA = (const float*)(F.ws + WS_ROPE); const float* tabM = tabA + 2048;
    const float qn_g = F.in[I_QNG][l * 64 + lane], kn_g = F.in[I_KNG][l * 64 + lane];
    for (int it = gw; it < MTOK + NCACHE; it += NGW) {
        if (it >= MTOK) {
            const int cr = it - MTOK, b = cr >> 9, j = cr & 511; const size_t src = (size_t)((b * 2 + l) * 512 + j);
            const int krow = M_CTX + b * 1536 + j;
            const float* gk = F.in[I_CGK] + src * 128; const float* gv = F.in[I_CGV] + src * 128; const float* ck = F.in[I_CCKV] + src * 128; const float* kr = F.in[I_CKR] + src * 32;
            KA[(size_t)krow * 128 + lane] = (bf16)f2bf(gk[lane]); KA[(size_t)krow * 128 + 64 + lane] = (bf16)f2bf(gk[64 + lane]);
            VA[(size_t)krow * 128 + lane] = (bf16)f2bf(gv[lane]); VA[(size_t)krow * 128 + 64 + lane] = (bf16)f2bf(gv[64 + lane]);
            CKV[(size_t)it * 256 + lane] = (bf16)f2bf(ck[lane]); CKV[(size_t)it * 256 + 64 + lane] = (bf16)f2bf(ck[64 + lane]);
            CKV[(size_t)it * 256 + 128 + lane] = 0; CKV[(size_t)it * 256 + 192 + lane] = 0;
            if (lane < 32) KR[(size_t)it * 32 + lane] = (bf16)f2bf(kr[lane]);
            continue;
        }
        const int m = it; const bool lat = m >= M_CTX;
        const int b = lat ? (m - M_CTX) >> 10 : m >> 8, t = lat ? (m - M_CTX) & 1023 : m & 255, L = lat ? 1024 : 256;
        const int pr = t >> 6, pc = t & 63;
        const bf16* zr = Z + (size_t)m * ZP;
        const size_t orow = (size_t)((b * 2 + l) * 256 + t);
        for (int hq = 0; hq < 4; ++hq) {
            const float x = bf2f(zr[Z_AQ + hq * 64 + lane]); const float ss = wave_sum(x * x);
            float y = x * (1.0f / sqrtf(ss * (1.f / 64.f) + 1e-6f)) * qn_g;
            if (lat) { const float yp = __shfl_xor(y, 16); const int pos = lane < 32 ? pr : pc; const float* cs = tabA + (pos * 16 + (lane & 15)) * 2;
                y = (lane & 16) ? y * cs[0] + yp * cs[1] : y * cs[0] - yp * cs[1]; }
            QA[(size_t)m * 256 + hq * 64 + lane] = (bf16)f2bf(y);
        }
        const int krow = lat ? M_CTX + b * 1536 + 512 + t : m;
        for (int kh = 0; kh < 2; ++kh) {
            const float x = bf2f(zr[Z_AK + kh * 64 + lane]); const float ss = wave_sum(x * x);
            float y = x * (1.0f / sqrtf(ss * (1.f / 64.f) + 1e-6f)) * kn_g;
            if (!lat) F.out[O_GK + orow * 128 + kh * 64 + lane] = y;
            if (lat) { const float yp = __shfl_xor(y, 16); const int pos = lane < 32 ? pr : pc; const float* cs = tabA + (pos * 16 + (lane & 15)) * 2;
                y = (lane & 16) ? y * cs[0] + yp * cs[1] : y * cs[0] - yp * cs[1]; }
            KA[(size_t)krow * 128 + kh * 64 + lane] = (bf16)f2bf(y);
            const bf16 vb = zr[Z_AV + kh * 64 + lane];
            VA[(size_t)krow * 128 + kh * 64 + lane] = vb;
            if (!lat) F.out[O_GV + orow * 128 + kh * 64 + lane] = bf2f(vb);
        }
        if (!lat) {
#pragma unroll
            for (int i = 0; i < 4; ++i) { F.out[O_NK + orow * 256 + i * 64 + lane] = bf2f(zr[Z_BK + i * 64 + lane]); F.out[O_NV + orow * 256 + i * 64 + lane] = bf2f(zr[Z_BV + i * 64 + lane]); }
        }
        for (int g = 0; g < 12; ++g) {
            const int ch = g * 64 + lane; float acc = 0.f;
#pragma unroll
            for (int j = 0; j < 4; ++j) { const int tt = t + j - 1; if (tt >= 0 && tt < L) acc += F.in[I_CONV][(size_t)(l * 4 + j) * 768 + ch] * bf2f(zr[(ptrdiff_t)(j - 1) * ZP + Z_CQKV + ch]); }
            float y = silu_f(acc);
            if (g < 8) { const float ss = wave_sum(y * y); y *= 1.0f / sqrtf(ss + 1e-6f); if (g < 4) y *= 0.125f; }
            bf16* dst = g < 4 ? DQ : (g < 8 ? DK : DV);
            dst[(size_t)m * 256 + (ch & 255)] = (bf16)f2bf(y);
        }
        if (lane < 8) {
            const float a = bf2f(zr[Z_CA + lane]), bb = bf2f(zr[Z_CB + lane]);
            const float beta = 1.0f / (1.0f + __expf(-bb));
            const float xx = a + F.in[I_DTB][l * 8 + lane];
            const float sp = fmaxf(xx, 0.f) + log1pf(__expf(-fabsf(xx)));
            BG[(size_t)m * 16 + lane] = beta; BG[(size_t)m * 16 + 8 + lane] = -__expf(F.in[I_ALOG][l * 8 + lane]) * sp;
        }
        {
            float x[4]; float ss = 0.f;
#pragma unroll
            for (int i = 0; i < 4; ++i) { x[i] = bf2f(zr[Z_DCQ + i * 64 + lane]); ss += x[i] * x[i]; }
            const float rstd = 1.0f / sqrtf(wave_sum(ss) * (1.f / 256.f) + 1e-6f);
#pragma unroll
            for (int i = 0; i < 4; ++i) QN[(size_t)m * 256 + i * 64 + lane] = (bf16)f2bf(x[i] * rstd * F.in[I_MQNG][l * 256 + i * 64 + lane]);
            const float c0 = bf2f(zr[Z_DCKV + lane]), c1 = bf2f(zr[Z_DCKV + 64 + lane]);
            const float r2 = 1.0f / sqrtf(wave_sum(c0 * c0 + c1 * c1) * (1.f / 128.f) + 1e-6f);
            const float y0 = c0 * r2 * F.in[I_MKVNG][l * 128 + lane], y1 = c1 * r2 * F.in[I_MKVNG][l * 128 + 64 + lane];
            CKV[(size_t)m * 256 + lane] = (bf16)f2bf(y0); CKV[(size_t)m * 256 + 64 + lane] = (bf16)f2bf(y1); CKV[(size_t)m * 256 + 128 + lane] = 0; CKV[(size_t)m * 256 + 192 + lane] = 0;
            if (!lat) { F.out[O_CKV + orow * 128 + lane] = y0; F.out[O_CKV + orow * 128 + 64 + lane] = y1; }
            const int d = lane & 31; float kr = bf2f(zr[Z_DKR + d]);
            if (!lat) { if (lane < 32) F.out[O_KR + orow * 32 + d] = kr; }
            else { const float kp = __shfl_xor(kr, 8); const int pos = d < 16 ? pr : pc; const float* cs = tabM + (pos * 8 + (d & 7)) * 2;
                kr = (d & 8) ? kr * cs[0] + kp * cs[1] : kr * cs[0] - kp * cs[1]; }
            if (lane < 32) KR[(size_t)m * 32 + d] = (bf16)f2bf(kr);
        }
    }
}

#define ATT_DOT8(s, q, base, w) s += q[base + 0] * bflo(w.x) + q[base + 1] * bfhi(w.x) + q[base + 2] * bflo(w.y) + q[base + 3] * bfhi(w.y) + q[base + 4] * bflo(w.z) + q[base + 5] * bfhi(w.z) + q[base + 6] * bflo(w.w) + q[base + 7] * bfhi(w.w)
#define ATT_ACC8(o, base, corr, p, w) do { o[base + 0] = o[base + 0] * corr + p * bflo(w.x); o[base + 1] = o[base + 1] * corr + p * bfhi(w.x); o[base + 2] = o[base + 2] * corr + p * bflo(w.y); o[base + 3] = o[base + 3] * corr + p * bfhi(w.y); \
    o[base + 4] = o[base + 4] * corr + p * bflo(w.z); o[base + 5] = o[base + 5] * corr + p * bfhi(w.z); o[base + 6] = o[base + 6] * corr + p * bflo(w.w); o[base + 7] = o[base + 7] * corr + p * bfhi(w.w); } while (0)
#define ATT_SOFTMAX_STEP(s) const float mn = fmaxf(mx, s); const float corr = __builtin_amdgcn_exp2f(mx - mn), p = __builtin_amdgcn_exp2f(s - mn); l = l * corr + p; mx = mn
template <bool ROPE> __device__ __forceinline__ void att_seg_bf16(const float (&q)[32], const float (&qr)[16], float (&o)[32], float& mx, float& l,
        const bf16* K, int kst, const bf16* K2, int k2st, const bf16* V, int vst, int nk) {
    for (int j = 0; j < nk; ++j) {
        const v4u* kp = (const v4u*)(K + (size_t)j * kst);
        float s = 0.f;
#pragma unroll
        for (int c = 0; c < 4; ++c) { const v4u w = kp[c]; ATT_DOT8(s, q, 8 * c, w); }
        if constexpr (ROPE) { const v4u* k2 = (const v4u*)(K2 + (size_t)j * k2st);
#pragma unroll
            for (int c = 0; c < 2; ++c) { const v4u w = k2[c]; ATT_DOT8(s, qr, 8 * c, w); } }
        s += __shfl_xor(s, 1);
        ATT_SOFTMAX_STEP(s);
        const v4u* vp = (const v4u*)(V + (size_t)j * vst);
#pragma unroll
        for (int c = 0; c < 4; ++c) { const v4u w = vp[c]; ATT_ACC8(o, 8 * c, corr, p, w); }
    }
}
__device__ __forceinline__ void att_store(bf16* dst, const float (&o)[32], float l) {
    const float rl = 1.0f / l;
#pragma unroll
    for (int c = 0; c < 4; ++c) { v4u w; w.x = pk2(o[8 * c] * rl, o[8 * c + 1] * rl); w.y = pk2(o[8 * c + 2] * rl, o[8 * c + 3] * rl); w.z = pk2(o[8 * c + 4] * rl, o[8 * c + 5] * rl); w.w = pk2(o[8 * c + 6] * rl, o[8 * c + 7] * rl);
        ((v4u*)dst)[c] = w; }
}
template <int NQ> __device__ __forceinline__ void load_q(float (&q)[NQ], const bf16* src, float scale) {
#pragma unroll
    for (int c = 0; c < NQ / 8; ++c) { const v4u w = ((const v4u*)src)[c];
        q[8 * c + 0] = bflo(w.x) * scale; q[8 * c + 1] = bfhi(w.x) * scale; q[8 * c + 2] = bflo(w.y) * scale; q[8 * c + 3] = bfhi(w.y) * scale;
        q[8 * c + 4] = bflo(w.z) * scale; q[8 * c + 5] = bfhi(w.z) * scale; q[8 * c + 6] = bflo(w.w) * scale; q[8 * c + 7] = bfhi(w.w) * scale; }
}
__device__ __forceinline__ void att_task(Frame& F, int ly, int mixer, bool lat, int b, int h, int qi, int hf) {
    const bf16* Z = (const bf16*)(F.ws + WS_Z); bf16* O = (bf16*)(F.ws + WS_O);
    const int row = lat ? M_CTX + b * 1024 + qi : b * 256 + qi;
    float o[32]; float mx = -1e30f, l = 0.f; float q[32], qr[16];
#pragma unroll
    for (int d = 0; d < 32; ++d) o[d] = 0.f;
#pragma unroll
    for (int d = 0; d < 16; ++d) qr[d] = 0.f;
    if (mixer == 0) {
        load_q<32>(q, (const bf16*)(F.ws + WS_QA) + (size_t)row * 256 + h * 64 + hf * 32, 0.125f * LOG2E);
        const bf16* KA = (const bf16*)(F.ws + WS_KA) + (h >> 1) * 64 + hf * 32; const bf16* VA = (const bf16*)(F.ws + WS_VA) + (h >> 1) * 64 + hf * 32;
        if (lat) { const size_t kb = (size_t)(M_CTX + b * 1536) * 128; att_seg_bf16<false>(q, qr, o, mx, l, KA + kb, 128, nullptr, 0, VA + kb, 128, 1536); }
        else { const size_t kb = (size_t)(b * 256) * 128; att_seg_bf16<false>(q, qr, o, mx, l, KA + kb, 128, nullptr, 0, VA + kb, 128, 256); }
        att_store(O + (size_t)row * 1024 + h * 64 + hf * 32, o, l);
    } else if (mixer == 1) {
        load_q<32>(q, Z + (size_t)row * ZP + Z_BQ + h * 64 + hf * 32, 0.125f * LOG2E);
        if (!lat) { const bf16* zb = Z + (size_t)(b * 256) * ZP + h * 64 + hf * 32; att_seg_bf16<false>(q, qr, o, mx, l, zb + Z_BK, ZP, nullptr, 0, zb + Z_BV, ZP, 256); }
        else {
            const float* ckk = F.in[I_CNK] + (size_t)((b * 2 + ly) * 512) * 256 + h * 64 + hf * 32; const float* cvv = F.in[I_CNV] + (size_t)((b * 2 + ly) * 512) * 256 + h * 64 + hf * 32;
            for (int j = 0; j < 512; ++j) {
                const f32x4* kp = (const f32x4*)(ckk + (size_t)j * 256); float s = 0.f;
#pragma unroll
                for (int c = 0; c < 8; ++c) { const f32x4 w = kp[c]; s += q[4 * c] * w.x + q[4 * c + 1] * w.y + q[4 * c + 2] * w.z + q[4 * c + 3] * w.w; }
                s += __shfl_xor(s, 1);
                ATT_SOFTMAX_STEP(s);
                const f32x4* vp = (const f32x4*)(cvv + (size_t)j * 256);
#pragma unroll
                for (int c = 0; c < 8; ++c) { const f32x4 w = vp[c]; o[4 * c] = o[4 * c] * corr + p * w.x; o[4 * c + 1] = o[4 * c + 1] * corr + p * w.y; o[4 * c + 2] = o[4 * c + 2] * corr + p * w.z; o[4 * c + 3] = o[4 * c + 3] * corr + p * w.w; }
            }
            const int r = qi >> 6, c = qi & 63; const int r0 = min(max(r - 4, 0), 8), c0 = min(max(c - 8, 0), 48);
            const float* nb = F.in[I_NAB] + (size_t)((ly * 4 + h) * 15) * 31;
            for (int kr = 0; kr < 8; ++kr) { const int ra = r0 + kr, ri = ra - r + 7;
                for (int kc = 0; kc < 16; ++kc) { const int ca = c0 + kc, ci = ca - c + 15;
                    const bf16* zk = Z + (size_t)(M_CTX + b * 1024 + ra * 64 + ca) * ZP + h * 64 + hf * 32;
                    const v4u* kp = (const v4u*)(zk + Z_BK); float s = 0.f;
#pragma unroll
                    for (int cc = 0; cc < 4; ++cc) { const v4u w = kp[cc]; ATT_DOT8(s, q, 8 * cc, w); }
                    s += __shfl_xor(s, 1);
                    s += nb[ri * 31 + ci] * LOG2E;
                    ATT_SOFTMAX_STEP(s);
                    const v4u* vp = (const v4u*)(zk + Z_BV);
#pragma unroll
                    for (int cc = 0; cc < 4; ++cc) { const v4u w = vp[cc]; ATT_ACC8(o, 8 * cc, corr, p, w); }
                } }
        }
        att_store(O + (size_t)row * 1024 + 256 + h * 64 + hf * 32, o, l);
    } else {
        const bf16* qsrc = (const bf16*)(F.ws + WS_QM) + (size_t)row * 512 + h * 96;
        load_q<32>(q, qsrc + hf * 32, MLA_SCALE * LOG2E); load_q<16>(qr, qsrc + 64 + hf * 16, MLA_SCALE * LOG2E);
        if (lat) { const float* tabM = (const float*)(F.ws + WS_ROPE) + 2048; const int pos = hf ? (qi & 63) : (qi >> 6);
#pragma unroll
            for (int i = 0; i < 8; ++i) { const float c1 = tabM[(pos * 8 + i) * 2], s1 = tabM[(pos * 8 + i) * 2 + 1]; const float a1 = qr[i], b1 = qr[8 + i];
                qr[i] = a1 * c1 - b1 * s1; qr[8 + i] = b1 * c1 + a1 * s1; } }
        const bf16* KV = (const bf16*)(F.ws + WS_KV) + h * 128 + hf * 32; const bf16* KR = (const bf16*)(F.ws + WS_KR) + hf * 16;
        if (lat) { const size_t r1 = (size_t)(MTOK + b * 512), r2 = (size_t)(M_CTX + b * 1024);
            att_seg_bf16<true>(q, qr, o, mx, l, KV + r1 * 512, 512, KR + r1 * 32, 32, KV + r1 * 512 + 64, 512, 512);
            att_seg_bf16<true>(q, qr, o, mx, l, KV + r2 * 512, 512, KR + r2 * 32, 32, KV + r2 * 512 + 64, 512, 1024); }
        else { const size_t r1 = (size_t)(b * 256); att_seg_bf16<true>(q, qr, o, mx, l, KV + r1 * 512, 512, KR + r1 * 32, 32, KV + r1 * 512 + 64, 512, 256); }
        att_store(O + (size_t)row * 1024 + 768 + h * 64 + hf * 32, o, l);
    }
}

__device__ __forceinline__ void dn_task(Frame& F, int l, int seq) {
    const bool lat = seq < 64; const int s2 = lat ? seq : seq - 64;
    const int b = s2 >> 3, h = (s2 >> 1) & 3, dir = s2 & 1, L = lat ? 1024 : 256, row0 = lat ? M_CTX + b * 1024 : b * 256;
    LAS float* qs = (LAS float*)F.lds; LAS float* ks = qs + 4096; LAS float* vs = ks + 4096; LAS float* gs = vs + 4096; LAS float* bs = gs + 64; LAS float* red1 = bs + 64; LAS float* red2 = red1 + 512;
    const bf16* DQ = (const bf16*)(F.ws + WS_DQ); const bf16* DK = (const bf16*)(F.ws + WS_DK); const bf16* DV = (const bf16*)(F.ws + WS_DV); const float* BG = (const float*)(F.ws + WS_BG);
    float* ODN = (float*)(F.ws + WS_XN) + (size_t)dir * MTOK * 256;
    const int w = F.wave, lane = F.lane;
    float s[8];
#pragma unroll
    for (int i = 0; i < 8; ++i) s[i] = lat ? F.in[I_SDN][((size_t)(((b * 2 + l) * 2 + dir) * 4 + h) * 64 + (8 * w + i)) * 64 + lane] : 0.f;
    for (int c = 0; c < L / 64; ++c) {
        __syncthreads();
        for (int e = F.tid; e < 4096; e += NT) { const int st = e >> 6, d = e & 63; const int step = c * 64 + st, t = dir ? L - 1 - step : step; const size_t r = (size_t)(row0 + t) * 256 + h * 64 + d;
            qs[e] = bf2f(DQ[r]); ks[e] = bf2f(DK[r]); vs[e] = bf2f(DV[r]); }
        if (F.tid < 64) { const int step = c * 64 + F.tid, t = dir ? L - 1 - step : step; const size_t r = (size_t)(row0 + t) * 16;
            bs[F.tid] = BG[r + dir * 4 + h]; gs[F.tid] = __expf(BG[r + 8 + dir * 4 + h]); }
        __syncthreads();
        for (int st = 0; st < 64; ++st) {
            const float a = gs[st], beta = bs[st], vv = vs[st * 64 + lane];
            float kk[8], qq[8];
#pragma unroll
            for (int i = 0; i < 8; ++i) { kk[i] = ks[st * 64 + 8 * w + i]; qq[i] = qs[st * 64 + 8 * w + i]; }
            float part = 0.f;
#pragma unroll
            for (int i = 0; i < 8; ++i) { s[i] *= a; part += s[i] * kk[i]; }
            red1[w * 64 + lane] = part;
            __syncthreads();
            float pred = 0.f;
#pragma unroll
            for (int i = 0; i < 8; ++i) pred += red1[i * 64 + lane];
            const float vn = beta * (vv - pred);
            float po = 0.f;
#pragma unroll
            for (int i = 0; i < 8; ++i) { s[i] += kk[i] * vn; po += s[i] * qq[i]; }
            red2[w * 64 + lane] = po;
            __syncthreads();
            if (w == 0) { float ov = 0.f;
#pragma unroll
                for (int i = 0; i < 8; ++i) ov += red2[i * 64 + lane];
                const int step = c * 64 + st, t = dir ? L - 1 - step : step;
                ODN[(size_t)(row0 + t) * 256 + h * 64 + lane] = ov; }
        }
    }
    if (!lat) {
#pragma unroll
        for (int i = 0; i < 8; ++i) F.out[O_DS + ((size_t)(((b * 2 + l) * 2 + dir) * 4 + h) * 64 + (8 * w + i)) * 64 + lane] = s[i];
    }
    __syncthreads();
}

__device__ __forceinline__ void mixer_phase(Frame& F, int l) {
    for (int task = F.bid; task < 768; task += F.G) {
        int mixer = 0, b = 0, h = 0, qi = 0, seq = -1; bool lat = true;
        const int q2 = F.tid >> 1;
        if (task < 128) { mixer = 2; b = task >> 4; h = (task >> 2) & 3; qi = (task & 3) * 256 + q2; }
        else if (task < 256) { const int t = task - 128; mixer = 0; b = t >> 4; h = (t >> 2) & 3; qi = (t & 3) * 256 + q2; }
        else if (task < 320) { seq = task - 256; }
        else if (task < 448) { const int t = task - 320; mixer = 1; b = t >> 4; h = (t >> 2) & 3; qi = (t & 3) * 256 + q2; }
        else if (task < 576) { seq = 64 + task - 448; }
        else { const int t = (task - 576) & 63; mixer = (task - 576) >> 6; lat = false; b = t >> 2; h = t & 3; qi = q2; }
        if (seq >= 0) dn_task(F, l, seq); else att_task(F, l, mixer, lat, b, h, qi, F.tid & 1);
    }
}

__device__ __forceinline__ void dn_combine(Frame& F, int l) {
    const int gw = F.bid * NWAVES + F.wave, NGW = F.G * NWAVES, lane = F.lane;
    const bf16* Z = (const bf16*)(F.ws + WS_Z); bf16* O = (bf16*)(F.ws + WS_O);
    const float* O0 = (const float*)(F.ws + WS_XN); const float* O1 = O0 + (size_t)MTOK * 256;
    const float g = F.in[I_DNOG][l * 64 + lane];
    for (int m = gw; m < MTOK; m += NGW) {
#pragma unroll
        for (int h = 0; h < 4; ++h) {
            const float v = O0[(size_t)m * 256 + h * 64 + lane] + O1[(size_t)m * 256 + h * 64 + lane];
            const float ss = wave_sum(v * v);
            const float y = v * (1.0f / sqrtf(ss * (1.f / 64.f) + 1e-6f)) * g * silu_f(bf2f(Z[(size_t)m * ZP + Z_CG + h * 64 + lane]));
            O[(size_t)m * 1024 + 512 + h * 64 + lane] = (bf16)f2bf(y);
        }
    }
}

constexpr int N_PHASES = 2 + 10 * DEPTH;
__global__ void __launch_bounds__(NT, 2) hybrid_fwd(Args args) {
    extern __shared__ __attribute__((aligned(16))) unsigned char lds_raw[];
    Frame F;
    F.lds = (LAS unsigned char*)lds_raw;
    F.tid = threadIdx.x; F.lane = F.tid & 63; F.wave = __builtin_amdgcn_readfirstlane(F.tid >> 6);
    F.G = gridDim.x; F.bid = blockIdx.x;
    F.in = args.in; F.out = args.out; F.ws = args.ws;
    volatile LAS unsigned* MISC = (volatile LAS unsigned*)(F.lds + MISC_OFF);
    for (int u = F.tid; u < (LDS_BYTES - LDSCTL_OFF) / 4; u += NT) ((LAS unsigned*)(F.lds + LDSCTL_OFF))[u] = 0u;
    __syncthreads();
    XcdBarrier bar; bar.bar = (unsigned*)(F.ws + WS_CTL) + CW_BAR; bar.x = 0; bar.st = nullptr;
#if !MK_PER_PHASE
    bar = xcd_barrier_post((unsigned*)(F.ws + WS_CTL) + CW_BAR, MISC + 8);
#endif
    for (int ph = args.ph_lo; ph < args.ph_hi; ++ph) {
        {
            int tid_ = threadIdx.x, bid_ = blockIdx.x; unsigned char* ws_ = args.ws; float* out_ = args.out;
            asm volatile("" : "+v"(tid_)); asm volatile("" : "+s"(bid_)); asm volatile("" : "+s"(ws_)); asm volatile("" : "+s"(out_));
            F.tid = tid_; F.lane = tid_ & 63; F.wave = __builtin_amdgcn_readfirstlane(tid_ >> 6); F.bid = bid_; F.ws = ws_; F.out = out_;
        }
        const float* mods = (const float*)(F.ws + WS_MODS);
        if (ph == 0) p0a(F);
        else if (ph == 1) norm_rows<0>(F, true, F.in[I_N1G], mods, 0, 1024);
        else {
            const int l = (ph - 2) / 10, sp = (ph - 2) % 10;
            unsigned char* wl = F.ws + WS_W + (size_t)l * W_LAYER;
            const float* mods_l = mods + (size_t)l * 9 * 6144;
            if (sp == 0) {
                pg8::Gemm g{(const bf16*)(F.ws + WS_XN), (const bf16*)(wl + W_IN), MTOK, ZP, 1024}; pg8::StaticOrder S; S.init(MTOK, ZP, F.G, F.bid);
                pg8::EpiBf16 E{(bf16*)(F.ws + WS_Z), ZP};
                pg8::gemm_phase<pg8::EpiBf16, pg8::StaticOrder, true, true>(F.lds, g, S, E, F.tid);
            } else if (sp == 1) prep_phase(F, l);
            else if (sp == 2) {
                { pg8::Gemm g{(const bf16*)(F.ws + WS_QN), (const bf16*)(wl + W_Q), MTOK, 512, 256}; pg8::StaticOrder S; S.init(MTOK, 512, F.G, F.bid);
                  pg8::EpiBf16 E{(bf16*)(F.ws + WS_QM), 512};
                  pg8::gemm_phase<pg8::EpiBf16, pg8::StaticOrder, true, true>(F.lds, g, S, E, F.tid); }
                { pg8::Gemm g{(const bf16*)(F.ws + WS_CKV), (const bf16*)(wl + W_KV), KVROWS, 512, 256}; pg8::StaticOrder S; S.init(KVROWS, 512, F.G, (F.bid + F.G - 96) % F.G);
                  pg8::EpiBf16 E{(bf16*)(F.ws + WS_KV), 512};
                  pg8::gemm_phase<pg8::EpiBf16, pg8::StaticOrder, true, true>(F.lds, g, S, E, F.tid); }
            } else if (sp == 3) mixer_phase(F, l);
            else if (sp == 4) dn_combine(F, l);
            else if (sp == 5) {
                pg8::Gemm g{(const bf16*)(F.ws + WS_O), (const bf16*)(wl + W_OUT), MTOK, 1024, 1024}; pg8::StaticOrder S; S.init(MTOK, 1024, F.G, F.bid);
                pg8::EpiRes E{l == 0 ? F.in[I_XP] : F.out, l == 0 ? F.in[I_XS] : F.out + (size_t)M_CTX * DM, F.out, mods_l + 2 * 1024};
                pg8::gemm_phase<pg8::EpiRes, pg8::StaticOrder, true, true>(F.lds, g, S, E, F.tid);
            } else if (sp == 6) norm_rows<0>(F, false, F.in[I_N2G] + l * 1024, mods_l, 3 * 1024, 4 * 1024);
            else if (sp == 7) {
                pg8::Gemm g{(const bf16*)(F.ws + WS_XN), (const bf16*)(wl + W_GU), MTOK, NGU, 1024}; pg8::StaticOrder S; S.init(MTOK, NGU, F.G, F.bid);
                pg8::EpiSwiglu E{(bf16*)(F.ws + WS_Z), FF};
                pg8::gemm_phase<pg8::EpiSwiglu, pg8::StaticOrder, true, true>(F.lds, g, S, E, F.tid);
            } else if (sp == 8) {
                pg8::Gemm g{(const bf16*)(F.ws + WS_Z), (const bf16*)(wl + W_D), MTOK, 1024, FF}; pg8::StaticOrder S; S.init(MTOK, 1024, F.G, F.bid);
                pg8::EpiRes E{F.out, F.out + (size_t)M_CTX * DM, F.out, mods_l + 5 * 1024};
                pg8::gemm_phase<pg8::EpiRes, pg8::StaticOrder, true, true>(F.lds, g, S, E, F.tid);
            } else {
                if (l + 1 < DEPTH) norm_rows<0>(F, false, F.in[I_N1G] + (l + 1) * 1024, mods_l + 9 * 6144, 0, 1024);
                else norm_rows<1>(F, false, F.in[I_FG], nullptr, 0, 0);
            }
        }
#if !MK_PER_PHASE
        if (ph + 1 < args.ph_hi) xcd_barrier(bar);
#endif
    }
}

extern "C" void kernel_launch(void* const* d_in, const int* in_sizes, int n_in, void* d_out, int out_size, void* d_ws, size_t ws_size, hipStream_t stream) {
    static int grid = 0;
    if (grid == 0) {
        if (n_in != N_IN || out_size != (int)O_END || ws_size < WS_END) { fprintf(stderr, "kernel_launch: unexpected shapes: n_in %d out %d ws %zu\n", n_in, out_size, ws_size); grid = -1; return; }
        int dev = 0, cus = 0, per_cu = 0;
        if (hipGetDevice(&dev) != hipSuccess || hipDeviceGetAttribute(&cus, hipDeviceAttributeMultiprocessorCount, dev) != hipSuccess) { grid = -1; return; }
        if (hipFuncSetAttribute((const void*)hybrid_fwd, hipFuncAttributeMaxDynamicSharedMemorySize, LDS_BYTES) != hipSuccess) { fprintf(stderr, "kernel_launch: hipFuncSetAttribute failed\n"); grid = -1; return; }
        if (hipOccupancyMaxActiveBlocksPerMultiprocessor(&per_cu, (const void*)hybrid_fwd, NT, LDS_BYTES) != hipSuccess || per_cu < 1) { fprintf(stderr, "kernel_launch: occupancy query says %d\n", per_cu); }
        (void)hipGetLastError();
        grid = cus;
    }
    if (grid < 0) return;
    (void)hipMemsetAsync((char*)d_ws + WS_CTL, 0, CTL_ZERO_BYTES, stream);
    Args a{};
    for (int i = 0; i < N_IN; ++i) a.in[i] = (const float*)d_in[i];
    a.out = (float*)d_out; a.ws = (unsigned char*)d_ws;
#if MK_PER_PHASE
    for (int ph = 0; ph < N_PHASES; ++ph) { a.ph_lo = ph; a.ph_hi = ph + 1; hipLaunchKernelGGL(hybrid_fwd, dim3(grid), dim3(NT), LDS_BYTES, stream, a); }
#else
    a.ph_lo = 0; a.ph_hi = N_PHASES;
    void* kargs[] = {&a};
    hipError_t e = hipLaunchCooperativeKernel((const void*)hybrid_fwd, dim3(grid), dim3(NT), kargs, LDS_BYTES, stream);
    if (e != hipSuccess) fprintf(stderr, "kernel_launch: cooperative launch failed: %s (grid %d)\n", hipGetErrorString(e), grid);
#endif
}
```

```cpp
#include <hip/hip_runtime.h>
#include <cstdio>
#include <cstdint>

#ifndef MK_PER_PHASE
#define MK_PER_PHASE 0
#endif

namespace pg8 {
#define PG8_LAS __attribute__((address_space(3)))
typedef unsigned short bf16_t;
typedef short bf16x8 __attribute__((ext_vector_type(8)));
typedef float f32x4 __attribute__((ext_vector_type(4)));
typedef unsigned u32x4 __attribute__((ext_vector_type(4)));
typedef unsigned u32x2 __attribute__((ext_vector_type(2)));
constexpr int BM = 256, BK = 64, HALF = 128, HTB = HALF * BK * 2, STAGE_BYTES = 8 * HTB, NXCD = 8, WGM = 8;

__host__ __device__ __forceinline__ int lds_byte(int r, int c) { const int st = (r >> 4) * 2 + (c >> 5), rr = r & 15, cc = c & 31, ob = rr * 64 + cc * 2; return st * 1024 + (ob ^ (((ob >> 9) & 1) << 5)); }
__host__ __device__ __forceinline__ void stage_rc(int b, int& R, int& C) { const int st = b / 1024, sb = b % 1024, swz = sb ^ (((sb >> 9) & 1) << 5); R = (st >> 1) * 16 + swz / 64; C = (st & 1) * 32 + (swz % 64) / 2; }
__host__ __device__ __forceinline__ int perm32(int rho) { const int n = rho >> 4, i = rho & 15; return 8 * (i >> 2) + 4 * n + (i & 3); }

struct Unit { int pm, pn; };
struct Gemm { const bf16_t* A; const bf16_t* Bt; int M, N, K; };

struct StaticOrder {
    int nM, nN, nwg, G, c;
    __host__ __device__ void init(int M, int N, int G_, int c_) { nM = M / BM; nN = N / BM; nwg = nM * nN; G = G_; c = c_; }
    __host__ __device__ bool next(int i, Unit& u) const {
        const long L = (long)i * G + c; if (L >= nwg) return false;
        int wgid = (int)L; { const int q = nwg / NXCD, r = nwg % NXCD, xcd = wgid % NXCD, off = wgid / NXCD; wgid = (xcd < r ? xcd * (q + 1) : r * (q + 1) + (xcd - r) * q) + off; }
        const int nig = WGM * nN, gid = wgid / nig, fm = gid * WGM, gsz = (nM - fm) < WGM ? (nM - fm) : WGM;
        u.pm = fm + ((wgid % nig) % gsz); u.pn = (wgid % nig) / gsz; return true;
    }
    __device__ __forceinline__ void a_ready(const Unit&) const {}
    __device__ __forceinline__ void done(const Unit&) const {}
};

__device__ __forceinline__ unsigned cvt_pk_bf16(float lo, float hi) { unsigned r; asm volatile("v_cvt_pk_bf16_f32 %0, %1, %2" : "=v"(r) : "v"(lo), "v"(hi)); return r; }

struct EpiBf16 {
    static constexpr bool PERM = true, AFTER_DRAIN = false;
    bf16_t* O; int ldc;
    __device__ __forceinline__ void operator()(const f32x4 (&acc)[2][2][4][2], const Unit& u, int wr, int wc, int fr, int fq) const {
        const int row0 = u.pm * BM + wr * 64 + fr; const int col0 = u.pn * BM + wc * 32 + 8 * fq;
#pragma unroll
        for (int ai = 0; ai < 2; ++ai)
#pragma unroll
            for (int m = 0; m < 4; ++m) { bf16_t* rowp = O + (size_t)(row0 + ai * HALF + m * 16) * ldc + col0;
#pragma unroll
                for (int bj = 0; bj < 2; ++bj) { const f32x4 v0 = acc[ai][bj][m][0], v1 = acc[ai][bj][m][1];
                    u32x4 w; w.x = cvt_pk_bf16(v0[0], v0[1]); w.y = cvt_pk_bf16(v0[2], v0[3]); w.z = cvt_pk_bf16(v1[0], v1[1]); w.w = cvt_pk_bf16(v1[2], v1[3]);
                    *(u32x4*)(rowp + bj * HALF) = w; } }
    }
};
struct EpiSwiglu {
    static constexpr bool PERM = true, AFTER_DRAIN = false;
    bf16_t* O; int ldc;
    __device__ __forceinline__ static float sw(float g, float u) { return g * u / (1.0f + __expf(-g)); }
    __device__ __forceinline__ void operator()(const f32x4 (&acc)[2][2][4][2], const Unit& u, int wr, int wc, int fr, int fq) const {
        const int row0 = u.pm * BM + wr * 64 + fr; const int col0 = (u.pn * BM + wc * 32 + 8 * fq) >> 1;
#pragma unroll
        for (int ai = 0; ai < 2; ++ai)
#pragma unroll
            for (int m = 0; m < 4; ++m) { bf16_t* rowp = O + (size_t)(row0 + ai * HALF + m * 16) * ldc + col0;
#pragma unroll
                for (int bj = 0; bj < 2; ++bj) { const f32x4 v0 = acc[ai][bj][m][0], v1 = acc[ai][bj][m][1];
                    u32x2 w; w.x = cvt_pk_bf16(sw(v0[0], v0[1]), sw(v0[2], v0[3])); w.y = cvt_pk_bf16(sw(v1[0], v1[1]), sw(v1[2], v1[3]));
                    *(u32x2*)(rowp + bj * (HALF / 2)) = w; } }
    }
};
struct EpiRes {
    static constexpr bool PERM = false, AFTER_DRAIN = false;
    const float* base_a; const float* base_b; float* out; const float* gate;
    __device__ __forceinline__ void operator()(const f32x4 (&acc)[2][2][4][2], const Unit& u, int wr, int wc, int fr, int fq) const {
        const int col0 = u.pn * BM + wc * 32 + 4 * fq;
        const int rmod = u.pm < 16 ? 0 : 1 + ((u.pm - 16) >> 2);
        const float* g = gate + (size_t)rmod * 6144 + col0;
        const float* bp = u.pm < 16 ? base_a + (size_t)u.pm * BM * 1024 : base_b + (size_t)(u.pm - 16) * BM * 1024;
        float* op = out + (size_t)u.pm * BM * 1024;
        f32x4 gv[2][2];
#pragma unroll
        for (int bj = 0; bj < 2; ++bj)
#pragma unroll
            for (int n = 0; n < 2; ++n) gv[bj][n] = *(const f32x4*)(g + bj * HALF + n * 16);
#pragma unroll
        for (int ai = 0; ai < 2; ++ai)
#pragma unroll
            for (int m = 0; m < 4; ++m) { const size_t off = (size_t)(ai * HALF + wr * 64 + m * 16 + fr) * 1024 + col0;
#pragma unroll
                for (int bj = 0; bj < 2; ++bj)
#pragma unroll
                    for (int n = 0; n < 2; ++n) { const f32x4 bs = *(const f32x4*)(bp + off + bj * HALF + n * 16);
                        *(f32x4*)(op + off + bj * HALF + n * 16) = bs + gv[bj][n] * acc[ai][bj][m][n]; } }
    }
};

template <class Epi, class Sched, bool ALIGN_EPI = false, bool SP2 = false>
__device__ __forceinline__ void gemm_phase(PG8_LAS unsigned char* lds, const Gemm g, const Sched& S, const Epi& E, const int tid) {
    const int wid = __builtin_amdgcn_readfirstlane(tid >> 6), lane = tid & 63, wr = wid >> 2, wc = wid & 3, fr = lane & 15, fq = lane >> 4;
    const int K = g.K, nt = K / BK;
    unsigned voffA[2], voffB[2];
#pragma unroll
    for (int i = 0; i < 2; ++i) { int R, C; stage_rc(tid * 16 + i * 8192, R, C); const int Rb = Epi::PERM ? ((R & ~31) + perm32(R & 31)) : R;
        voffA[i] = (unsigned)(R * K + C) * 2u; voffB[i] = (unsigned)(Rb * K + C) * 2u; }
    const size_t kstep = (size_t)(BK * 2);
    const size_t hstep = (size_t)HALF * K * 2;
    const size_t tstep = 2 * hstep;
    const unsigned ldsw = (unsigned)wid * 1024u;
    const int aoff = lds_byte(wr * 64 + fr, fq * 8), boff = lds_byte(wc * 32 + fr, fq * 8);
#define PG8_SA(b, h) (((b) * 2 + (h)) * HTB)
#define PG8_SB(b, h) ((4 + (b) * 2 + (h)) * HTB)
#define PG8_STAGE(bufoff, gbase, voff) do { _Pragma("unroll") for (int _i = 0; _i < 2; ++_i) \
        __builtin_amdgcn_global_load_lds((const unsigned*)((const char*)(gbase) + (voff)[_i]), (PG8_LAS unsigned*)(lds + (bufoff) + ldsw + _i * 8192), 16, 0, 0); } while (0)
#define PG8_LDA(dst, b, h) do { _Pragma("unroll") for (int m = 0; m < 4; ++m) _Pragma("unroll") for (int k = 0; k < 2; ++k) dst[m][k] = *(const PG8_LAS bf16x8*)(lds + PG8_SA(b, h) + aoff + m * 2048 + k * 1024); } while (0)
#define PG8_LDB(dst, b, h) do { _Pragma("unroll") for (int n = 0; n < 2; ++n) _Pragma("unroll") for (int k = 0; k < 2; ++k) dst[n][k] = *(const PG8_LAS bf16x8*)(lds + PG8_SB(b, h) + boff + n * 2048 + k * 1024); } while (0)
#define PG8_MMA(ai, bj, At, Bt) do { __builtin_amdgcn_s_setprio(1); _Pragma("unroll") for (int m = 0; m < 4; ++m) _Pragma("unroll") for (int n = 0; n < 2; ++n) _Pragma("unroll") for (int k = 0; k < 2; ++k) \
        acc[ai][bj][m][n] = __builtin_amdgcn_mfma_f32_16x16x32_bf16(Bt[n][k], At[m][k], acc[ai][bj][m][n], 0, 0, 0); __builtin_amdgcn_s_setprio(0); } while (0)
#define PG8_WAIT_V(n) asm volatile("s_waitcnt vmcnt(" #n ")" ::: "memory")
#define PG8_WAIT_L(n) asm volatile("s_waitcnt lgkmcnt(" #n ")" ::: "memory")
#define PG8_BAR __builtin_amdgcn_s_barrier()
#define PG8_SCHED __builtin_amdgcn_sched_barrier(0)
    Unit cur, nxt; int ui = 0;
    if (!S.next(0, cur)) return;
    f32x4 acc[2][2][4][2];
#pragma unroll
    for (int a = 0; a < 2; ++a)
#pragma unroll
        for (int b = 0; b < 2; ++b)
#pragma unroll
            for (int m = 0; m < 4; ++m)
#pragma unroll
                for (int n = 0; n < 2; ++n) acc[a][b][m][n] = (f32x4){0.f, 0.f, 0.f, 0.f};
    bf16x8 At[4][2], B0[2][2], B1[2][2];
    const char* cA = (const char*)g.A + (size_t)cur.pm * tstep; const char* cB = (const char*)g.Bt + (size_t)cur.pn * tstep;
    S.a_ready(cur);
    if constexpr (SP2) {
        PG8_STAGE(PG8_SB(0, 0), cB, voffB); PG8_STAGE(PG8_SB(0, 1), cB + hstep, voffB); PG8_STAGE(PG8_SA(0, 0), cA, voffA); PG8_STAGE(PG8_SA(0, 1), cA + hstep, voffA);
        if (wr == 1) PG8_BAR;
        PG8_WAIT_V(2); PG8_BAR;
        PG8_STAGE(PG8_SB(1, 0), cB + kstep, voffB); PG8_STAGE(PG8_SA(1, 0), cA + kstep, voffA); PG8_STAGE(PG8_SB(1, 1), cB + hstep + kstep, voffB);
        PG8_WAIT_V(6); PG8_BAR;
    } else {
        PG8_STAGE(PG8_SB(0, 0), cB, voffB); PG8_STAGE(PG8_SA(0, 0), cA, voffA); PG8_STAGE(PG8_SB(0, 1), cB + hstep, voffB); PG8_STAGE(PG8_SA(0, 1), cA + hstep, voffA);
        if (wr == 1) PG8_BAR;
        PG8_WAIT_V(4); PG8_BAR;
        PG8_STAGE(PG8_SB(1, 0), cB + kstep, voffB); PG8_STAGE(PG8_SA(1, 0), cA + kstep, voffA); PG8_STAGE(PG8_SB(1, 1), cB + hstep + kstep, voffB);
        PG8_WAIT_V(6); PG8_BAR;
    }
    for (;;) {
        const bool has_next = S.next(ui + 1, nxt);
        const char* nA = has_next ? (const char*)g.A + (size_t)nxt.pm * tstep : cA; const char* nB = has_next ? (const char*)g.Bt + (size_t)nxt.pn * tstep : cB;
        for (int t = 0; t < nt; t += 2) {
            const bool last = (t == nt - 2);
            const char* a1 = cA + (size_t)(t + 1) * kstep;
            const char* a2 = last ? nA : cA + (size_t)(t + 2) * kstep; const char* b2 = last ? nB : cB + (size_t)(t + 2) * kstep;
            const char* a3 = a2 + kstep; const char* b3 = b2 + kstep;
            if (last && has_next) S.a_ready(nxt);
            if constexpr (SP2) {
            PG8_LDB(B0, 0, 0); PG8_LDB(B1, 0, 1); PG8_SCHED; PG8_LDA(At, 0, 0); PG8_STAGE(PG8_SA(1, 1), a1 + hstep, voffA);
            PG8_WAIT_V(8); PG8_WAIT_L(0); PG8_BAR; PG8_MMA(0, 0, At, B0); PG8_MMA(0, 1, At, B1); PG8_BAR; PG8_SCHED;
            PG8_LDA(At, 0, 1); PG8_STAGE(PG8_SB(0, 0), b2, voffB); PG8_STAGE(PG8_SB(0, 1), b2 + hstep, voffB); PG8_STAGE(PG8_SA(0, 0), a2, voffA);
            PG8_WAIT_V(8); PG8_WAIT_L(0); PG8_BAR; PG8_MMA(1, 0, At, B0); PG8_MMA(1, 1, At, B1); PG8_BAR; PG8_SCHED;
            PG8_LDB(B0, 1, 0); PG8_LDB(B1, 1, 1); PG8_SCHED; PG8_LDA(At, 1, 0); PG8_STAGE(PG8_SA(0, 1), a2 + hstep, voffA);
            PG8_WAIT_V(8); PG8_WAIT_L(0); PG8_BAR; PG8_MMA(0, 0, At, B0); PG8_MMA(0, 1, At, B1); PG8_BAR; PG8_SCHED;
            PG8_LDA(At, 1, 1); PG8_STAGE(PG8_SB(1, 0), b3, voffB); PG8_STAGE(PG8_SB(1, 1), b3 + hstep, voffB); PG8_STAGE(PG8_SA(1, 0), a3, voffA);
            PG8_WAIT_V(8); PG8_WAIT_L(0); PG8_BAR; PG8_MMA(1, 0, At, B0); PG8_MMA(1, 1, At, B1); PG8_BAR; PG8_SCHED;
            } else {
            PG8_LDB(B0, 0, 0); PG8_SCHED; PG8_LDA(At, 0, 0); PG8_STAGE(PG8_SA(1, 1), a1 + hstep, voffA);
            PG8_WAIT_L(8); PG8_BAR; PG8_WAIT_L(0); PG8_MMA(0, 0, At, B0); PG8_BAR; PG8_SCHED;
            PG8_LDB(B1, 0, 1); PG8_STAGE(PG8_SB(0, 0), b2, voffB);
            PG8_BAR; PG8_WAIT_L(0); PG8_MMA(0, 1, At, B1); PG8_BAR;
            PG8_LDA(At, 0, 1); PG8_STAGE(PG8_SA(0, 0), a2, voffA);
            PG8_BAR; PG8_WAIT_L(0); PG8_MMA(1, 0, At, B0); PG8_BAR; PG8_SCHED;
            PG8_STAGE(PG8_SB(0, 1), b2 + hstep, voffB);
            PG8_WAIT_V(6); PG8_BAR; PG8_MMA(1, 1, At, B1); PG8_BAR;
            PG8_LDB(B0, 1, 0); PG8_SCHED; PG8_LDA(At, 1, 0); PG8_STAGE(PG8_SA(0, 1), a2 + hstep, voffA);
            PG8_WAIT_L(8); PG8_BAR; PG8_WAIT_L(0); PG8_MMA(0, 0, At, B0); PG8_BAR; PG8_SCHED;
            PG8_LDB(B1, 1, 1); PG8_STAGE(PG8_SB(1, 0), b3, voffB);
            PG8_BAR; PG8_WAIT_L(0); PG8_MMA(0, 1, At, B1); PG8_BAR;
            PG8_LDA(At, 1, 1); PG8_STAGE(PG8_SA(1, 0), a3, voffA);
            PG8_BAR; PG8_WAIT_L(0); PG8_MMA(1, 0, At, B0); PG8_BAR; PG8_SCHED;
            PG8_STAGE(PG8_SB(1, 1), b3 + hstep, voffB);
            PG8_WAIT_V(6); PG8_BAR; PG8_MMA(1, 1, At, B1); PG8_BAR;
            }
        }
        if constexpr (ALIGN_EPI) { if (wr == 0) PG8_BAR; }
        if constexpr (!Epi::AFTER_DRAIN) { E(acc, cur, wr, wc, fr, fq); S.done(cur); }
        if (!has_next) break;
#pragma unroll
        for (int a = 0; a < 2; ++a)
#pragma unroll
            for (int b = 0; b < 2; ++b)
#pragma unroll
                for (int m = 0; m < 4; ++m)
#pragma unroll
                    for (int n = 0; n < 2; ++n) acc[a][b][m][n] = (f32x4){0.f, 0.f, 0.f, 0.f};
        cur = nxt; cA = nA; cB = nB; ++ui;
        if constexpr (ALIGN_EPI) { if (wr == 1) PG8_BAR; }
    }
    PG8_WAIT_V(0);
    if constexpr (!ALIGN_EPI) { if (wr == 0) PG8_BAR; }
    PG8_BAR;
#undef PG8_SA
#undef PG8_SB
#undef PG8_STAGE
#undef PG8_LDA
#undef PG8_LDB
#undef PG8_MMA
#undef PG8_WAIT_V
#undef PG8_WAIT_L
#undef PG8_BAR
#undef PG8_SCHED
}
}

constexpr int NWAVES = 8, NT = 512;
constexpr int DM = 1024, M_CTX = 4096, M_LAT = 8192, MTOK = 12288, DEPTH = 2;
constexpr int ZP = 2816, FF = 2816, NGU = 5632, IN_COLS = 2736;
constexpr int Z_AQ = 0, Z_AK = 256, Z_AV = 384, Z_BQ = 512, Z_BK = 768, Z_BV = 1024, Z_CQKV = 1280, Z_CG = 2048, Z_CA = 2304, Z_CB = 2312, Z_DCQ = 2320, Z_DCKV = 2576, Z_DKR = 2704;
constexpr int NCACHE = 4096;
constexpr int KVROWS = MTOK + NCACHE;
constexpr float LOG2E = 1.4426950408889634f;
constexpr float MLA_SCALE = 0.10206207261596577f;
enum { I_XP = 0, I_XS, I_CGK, I_CGV, I_CNK, I_CNV, I_SDN, I_CCKV, I_CKR, I_C, I_CCTX, I_N1G, I_N2G, I_WMOD, I_BMOD, I_WIN, I_WOUT, I_QNG, I_KNG, I_NAB,
       I_CONV, I_ALOG, I_DTB, I_DNOG, I_MQNG, I_WQUP, I_MKVNG, I_WKVUP, I_WG, I_WU, I_WD, I_FG, N_IN };
constexpr size_t O_YP = 0, O_YS = 4194304, O_GK = 12582912, O_GV = 13631488, O_NK = 14680064, O_NV = 16777216, O_DS = 18874368, O_CKV = 19922944, O_KR = 20971520, O_END = 21233664;

constexpr size_t MiB = 1u << 20;
constexpr size_t WS_CTL = 0, CTL_ZERO_BYTES = 1 * MiB;
constexpr size_t WS_MODS = 1 * MiB;
constexpr size_t WS_ROPE = 1 * MiB + 512 * 1024;
constexpr size_t WS_W = 2 * MiB, W_LAYER = 25 * MiB;
constexpr size_t W_IN = 0, W_OUT = W_IN + (size_t)ZP * 1024 * 2, W_GU = W_OUT + (size_t)1024 * 1024 * 2, W_D = W_GU + (size_t)NGU * 1024 * 2,
                 W_Q = W_D + (size_t)1024 * FF * 2, W_KV = W_Q + (size_t)512 * 256 * 2, W_LEND = W_KV + (size_t)512 * 256 * 2;
static_assert(W_LEND <= W_LAYER, "weights per layer");
constexpr size_t WS_XN = 52 * MiB;
constexpr size_t WS_Z = 76 * MiB;
constexpr size_t WS_O = 142 * MiB;
constexpr size_t WS_QA = 166 * MiB, WS_KA = 172 * MiB, WS_VA = 176 * MiB;
constexpr size_t WS_DQ = 180 * MiB, WS_DK = 186 * MiB, WS_DV = 192 * MiB;
constexpr size_t WS_BG = 198 * MiB;
constexpr size_t WS_QN = 199 * MiB;
constexpr size_t WS_CKV = 205 * MiB;
constexpr size_t WS_KR = 213 * MiB;
constexpr size_t WS_QM = 214 * MiB;
constexpr size_t WS_KV = 226 * MiB;
constexpr size_t WS_NKB = 242 * MiB, WS_NVB = 244 * MiB;
constexpr size_t WS_END = 246 * MiB;
constexpr int CW_BAR = 4096;

constexpr int RING_BYTES = 131072, LDSCTL_OFF = RING_BYTES, MISC_OFF = LDSCTL_OFF + 320, LDS_BYTES = 147456;

#define GAS __attribute__((address_space(1)))
#define LAS __attribute__((address_space(3)))
typedef unsigned short bf16;
typedef unsigned v4u __attribute__((ext_vector_type(4)));
typedef unsigned v2u __attribute__((ext_vector_type(2)));
typedef float f32x4 __attribute__((ext_vector_type(4)));
__device__ __forceinline__ unsigned f2bf(float f) { unsigned u = __builtin_bit_cast(unsigned, f); return (u + 0x7fffu + ((u >> 16) & 1u)) >> 16; }
__device__ __forceinline__ unsigned pk2(float lo, float hi) { return f2bf(lo) | (f2bf(hi) << 16); }
__device__ __forceinline__ float bf2f(bf16 h) { return __uint_as_float((unsigned)h << 16); }
__device__ __forceinline__ float bflo(unsigned u) { return __uint_as_float(u << 16); }
__device__ __forceinline__ float bfhi(unsigned u) { return __uint_as_float(u & 0xffff0000u); }
#define LDS_WAIT() asm volatile("s_waitcnt lgkmcnt(0)" ::: "memory")

#define XB_TMO      128
#define XB_XCNT(j)  (256  + 64 * (j))
#define XB_XSUB(j)  (1280 + 64 * (j))
#define XB_XGEN(j)  (2304 + 64 * (j))
#define XB_TOP      3328
#define XB_TOPGEN   3392
#define XCD_BAR_WORDS 3456
#define XB_SPIN_CAP (1u << 18)
__device__ __forceinline__ unsigned xb_ld(unsigned* p)              { return __hip_atomic_load(p, __ATOMIC_RELAXED, __HIP_MEMORY_SCOPE_AGENT); }
__device__ __forceinline__ unsigned xb_add(unsigned* p, unsigned v) { return __hip_atomic_fetch_add(p, v, __ATOMIC_RELAXED, __HIP_MEMORY_SCOPE_AGENT); }
__device__ __forceinline__ unsigned xb_xcc_id() { return (unsigned)__builtin_amdgcn_s_getreg((3 << 11) | 20) & 0xFu; }
#define XB_SPIN(cond, bar) do { unsigned _sp = 0; while (cond) { __builtin_amdgcn_s_sleep(1); \
    if ((++_sp & 255u) == 0u) { if (xb_ld(&(bar)[XB_TMO])) break; if (_sp > XB_SPIN_CAP) { atomicAdd(&(bar)[XB_TMO], 1u); break; } } } } while (0)
struct XcdBarrier { unsigned* bar; unsigned x; volatile LAS unsigned* st; };
__device__ __forceinline__ XcdBarrier xcd_barrier_post(unsigned* bar, volatile LAS unsigned* st) {
    XcdBarrier b; b.bar = bar; b.x = xb_xcc_id(); b.st = st;
    if (threadIdx.x == 0) (void)xb_add(&bar[XB_XCNT(b.x)], 1u);
    return b;
}
__device__ __forceinline__ void xcd_barrier_complete(unsigned* bar, unsigned x, unsigned& nloc, unsigned& nx) {
    const unsigned G = gridDim.x * gridDim.y * gridDim.z;
    unsigned sum, cnt, mine, sp = 0u;
    for (;;) {
        sum = 0u; cnt = 0u; mine = 0u;
#pragma unroll
        for (unsigned j = 0; j < 16; ++j) { const unsigned c = xb_ld(&bar[XB_XCNT(j)]); sum += c; cnt += (c > 0u) ? 1u : 0u; mine = (j == x) ? c : mine; }
        if (sum == G) break;
        __builtin_amdgcn_s_sleep(1);
        if ((++sp & 255u) == 0u) { if (xb_ld(&bar[XB_TMO])) break; if (sp > XB_SPIN_CAP) { atomicAdd(&bar[XB_TMO], 1u); break; } }
    }
    nloc = mine > 0u ? mine : 1u; nx = cnt > 0u ? cnt : 1u;
}
__device__ __forceinline__ void xcd_barrier(const XcdBarrier& b) {
    asm volatile("s_waitcnt vmcnt(0)" ::: "memory");
    __syncthreads();
    if (threadIdx.x == 0) {
        unsigned* bar = b.bar;
        __builtin_amdgcn_s_waitcnt(0);
        unsigned nloc = b.st[0], nx = b.st[1];
        if (nloc == 0u) { xcd_barrier_complete(bar, b.x, nloc, nx); b.st[0] = nloc; b.st[1] = nx; }
        const unsigned old = xb_add(&bar[XB_XSUB(b.x)], 1u);
        const unsigned gen = old / nloc;
        if (old + 1u == (gen + 1u) * nloc) {
            __builtin_amdgcn_fence(__ATOMIC_RELEASE, "agent");
            asm volatile("s_waitcnt vmcnt(0)" ::: "memory");
            const unsigned og = xb_add(&bar[XB_TOP], 1u);
            const unsigned tg = og / nx;
            if (og + 1u == (tg + 1u) * nx) xb_add(&bar[XB_TOPGEN], 1u);
            else XB_SPIN(xb_ld(&bar[XB_TOPGEN]) == tg, bar);
            __builtin_amdgcn_fence(__ATOMIC_ACQUIRE, "agent");
            xb_add(&bar[XB_XGEN(b.x)], 1u);
            asm volatile("s_waitcnt vmcnt(0)" ::: "memory");
        } else {
            XB_SPIN(xb_ld(&bar[XB_XGEN(b.x)]) == gen, bar);
            __builtin_amdgcn_fence(__ATOMIC_ACQUIRE, "agent");
            asm volatile("s_waitcnt vmcnt(0)" ::: "memory");
        }
    }
    __syncthreads();
}

struct Args { const float* in[N_IN]; float* out; unsigned char* ws; int ph_lo, ph_hi; };
struct Frame {
    LAS unsigned char* lds;
    int tid, lane, wave, G, bid;
    const float* const* in; float* out; unsigned char* ws;
};
__device__ __forceinline__ float wave_sum(float v) {
#pragma unroll
    for (int o = 1; o < 64; o <<= 1) v += __shfl_xor(v, o);
    return v;
}
__device__ __forceinline__ float silu_f(float x) { return x / (1.0f + __expf(-x)); }

__device__ __forceinline__ void p0_transpose_item(const float* W, int K, int Nsrc, int Npad, int KP, bf16* WT, int row_off, int rmul, LAS float* scr, int item, int lane) {
    const int nblk = Npad / 32, kb = item / nblk, nb = item % nblk, k0 = 64 * kb, n0 = 32 * nb;
    const int nn = n0 + (lane & 31);
#pragma unroll 8
    for (int i = 0; i < 32; ++i) { const int kk = 2 * i + (lane >> 5); scr[kk * 33 + (lane & 31)] = (nn < Nsrc && (k0 + kk) < K) ? W[(size_t)(k0 + kk) * Nsrc + nn] : 0.f; }
    LDS_WAIT(); asm volatile("" ::: "memory");
    const int c = lane & 7;
#pragma unroll
    for (int j = 0; j < 4; ++j) { const int n = (lane >> 3) + 8 * j; const LAS float* s = scr + (8 * c) * 33 + n;
        v4u o; o.x = pk2(s[0 * 33], s[1 * 33]); o.y = pk2(s[2 * 33], s[3 * 33]); o.z = pk2(s[4 * 33], s[5 * 33]); o.w = pk2(s[6 * 33], s[7 * 33]);
        *(v4u*)(WT + (size_t)(row_off + rmul * (n0 + n)) * KP + k0 + 8 * c) = o; }
    LDS_WAIT(); asm volatile("" ::: "memory");
}
__device__ __forceinline__ void p0a(Frame& F) {
    {
        LAS float* sc = (LAS float*)(F.lds);
        LAS float* part = (LAS float*)(F.lds + 9 * 1024 * 4);
        for (int e = F.tid; e < 9 * 1024; e += NT) { const int r = e >> 10, k = e & 1023; const float c = (r == 0) ? F.in[I_CCTX][k] : F.in[I_C][(r - 1) * 1024 + k]; sc[e] = silu_f(c); }
        __syncthreads();
        for (int it = F.bid; it < 2 * 96; it += F.G) {
            const int l = it / 96, n0 = (it % 96) * 64;
            const float* w = F.in[I_WMOD] + (size_t)l * 1024 * 6144 + n0 + F.lane;
            float acc[9];
#pragma unroll
            for (int r = 0; r < 9; ++r) acc[r] = 0.f;
            const int kb = F.wave * 128;
#pragma unroll 8
            for (int k = 0; k < 128; ++k) { const float wv = w[(size_t)(kb + k) * 6144];
#pragma unroll
                for (int r = 0; r < 9; ++r) acc[r] += sc[r * 1024 + kb + k] * wv; }
#pragma unroll
            for (int r = 0; r < 9; ++r) part[(F.wave * 9 + r) * 64 + F.lane] = acc[r];
            __syncthreads();
            for (int e = F.tid; e < 9 * 64; e += NT) { const int r = e >> 6, c = e & 63; float s = 0.f;
#pragma unroll
                for (int w8 = 0; w8 < 8; ++w8) s += part[(w8 * 9 + r) * 64 + c];
                ((float*)(F.ws + WS_MODS))[(size_t)(l * 9 + r) * 6144 + n0 + c] = s + F.in[I_BMOD][l * 6144 + n0 + c]; }
            __syncthreads();
        }
    }
    if (F.bid == F.G - 1) {
        float* tab = (float*)(F.ws + WS_ROPE);
        for (int e = F.tid; e < 64 * 16 + 64 * 8; e += NT) {
            int pos, i, half; float* dst;
            if (e < 1024) { pos = e >> 4; i = e & 15; half = 16; dst = tab + 2 * e; } else { const int e2 = e - 1024; pos = e2 >> 3; i = e2 & 7; half = 8; dst = tab + 2048 + 2 * e2; }
            const float inv = exp2f(-(float)i / (float)half * 13.287712379549449f);
            const float ang = (float)pos * inv;
            const double twopi = 6.283185307179586476925; const double a = (double)ang; const double kq = __builtin_rint(a / twopi); const float rr = (float)(a - kq * twopi);
            dst[0] = __builtin_cosf(rr); dst[1] = __builtin_sinf(rr);
        }
    }
    __syncthreads();
    {
        LAS float* scr = (LAS float*)(F.lds + F.wave * 16384);
        const int gw = F.bid * NWAVES + F.wave, NGW = F.G * NWAVES;
        constexpr int I_IN = 16 * 88, I_OUT = 16 * 32, I_G = 16 * 88, I_U = 16 * 88, I_D = 44 * 32, I_Q = 4 * 16, I_KV = 4 * 16;
        constexpr int PER_L = I_IN + I_OUT + I_G + I_U + I_D + I_Q + I_KV;
        for (int it = gw; it < 2 * PER_L; it += NGW) {
            const int l = it / PER_L; int r = it % PER_L;
            unsigned char* wl = F.ws + WS_W + (size_t)l * W_LAYER;
            if (r < I_IN) { p0_transpose_item(F.in[I_WIN] + (size_t)l * 1024 * IN_COLS, 1024, IN_COLS, ZP, 1024, (bf16*)(wl + W_IN), 0, 1, scr, r, F.lane); continue; } r -= I_IN;
            if (r < I_OUT) { p0_transpose_item(F.in[I_WOUT] + (size_t)l * 1024 * 1024, 1024, 1024, 1024, 1024, (bf16*)(wl + W_OUT), 0, 1, scr, r, F.lane); continue; } r -= I_OUT;
            if (r < I_G) { p0_transpose_item(F.in[I_WG] + (size_t)l * 1024 * FF, 1024, FF, FF, 1024, (bf16*)(wl + W_GU), 0, 2, scr, r, F.lane); continue; } r -= I_G;
            if (r < I_U) { p0_transpose_item(F.in[I_WU] + (size_t)l * 1024 * FF, 1024, FF, FF, 1024, (bf16*)(wl + W_GU), 1, 2, scr, r, F.lane); continue; } r -= I_U;
            if (r < I_D) { p0_transpose_item(F.in[I_WD] + (size_t)l * FF * 1024, FF, 1024, 1024, FF, (bf16*)(wl + W_D), 0, 1, scr, r, F.lane); continue; } r -= I_D;
            if (r < I_Q) { p0_transpose_item(F.in[I_WQUP] + (size_t)l * 256 * 384, 256, 384, 512, 256, (bf16*)(wl + W_Q), 0, 1, scr, r, F.lane); continue; } r -= I_Q;
            p0_transpose_item(F.in[I_WKVUP] + (size_t)l * 128 * 512, 128, 512, 512, 256, (bf16*)(wl + W_KV), 0, 1, scr, r, F.lane);
        }
    }
}

__device__ __forceinline__ const float* xrow_ptr(Frame& F, int m, bool from_in) {
    if (from_in) return m < M_CTX ? F.in[I_XP] + (size_t)m * DM : F.in[I_XS] + (size_t)(m - M_CTX) * DM;
    return F.out + (size_t)m * DM;
}
template <int MODE> __device__ __forceinline__ void norm_rows(Frame& F, bool from_in, const float* g, const float* mods_l  , int sh_off, int sc_off) {
    const int gw = F.bid * NWAVES + F.wave, NGW = F.G * NWAVES;
    for (int m = gw; m < MTOK; m += NGW) {
        const f32x4* xr = (const f32x4*)xrow_ptr(F, m, from_in) + F.lane;
        f32x4 v[4]; float s = 0.f;
#pragma unroll
        for (int j = 0; j < 4; ++j) { v[j] = xr[64 * j]; s += (v[j].x * v[j].x + v[j].y * v[j].y) + (v[j].z * v[j].z + v[j].w * v[j].w); }
        const float rstd = 1.0f / sqrtf(wave_sum(s) * (1.f / DM) + 1e-6f);
        if (MODE == 0) {
            const int rmod = m < M_CTX ? 0 : 1 + ((m - M_CTX) >> 10);
            const float* mr = mods_l + (size_t)rmod * 6144;
            unsigned long long* o8 = (unsigned long long*)((bf16*)(F.ws + WS_XN) + (size_t)m * DM) + F.lane;
#pragma unroll
            for (int j = 0; j < 4; ++j) { const int c = 4 * F.lane + 256 * j; const f32x4 gg = *(const f32x4*)(g + c), sh = *(const f32x4*)(mr + sh_off + c), sc = *(const f32x4*)(mr + sc_off + c);
                const f32x4 y = (v[j] * rstd * gg) * (sc + 1.0f) + sh;
                o8[64 * j] = (unsigned long long)pk2(y.x, y.y) | ((unsigned long long)pk2(y.z, y.w) << 32); }
        } else {
            f32x4* yo = (f32x4*)(F.out + (size_t)m * DM) + F.lane;
#pragma unroll
            for (int j = 0; j < 4; ++j) { const int c = 4 * F.lane + 256 * j; const f32x4 gg = *(const f32x4*)(g + c); yo[64 * j] = v[j] * rstd * gg; }
        }
    }
}

__device__ __forceinline__ void prep_phase(Frame& F, int l) {
    const int gw = F.bid * NWAVES + F.wave, NGW = F.G * NWAVES, lane = F.lane;
    const bf16* Z = (const bf16*)(F.ws + WS_Z);
    bf16* QA = (bf16*)(F.ws + WS_QA); bf16* KA = (bf16*)(F.ws + WS_KA); bf16* VA = (bf16*)(F.ws + WS_VA);
    bf16* DQ = (bf16*)(F.ws + WS_DQ); bf16* DK = (bf16*)(F.ws + WS_DK); bf16* DV = (bf16*)(F.ws + WS_DV);
    float* BG = (float*)(F.ws + WS_BG);
    bf16* QN = (bf16*)(F.ws + WS_QN); bf16* CKV = (bf16*)(F.ws + WS_CKV); bf16* KR = (bf16*)(F.ws + WS_KR);
    const float* tabA = (const float*)(F.ws + WS_ROPE); const float* tabM = tabA + 2048;
    const float qn_g = F.in[I_QNG][l * 64 + lane], kn_g = F.in[I_KNG][l * 64 + lane];
    for (int it = gw; it < MTOK + NCACHE; it += NGW) {
        if (it >= MTOK) {
            const int cr = it - MTOK, b = cr >> 9, j = cr & 511; const size_t src = (size_t)((b * 2 + l) * 512 + j);
            const int krow = M_CTX + b * 1536 + j;
            const float* gk = F.in[I_CGK] + src * 128; const float* gv = F.in[I_CGV] + src * 128; const float* ck = F.in[I_CCKV] + src * 128; const float* kr = F.in[I_CKR] + src * 32;
            KA[(size_t)krow * 128 + lane] = (bf16)f2bf(gk[lane]); KA[(size_t)krow * 128 + 64 + lane] = (bf16)f2bf(gk[64 + lane]);
            VA[(size_t)krow * 128 + lane] = (bf16)f2bf(gv[lane]); VA[(size_t)krow * 128 + 64 + lane] = (bf16)f2bf(gv[64 + lane]);
            CKV[(size_t)it * 256 + lane] = (bf16)f2bf(ck[lane]); CKV[(size_t)it * 256 + 64 + lane] = (bf16)f2bf(ck[64 + lane]);
            CKV[(size_t)it * 256 + 128 + lane] = 0; CKV[(size_t)it * 256 + 192 + lane] = 0;
            if (lane < 32) KR[(size_t)it * 32 + lane] = (bf16)f2bf(kr[lane]);
            { const float* nk = F.in[I_CNK] + src * 256; const float* nv = F.in[I_CNV] + src * 256; bf16* NKB = (bf16*)(F.ws + WS_NKB) + (size_t)cr * 256; bf16* NVB = (bf16*)(F.ws + WS_NVB) + (size_t)cr * 256;
#pragma unroll
              for (int i = 0; i < 4; ++i) { NKB[i * 64 + lane] = (bf16)f2bf(nk[i * 64 + lane]); NVB[i * 64 + lane] = (bf16)f2bf(nv[i * 64 + lane]); } }
            continue;
        }
        const int m = it; const bool lat = m >= M_CTX;
        const int b = lat ? (m - M_CTX) >> 10 : m >> 8, t = lat ? (m - M_CTX) & 1023 : m & 255, L = lat ? 1024 : 256;
        const int pr = t >> 6, pc = t & 63;
        const bf16* zr = Z + (size_t)m * ZP;
        const size_t orow = (size_t)((b * 2 + l) * 256 + t);
        for (int hq = 0; hq < 4; ++hq) {
            const float x = bf2f(zr[Z_AQ + hq * 64 + lane]); const float ss = wave_sum(x * x);
            float y = x * (1.0f / sqrtf(ss * (1.f / 64.f) + 1e-6f)) * qn_g;
            if (lat) { const float yp = __shfl_xor(y, 16); const int pos = lane < 32 ? pr : pc; const float* cs = tabA + (pos * 16 + (lane & 15)) * 2;
                y = (lane & 16) ? y * cs[0] + yp * cs[1] : y * cs[0] - yp * cs[1]; }
            QA[(size_t)m * 256 + hq * 64 + lane] = (bf16)f2bf(y);
        }
        const int krow = lat ? M_CTX + b * 1536 + 512 + t : m;
        for (int kh = 0; kh < 2; ++kh) {
            const float x = bf2f(zr[Z_AK + kh * 64 + lane]); const float ss = wave_sum(x * x);
            float y = x * (1.0f / sqrtf(ss * (1.f / 64.f) + 1e-6f)) * kn_g;
            if (!lat) F.out[O_GK + orow * 128 + kh * 64 + lane] = y;
            if (lat) { const float yp = __shfl_xor(y, 16); const int pos = lane < 32 ? pr : pc; const float* cs = tabA + (pos * 16 + (lane & 15)) * 2;
                y = (lane & 16) ? y * cs[0] + yp * cs[1] : y * cs[0] - yp * cs[1]; }
            KA[(size_t)krow * 128 + kh * 64 + lane] = (bf16)f2bf(y);
            const bf16 vb = zr[Z_AV + kh * 64 + lane];
            VA[(size_t)krow * 128 + kh * 64 + lane] = vb;
            if (!lat) F.out[O_GV + orow * 128 + kh * 64 + lane] = bf2f(vb);
        }
        if (!lat) {
#pragma unroll
            for (int i = 0; i < 4; ++i) { F.out[O_NK + orow * 256 + i * 64 + lane] = bf2f(zr[Z_BK + i * 64 + lane]); F.out[O_NV + orow * 256 + i * 64 + lane] = bf2f(zr[Z_BV + i * 64 + lane]); }
        }
        for (int g = 0; g < 12; ++g) {
            const int ch = g * 64 + lane; float acc = 0.f;
#pragma unroll
            for (int j = 0; j < 4; ++j) { const int tt = t + j - 1; if (tt >= 0 && tt < L) acc += F.in[I_CONV][(size_t)(l * 4 + j) * 768 + ch] * bf2f(zr[(ptrdiff_t)(j - 1) * ZP + Z_CQKV + ch]); }
            float y = silu_f(acc);
            if (g < 8) { const float ss = wave_sum(y * y); y *= 1.0f / sqrtf(ss + 1e-6f); if (g < 4) y *= 0.125f; }
            bf16* dst = g < 4 ? DQ : (g < 8 ? DK : DV);
            dst[(size_t)m * 256 + (ch & 255)] = (bf16)f2bf(y);
        }
        if (lane < 8) {
            const float a = bf2f(zr[Z_CA + lane]), bb = bf2f(zr[Z_CB + lane]);
            const float beta = 1.0f / (1.0f + __expf(-bb));
            const float xx = a + F.in[I_DTB][l * 8 + lane];
            const float sp = fmaxf(xx, 0.f) + log1pf(__expf(-fabsf(xx)));
            BG[(size_t)m * 16 + lane] = beta; BG[(size_t)m * 16 + 8 + lane] = -__expf(F.in[I_ALOG][l * 8 + lane]) * sp;
        }
        {
            float x[4]; float ss = 0.f;
#pragma unroll
            for (int i = 0; i < 4; ++i) { x[i] = bf2f(zr[Z_DCQ + i * 64 + lane]); ss += x[i] * x[i]; }
            const float rstd = 1.0f / sqrtf(wave_sum(ss) * (1.f / 256.f) + 1e-6f);
#pragma unroll
            for (int i = 0; i < 4; ++i) QN[(size_t)m * 256 + i * 64 + lane] = (bf16)f2bf(x[i] * rstd * F.in[I_MQNG][l * 256 + i * 64 + lane]);
            const float c0 = bf2f(zr[Z_DCKV + lane]), c1 = bf2f(zr[Z_DCKV + 64 + lane]);
            const float r2 = 1.0f / sqrtf(wave_sum(c0 * c0 + c1 * c1) * (1.f / 128.f) + 1e-6f);
            const float y0 = c0 * r2 * F.in[I_MKVNG][l * 128 + lane], y1 = c1 * r2 * F.in[I_MKVNG][l * 128 + 64 + lane];
            CKV[(size_t)m * 256 + lane] = (bf16)f2bf(y0); CKV[(size_t)m * 256 + 64 + lane] = (bf16)f2bf(y1); CKV[(size_t)m * 256 + 128 + lane] = 0; CKV[(size_t)m * 256 + 192 + lane] = 0;
            if (!lat) { F.out[O_CKV + orow * 128 + lane] = y0; F.out[O_CKV + orow * 128 + 64 + lane] = y1; }
            const int d = lane & 31; float kr = bf2f(zr[Z_DKR + d]);
            if (!lat) { if (lane < 32) F.out[O_KR + orow * 32 + d] = kr; }
            else { const float kp = __shfl_xor(kr, 8); const int pos = d < 16 ? pr : pc; const float* cs = tabM + (pos * 8 + (d & 7)) * 2;
                kr = (d & 8) ? kr * cs[0] + kp * cs[1] : kr * cs[0] - kp * cs[1]; }
            if (lane < 32) KR[(size_t)m * 32 + d] = (bf16)f2bf(kr);
        }
    }
}

typedef short bf16x8 __attribute__((ext_vector_type(8)));
typedef float f32x16 __attribute__((ext_vector_type(16)));
typedef float f32x2_t __attribute__((ext_vector_type(2))); typedef __bf16 bf16x2_t __attribute__((ext_vector_type(2)));
__device__ __forceinline__ unsigned cvtpk(float lo, float hi) { f32x2_t v = {lo, hi}; bf16x2_t b = __builtin_convertvector(v, bf16x2_t); return __builtin_bit_cast(unsigned, b); }
struct AttDesc {
    const bf16* Q; int qs; int qrow0;
    const bf16 *K0, *K1, *R0, *R1, *V0, *V1; int ks0, ks1, rs0, rs1, vs0, vs1;
    int row00, row01, nt0, nt;
    bf16* O; float scale;
    int qpos0;
    int rlo; const float* nab;
};
constexpr int ATT_KT = 0, ATT_VT = 16384, ATT_NB = 28672, ATT_VROW = 68;
template <int DK, bool NA, bool QROPE>
__device__ __forceinline__ void attn_block(Frame& F, const AttDesc& D) {
    constexpr int KROWB = (DK + 8) * 2, NS = DK / 16;
    const int tid = F.tid, lane = F.lane, w = F.wave, lq = lane & 31, hh = lane >> 5;
    LAS unsigned char* lds = F.lds;
    __syncthreads();
    if constexpr (NA) { for (int e = tid; e < 465; e += NT) ((LAS float*)(lds + ATT_NB))[e] = D.nab[e] * LOG2E; }
    const int qrow = D.qrow0 + 32 * w + lq;
    bf16x8 qf[NS];
#pragma unroll
    for (int s = 0; s < NS; ++s) qf[s] = *(const bf16x8*)(D.Q + (size_t)qrow * D.qs + 16 * s + 8 * hh);
    if constexpr (QROPE) {
        const float* tabM = (const float*)(F.ws + WS_ROPE) + 2048; const int n = D.qpos0 + 32 * w + lq;
#pragma unroll
        for (int sx = 4; sx < 6; ++sx) { const int pos = sx == 4 ? (n >> 6) : (n & 63); const v4u qw = __builtin_bit_cast(v4u, qf[sx]); float res[8];
#pragma unroll
            for (int j = 0; j < 8; ++j) { const unsigned dw = qw[j >> 1]; const float own = (j & 1) ? bfhi(dw) : bflo(dw); const float oth = __shfl_xor(own, 32);
                const float c = tabM[(pos * 8 + j) * 2], sn = tabM[(pos * 8 + j) * 2 + 1]; res[j] = hh ? own * c + oth * sn : own * c - oth * sn; }
            v4u nw; nw.x = cvtpk(res[0], res[1]); nw.y = cvtpk(res[2], res[3]); nw.z = cvtpk(res[4], res[5]); nw.w = cvtpk(res[6], res[7]); qf[sx] = __builtin_bit_cast(bf16x8, nw); }
    }
    const int na_r = (D.qpos0 >> 6) + (w >> 1), na_c = (w & 1) * 32 + lq, na_r0 = min(max(na_r - 4, 0), 8), na_c0 = min(max(na_c - 8, 0), 48);
    f32x16 o0, o1;
#pragma unroll
    for (int r = 0; r < 16; ++r) { o0[r] = 0.f; o1[r] = 0.f; }
    float m = -1e30f, lsum = 0.f;
    v4u kreg, rreg = (v4u){0u, 0u, 0u, 0u}, vreg;
#define ATT_LOAD(t_) do { const int t__ = (t_); const bool sg = t__ >= D.nt0; const int r0_ = sg ? D.row01 + 64 * (t__ - D.nt0) : D.row00 + 64 * t__; \
        const bf16* Kb = sg ? D.K1 : D.K0; const bf16* Vb = sg ? D.V1 : D.V0; const int ks_ = sg ? D.ks1 : D.ks0, vs_ = sg ? D.vs1 : D.vs0; \
        kreg = *(const v4u*)(Kb + (size_t)(r0_ + (tid >> 3)) * ks_ + (tid & 7) * 8); \
        if constexpr (DK == 96) { if (tid < 256) { const bf16* Rb = sg ? D.R1 : D.R0; const int rs_ = sg ? D.rs1 : D.rs0; rreg = *(const v4u*)(Rb + (size_t)(r0_ + (tid >> 2)) * rs_ + (tid & 3) * 8); } } \
        vreg = *(const v4u*)(Vb + (size_t)(r0_ + lane) * vs_ + w * 8); } while (0)
    ATT_LOAD(0);
    for (int t = 0; t < D.nt; ++t) {
        __syncthreads();
        *(LAS v4u*)(lds + ATT_KT + (tid >> 3) * KROWB + (tid & 7) * 16) = kreg;
        if constexpr (DK == 96) { if (tid < 256) *(LAS v4u*)(lds + ATT_KT + (tid >> 2) * KROWB + 128 + (tid & 3) * 16) = rreg; }
        { LAS bf16* vt = (LAS bf16*)(lds + ATT_VT) + (8 * w) * ATT_VROW + lane;
#pragma unroll
          for (int i = 0; i < 8; ++i) { const unsigned dw = vreg[i >> 1]; vt[i * ATT_VROW] = (bf16)((i & 1) ? (dw >> 16) : (dw & 0xffffu)); } }
        __syncthreads();
        if (t + 1 < D.nt) ATT_LOAD(t + 1);
        bool rel = true; int kr = 0; bool local = false;
        if constexpr (NA) { if (t >= D.nt0) { local = true; kr = D.rlo + (t - D.nt0); rel = (kr >= na_r0) && (kr < na_r0 + 8); } }
        if (rel) {
            f32x16 s0, s1;
#pragma unroll
            for (int r = 0; r < 16; ++r) { s0[r] = 0.f; s1[r] = 0.f; }
#pragma unroll
            for (int s = 0; s < NS; ++s) {
                const bf16x8 a0 = *(const LAS bf16x8*)(lds + ATT_KT + lq * KROWB + 32 * s + 16 * hh);
                const bf16x8 a1 = *(const LAS bf16x8*)(lds + ATT_KT + (32 + lq) * KROWB + 32 * s + 16 * hh);
                s0 = __builtin_amdgcn_mfma_f32_32x32x16_bf16(a0, qf[s], s0, 0, 0, 0);
                s1 = __builtin_amdgcn_mfma_f32_32x32x16_bf16(a1, qf[s], s1, 0, 0, 0);
            }
            float tmax = -1e30f;
            if (NA && local) {
                const LAS float* nbp = (const LAS float*)(lds + ATT_NB) + (kr - na_r + 7) * 31 + 15 - na_c;
#pragma unroll
                for (int r = 0; r < 16; ++r) { const int kc0 = (r & 3) + 8 * (r >> 2) + 4 * hh, kc1 = kc0 + 32;
                    const bool al0 = (unsigned)(kc0 - na_c0) < 16u, al1 = (unsigned)(kc1 - na_c0) < 16u;
                    const float b0 = nbp[al0 ? kc0 : na_c], b1 = nbp[al1 ? kc1 : na_c];
                    s0[r] = al0 ? s0[r] * D.scale + b0 : -1e30f; s1[r] = al1 ? s1[r] * D.scale + b1 : -1e30f;
                    tmax = fmaxf(tmax, fmaxf(s0[r], s1[r])); }
            } else {
#pragma unroll
                for (int r = 0; r < 16; ++r) { s0[r] *= D.scale; s1[r] *= D.scale; tmax = fmaxf(tmax, fmaxf(s0[r], s1[r])); }
            }
            tmax = fmaxf(tmax, __shfl_xor(tmax, 32));
            const float mn = fmaxf(m, tmax); const float corr = __builtin_amdgcn_exp2f(m - mn); m = mn;
            float ps = 0.f;
#pragma unroll
            for (int r = 0; r < 16; ++r) { s0[r] = __builtin_amdgcn_exp2f(s0[r] - mn); s1[r] = __builtin_amdgcn_exp2f(s1[r] - mn); ps += s0[r] + s1[r]; }
            lsum = lsum * corr + ps;
#pragma unroll
            for (int r = 0; r < 16; ++r) { o0[r] *= corr; o1[r] *= corr; }
            bf16x8 pf[2][2];
#pragma unroll
            for (int s = 0; s < 2; ++s) { v4u p0, p1;
                p0.x = cvtpk(s0[8 * s + 0], s0[8 * s + 1]); p0.y = cvtpk(s0[8 * s + 2], s0[8 * s + 3]); p0.z = cvtpk(s0[8 * s + 4], s0[8 * s + 5]); p0.w = cvtpk(s0[8 * s + 6], s0[8 * s + 7]);
                p1.x = cvtpk(s1[8 * s + 0], s1[8 * s + 1]); p1.y = cvtpk(s1[8 * s + 2], s1[8 * s + 3]); p1.z = cvtpk(s1[8 * s + 4], s1[8 * s + 5]); p1.w = cvtpk(s1[8 * s + 6], s1[8 * s + 7]);
                pf[0][s] = __builtin_bit_cast(bf16x8, p0); pf[1][s] = __builtin_bit_cast(bf16x8, p1); }
#pragma unroll
            for (int kt = 0; kt < 2; ++kt)
#pragma unroll
                for (int s = 0; s < 2; ++s) {
                    const LAS unsigned char* vb0 = lds + ATT_VT + lq * (ATT_VROW * 2) + 8 * hh + 64 * kt + 32 * s;
                    const LAS unsigned char* vb1 = vb0 + 32 * (ATT_VROW * 2);
                    const v2u l0 = *(const LAS v2u*)(vb0), h0 = *(const LAS v2u*)(vb0 + 16), l1 = *(const LAS v2u*)(vb1), h1 = *(const LAS v2u*)(vb1 + 16);
                    const v4u a0 = {l0.x, l0.y, h0.x, h0.y}, a1 = {l1.x, l1.y, h1.x, h1.y};
                    o0 = __builtin_amdgcn_mfma_f32_32x32x16_bf16(__builtin_bit_cast(bf16x8, a0), pf[kt][s], o0, 0, 0, 0);
                    o1 = __builtin_amdgcn_mfma_f32_32x32x16_bf16(__builtin_bit_cast(bf16x8, a1), pf[kt][s], o1, 0, 0, 0);
                }
        }
    }
#undef ATT_LOAD
    lsum += __shfl_xor(lsum, 32);
    const float rl = 1.0f / lsum;
    bf16* orow = D.O + (size_t)qrow * 1024 + 4 * hh;
#pragma unroll
    for (int g = 0; g < 4; ++g) {
        v2u w0, w1; w0.x = cvtpk(o0[4 * g] * rl, o0[4 * g + 1] * rl); w0.y = cvtpk(o0[4 * g + 2] * rl, o0[4 * g + 3] * rl);
        w1.x = cvtpk(o1[4 * g] * rl, o1[4 * g + 1] * rl); w1.y = cvtpk(o1[4 * g + 2] * rl, o1[4 * g + 3] * rl);
        *(v2u*)(orow + 8 * g) = w0; *(v2u*)(orow + 32 + 8 * g) = w1;
    }
}
__device__ __forceinline__ void att_task(Frame& F, int ly, int mixer, bool lat, int b, int h, int qb) {
    const bf16* Z = (const bf16*)(F.ws + WS_Z);
    AttDesc D;
    D.qrow0 = lat ? M_CTX + b * 1024 + qb * 256 : b * 256; D.qpos0 = qb * 256; D.rlo = 0; D.nab = nullptr;
    D.R0 = nullptr; D.R1 = nullptr; D.rs0 = 0; D.rs1 = 0;
    if (mixer == 0) {
        D.Q = (const bf16*)(F.ws + WS_QA) + h * 64; D.qs = 256;
        D.K0 = D.K1 = (const bf16*)(F.ws + WS_KA) + (h >> 1) * 64; D.V0 = D.V1 = (const bf16*)(F.ws + WS_VA) + (h >> 1) * 64; D.ks0 = D.ks1 = D.vs0 = D.vs1 = 128;
        D.row00 = lat ? M_CTX + b * 1536 : b * 256; D.row01 = 0; D.nt0 = D.nt = lat ? 24 : 4;
        D.O = (bf16*)(F.ws + WS_O) + h * 64; D.scale = 0.125f * LOG2E;
        attn_block<64, false, false>(F, D);
    } else if (mixer == 1) {
        D.Q = Z + Z_BQ + h * 64; D.qs = ZP; D.O = (bf16*)(F.ws + WS_O) + 256 + h * 64; D.scale = 0.125f * LOG2E;
        D.K1 = Z + Z_BK + h * 64; D.V1 = Z + Z_BV + h * 64; D.ks1 = D.vs1 = ZP;
        if (!lat) { D.K0 = D.K1; D.V0 = D.V1; D.ks0 = D.vs0 = ZP; D.row00 = b * 256; D.row01 = 0; D.nt0 = D.nt = 4; attn_block<64, false, false>(F, D); }
        else {
            D.K0 = (const bf16*)(F.ws + WS_NKB) + h * 64; D.V0 = (const bf16*)(F.ws + WS_NVB) + h * 64; D.ks0 = D.vs0 = 256; D.row00 = b * 512; D.nt0 = 8;
            const int r_first = qb * 4, rlo = min(max(r_first - 4, 0), 8), rhi = min(max(r_first + 3 - 4, 0), 8) + 7;
            D.rlo = rlo; D.row01 = M_CTX + b * 1024 + rlo * 64; D.nt = 8 + (rhi - rlo + 1);
            D.nab = F.in[I_NAB] + (size_t)((ly * 4 + h) * 15) * 31;
            attn_block<64, true, false>(F, D);
        }
    } else {
        D.Q = (const bf16*)(F.ws + WS_QM) + h * 96; D.qs = 512; D.O = (bf16*)(F.ws + WS_O) + 768 + h * 64; D.scale = MLA_SCALE * LOG2E;
        D.K0 = D.K1 = (const bf16*)(F.ws + WS_KV) + h * 128; D.V0 = D.V1 = (const bf16*)(F.ws + WS_KV) + h * 128 + 64; D.R0 = D.R1 = (const bf16*)(F.ws + WS_KR);
        D.ks0 = D.ks1 = D.vs0 = D.vs1 = 512; D.rs0 = D.rs1 = 32;
        if (lat) { D.row00 = MTOK + b * 512; D.nt0 = 8; D.row01 = M_CTX + b * 1024; D.nt = 24; attn_block<96, false, true>(F, D); }
        else { D.row00 = b * 256; D.row01 = 0; D.nt0 = D.nt = 4; attn_block<96, false, false>(F, D); }
    }
}

__device__ __forceinline__ void dn_task(Frame& F, int l, int seq) {
    const bool lat = seq < 64; const int s2 = lat ? seq : seq - 64;
    const int b = s2 >> 3, h = (s2 >> 1) & 3, dir = s2 & 1, L = lat ? 1024 : 256, row0 = lat ? M_CTX + b * 1024 : b * 256;
    LAS float* qs = (LAS float*)F.lds; LAS float* ks = qs + 4096; LAS float* vs = ks + 4096; LAS float* gs = vs + 4096; LAS float* bs = gs + 64; LAS float* red1 = bs + 64; LAS float* red2 = red1 + 512;
    const bf16* DQ = (const bf16*)(F.ws + WS_DQ); const bf16* DK = (const bf16*)(F.ws + WS_DK); const bf16* DV = (const bf16*)(F.ws + WS_DV); const float* BG = (const float*)(F.ws + WS_BG);
    float* ODN = (float*)(F.ws + WS_XN) + (size_t)dir * MTOK * 256;
    const int w = F.wave, lane = F.lane;
    float s[8];
#pragma unroll
    for (int i = 0; i < 8; ++i) s[i] = lat ? F.in[I_SDN][((size_t)(((b * 2 + l) * 2 + dir) * 4 + h) * 64 + (8 * w + i)) * 64 + lane] : 0.f;
    for (int c = 0; c < L / 64; ++c) {
        __syncthreads();
        for (int e = F.tid; e < 4096; e += NT) { const int st = e >> 6, d = e & 63; const int step = c * 64 + st, t = dir ? L - 1 - step : step; const size_t r = (size_t)(row0 + t) * 256 + h * 64 + d;
            qs[e] = bf2f(DQ[r]); ks[e] = bf2f(DK[r]); vs[e] = bf2f(DV[r]); }
        if (F.tid < 64) { const int step = c * 64 + F.tid, t = dir ? L - 1 - step : step; const size_t r = (size_t)(row0 + t) * 16;
            bs[F.tid] = BG[r + dir * 4 + h]; gs[F.tid] = __expf(BG[r + 8 + dir * 4 + h]); }
        __syncthreads();
        for (int st = 0; st < 64; ++st) {
            const float a = gs[st], beta = bs[st], vv = vs[st * 64 + lane];
            float kk[8], qq[8];
#pragma unroll
            for (int i = 0; i < 8; ++i) { kk[i] = ks[st * 64 + 8 * w + i]; qq[i] = qs[st * 64 + 8 * w + i]; }
            float part = 0.f;
#pragma unroll
            for (int i = 0; i < 8; ++i) { s[i] *= a; part += s[i] * kk[i]; }
            red1[w * 64 + lane] = part;
            __syncthreads();
            float pred = 0.f;
#pragma unroll
            for (int i = 0; i < 8; ++i) pred += red1[i * 64 + lane];
            const float vn = beta * (vv - pred);
            float po = 0.f;
#pragma unroll
            for (int i = 0; i < 8; ++i) { s[i] += kk[i] * vn; po += s[i] * qq[i]; }
            red2[w * 64 + lane] = po;
            __syncthreads();
            if (w == 0) { float ov = 0.f;
#pragma unroll
                for (int i = 0; i < 8; ++i) ov += red2[i * 64 + lane];
                const int step = c * 64 + st, t = dir ? L - 1 - step : step;
                ODN[(size_t)(row0 + t) * 256 + h * 64 + lane] = ov; }
        }
    }
    if (!lat) {
#pragma unroll
        for (int i = 0; i < 8; ++i) F.out[O_DS + ((size_t)(((b * 2 + l) * 2 + dir) * 4 + h) * 64 + (8 * w + i)) * 64 + lane] = s[i];
    }
    __syncthreads();
}

__device__ __forceinline__ void mixer_phase(Frame& F, int l) {
    for (int task = F.bid; task < 768; task += F.G) {
        int mixer = 0, b = 0, h = 0, qb = 0, seq = -1; bool lat = true;
        if (task < 128) { mixer = 2; b = task >> 4; h = (task >> 2) & 3; qb = task & 3; }
        else if (task < 256) { const int t = task - 128; mixer = 0; b = t >> 4; h = (t >> 2) & 3; qb = t & 3; }
        else if (task < 320) { seq = task - 256; }
        else if (task < 448) { const int t = task - 320; mixer = 1; b = t >> 4; h = (t >> 2) & 3; qb = t & 3; }
        else if (task < 576) { seq = 64 + task - 448; }
        else { const int t = (task - 576) & 63; mixer = (task - 576) >> 6; lat = false; b = t >> 2; h = t & 3; qb = 0; }
        if (seq >= 0) dn_task(F, l, seq); else att_task(F, l, mixer, lat, b, h, qb);
    }
}

__device__ __forceinline__ void dn_combine(Frame& F, int l) {
    const int gw = F.bid * NWAVES + F.wave, NGW = F.G * NWAVES, lane = F.lane;
    const bf16* Z = (const bf16*)(F.ws + WS_Z); bf16* O = (bf16*)(F.ws + WS_O);
    const float* O0 = (const float*)(F.ws + WS_XN); const float* O1 = O0 + (size_t)MTOK * 256;
    const float g = F.in[I_DNOG][l * 64 + lane];
    for (int m = gw; m < MTOK; m += NGW) {
#pragma unroll
        for (int h = 0; h < 4; ++h) {
            const float v = O0[(size_t)m * 256 + h * 64 + lane] + O1[(size_t)m * 256 + h * 64 + lane];
            const float ss = wave_sum(v * v);
            const float y = v * (1.0f / sqrtf(ss * (1.f / 64.f) + 1e-6f)) * g * silu_f(bf2f(Z[(size_t)m * ZP + Z_CG + h * 64 + lane]));
            O[(size_t)m * 1024 + 512 + h * 64 + lane] = (bf16)f2bf(y);
        }
    }
}

constexpr int N_PHASES = 2 + 10 * DEPTH;
__global__ void __launch_bounds__(NT, 2) hybrid_fwd(Args args) {
    extern __shared__ __attribute__((aligned(16))) unsigned char lds_raw[];
    Frame F;
    F.lds = (LAS unsigned char*)lds_raw;
    F.tid = threadIdx.x; F.lane = F.tid & 63; F.wave = __builtin_amdgcn_readfirstlane(F.tid >> 6);
    F.G = gridDim.x; F.bid = blockIdx.x;
    F.in = args.in; F.out = args.out; F.ws = args.ws;
    volatile LAS unsigned* MISC = (volatile LAS unsigned*)(F.lds + MISC_OFF);
    for (int u = F.tid; u < (LDS_BYTES - LDSCTL_OFF) / 4; u += NT) ((LAS unsigned*)(F.lds + LDSCTL_OFF))[u] = 0u;
    __syncthreads();
    XcdBarrier bar; bar.bar = (unsigned*)(F.ws + WS_CTL) + CW_BAR; bar.x = 0; bar.st = nullptr;
#if !MK_PER_PHASE
    bar = xcd_barrier_post((unsigned*)(F.ws + WS_CTL) + CW_BAR, MISC + 8);
#endif
    for (int ph = args.ph_lo; ph < args.ph_hi; ++ph) {
        {
            int tid_ = threadIdx.x, bid_ = blockIdx.x; unsigned char* ws_ = args.ws; float* out_ = args.out;
            asm volatile("" : "+v"(tid_)); asm volatile("" : "+s"(bid_)); asm volatile("" : "+s"(ws_)); asm volatile("" : "+s"(out_));
            F.tid = tid_; F.lane = tid_ & 63; F.wave = __builtin_amdgcn_readfirstlane(tid_ >> 6); F.bid = bid_; F.ws = ws_; F.out = out_;
        }
        const float* mods = (const float*)(F.ws + WS_MODS);
        if (ph == 0) p0a(F);
        else if (ph == 1) norm_rows<0>(F, true, F.in[I_N1G], mods, 0, 1024);
        else {
            const int l = (ph - 2) / 10, sp = (ph - 2) % 10;
            unsigned char* wl = F.ws + WS_W + (size_t)l * W_LAYER;
            const float* mods_l = mods + (size_t)l * 9 * 6144;
            if (sp == 0) {
                pg8::Gemm g{(const bf16*)(F.ws + WS_XN), (const bf16*)(wl + W_IN), MTOK, ZP, 1024}; pg8::StaticOrder S; S.init(MTOK, ZP, F.G, F.bid);
                pg8::EpiBf16 E{(bf16*)(F.ws + WS_Z), ZP};
                pg8::gemm_phase<pg8::EpiBf16, pg8::StaticOrder, true, true>(F.lds, g, S, E, F.tid);
            } else if (sp == 1) prep_phase(F, l);
            else if (sp == 2) {
                { pg8::Gemm g{(const bf16*)(F.ws + WS_QN), (const bf16*)(wl + W_Q), MTOK, 512, 256}; pg8::StaticOrder S; S.init(MTOK, 512, F.G, F.bid);
                  pg8::EpiBf16 E{(bf16*)(F.ws + WS_QM), 512};
                  pg8::gemm_phase<pg8::EpiBf16, pg8::StaticOrder, true, true>(F.lds, g, S, E, F.tid); }
                { pg8::Gemm g{(const bf16*)(F.ws + WS_CKV), (const bf16*)(wl + W_KV), KVROWS, 512, 256}; pg8::StaticOrder S; S.init(KVROWS, 512, F.G, (F.bid + F.G - 96) % F.G);
                  pg8::EpiBf16 E{(bf16*)(F.ws + WS_KV), 512};
                  pg8::gemm_phase<pg8::EpiBf16, pg8::StaticOrder, true, true>(F.lds, g, S, E, F.tid); }
            } else if (sp == 3) mixer_phase(F, l);
            else if (sp == 4) dn_combine(F, l);
            else if (sp == 5) {
                pg8::Gemm g{(const bf16*)(F.ws + WS_O), (const bf16*)(wl + W_OUT), MTOK, 1024, 1024}; pg8::StaticOrder S; S.init(MTOK, 1024, F.G, F.bid);
                pg8::EpiRes E{l == 0 ? F.in[I_XP] : F.out, l == 0 ? F.in[I_XS] : F.out + (size_t)M_CTX * DM, F.out, mods_l + 2 * 1024};
                pg8::gemm_phase<pg8::EpiRes, pg8::StaticOrder, true, true>(F.lds, g, S, E, F.tid);
            } else if (sp == 6) norm_rows<0>(F, false, F.in[I_N2G] + l * 1024, mods_l, 3 * 1024, 4 * 1024);
            else if (sp == 7) {
                pg8::Gemm g{(const bf16*)(F.ws + WS_XN), (const bf16*)(wl + W_GU), MTOK, NGU, 1024}; pg8::StaticOrder S; S.init(MTOK, NGU, F.G, F.bid);
                pg8::EpiSwiglu E{(bf16*)(F.ws + WS_Z), FF};
                pg8::gemm_phase<pg8::EpiSwiglu, pg8::StaticOrder, true, true>(F.lds, g, S, E, F.tid);
            } else if (sp == 8) {
                pg8::Gemm g{(const bf16*)(F.ws + WS_Z), (const bf16*)(wl + W_D), MTOK, 1024, FF}; pg8::StaticOrder S; S.init(MTOK, 1024, F.G, F.bid);
                pg8::EpiRes E{F.out, F.out + (size_t)M_CTX * DM, F.out, mods_l + 5 * 1024};
                pg8::gemm_phase<pg8::EpiRes, pg8::StaticOrder, true, true>(F.lds, g, S, E, F.tid);
            } else {
                if (l + 1 < DEPTH) norm_rows<0>(F, false, F.in[I_N1G] + (l + 1) * 1024, mods_l + 9 * 6144, 0, 1024);
                else norm_rows<1>(F, false, F.in[I_FG], nullptr, 0, 0);
            }
        }
#if !MK_PER_PHASE
        if (ph + 1 < args.ph_hi) xcd_barrier(bar);
#endif
    }
}

extern "C" void kernel_launch(void* const* d_in, const int* in_sizes, int n_in, void* d_out, int out_size, void* d_ws, size_t ws_size, hipStream_t stream) {
    static int grid = 0;
    if (grid == 0) {
        if (n_in != N_IN || out_size != (int)O_END || ws_size < WS_END) { fprintf(stderr, "kernel_launch: unexpected shapes: n_in %d out %d ws %zu\n", n_in, out_size, ws_size); grid = -1; return; }
        int dev = 0, cus = 0, per_cu = 0;
        if (hipGetDevice(&dev) != hipSuccess || hipDeviceGetAttribute(&cus, hipDeviceAttributeMultiprocessorCount, dev) != hipSuccess) { grid = -1; return; }
        if (hipFuncSetAttribute((const void*)hybrid_fwd, hipFuncAttributeMaxDynamicSharedMemorySize, LDS_BYTES) != hipSuccess) { fprintf(stderr, "kernel_launch: hipFuncSetAttribute failed\n"); grid = -1; return; }
        if (hipOccupancyMaxActiveBlocksPerMultiprocessor(&per_cu, (const void*)hybrid_fwd, NT, LDS_BYTES) != hipSuccess || per_cu < 1) { fprintf(stderr, "kernel_launch: occupancy query says %d\n", per_cu); }
        (void)hipGetLastError();
        grid = cus;
    }
    if (grid < 0) return;
    (void)hipMemsetAsync((char*)d_ws + WS_CTL, 0, CTL_ZERO_BYTES, stream);
    Args a{};
    for (int i = 0; i < N_IN; ++i) a.in[i] = (const float*)d_in[i];
    a.out = (float*)d_out; a.ws = (unsigned char*)d_ws;
#if MK_PER_PHASE
    for (int ph = 0; ph < N_PHASES; ++ph) { a.ph_lo = ph; a.ph_hi = ph + 1; hipLaunchKernelGGL(hybrid_fwd, dim3(grid), dim3(NT), LDS_BYTES, stream, a); }
#else
    a.ph_lo = 0; a.ph_hi = N_PHASES;
    void* kargs[] = {&a};
    hipError_t e = hipLaunchCooperativeKernel((const void*)hybrid_fwd, dim3(grid), dim3(NT), kargs, LDS_BYTES, stream);
    if (e != hipSuccess) fprintf(stderr, "kernel_launch: cooperative launch failed: %s (grid %d)\n", hipGetErrorString(e), grid);
#endif
}
```

```cpp
#include <hip/hip_runtime.h>
#include <cstdio>
#include <cstdint>

#ifndef MK_PER_PHASE
#define MK_PER_PHASE 0
#endif

namespace pg8 {
#define PG8_LAS __attribute__((address_space(3)))
typedef unsigned short bf16_t;
typedef short bf16x8 __attribute__((ext_vector_type(8)));
typedef float f32x4 __attribute__((ext_vector_type(4)));
typedef unsigned u32x4 __attribute__((ext_vector_type(4)));
typedef unsigned u32x2 __attribute__((ext_vector_type(2)));
constexpr int BM = 256, BK = 64, HALF = 128, HTB = HALF * BK * 2, STAGE_BYTES = 8 * HTB, NXCD = 8, WGM = 8;

__host__ __device__ __forceinline__ int lds_byte(int r, int c) { const int st = (r >> 4) * 2 + (c >> 5), rr = r & 15, cc = c & 31, ob = rr * 64 + cc * 2; return st * 1024 + (ob ^ (((ob >> 9) & 1) << 5)); }
__host__ __device__ __forceinline__ void stage_rc(int b, int& R, int& C) { const int st = b / 1024, sb = b % 1024, swz = sb ^ (((sb >> 9) & 1) << 5); R = (st >> 1) * 16 + swz / 64; C = (st & 1) * 32 + (swz % 64) / 2; }
__host__ __device__ __forceinline__ int perm32(int rho) { const int n = rho >> 4, i = rho & 15; return 8 * (i >> 2) + 4 * n + (i & 3); }

struct Unit { int pm, pn; };
struct Gemm { const bf16_t* A; const bf16_t* Bt; int M, N, K; };

struct StaticOrder {
    int nM, nN, nwg, G, c;
    __host__ __device__ void init(int M, int N, int G_, int c_) { nM = M / BM; nN = N / BM; nwg = nM * nN; G = G_; c = c_; }
    __host__ __device__ bool next(int i, Unit& u) const {
        const long L = (long)i * G + c; if (L >= nwg) return false;
        int wgid = (int)L; { const int q = nwg / NXCD, r = nwg % NXCD, xcd = wgid % NXCD, off = wgid / NXCD; wgid = (xcd < r ? xcd * (q + 1) : r * (q + 1) + (xcd - r) * q) + off; }
        const int nig = WGM * nN, gid = wgid / nig, fm = gid * WGM, gsz = (nM - fm) < WGM ? (nM - fm) : WGM;
        u.pm = fm + ((wgid % nig) % gsz); u.pn = (wgid % nig) / gsz; return true;
    }
    __device__ __forceinline__ void a_ready(const Unit&) const {}
    __device__ __forceinline__ void done(const Unit&) const {}
};

__device__ __forceinline__ unsigned cvt_pk_bf16(float lo, float hi) { unsigned r; asm volatile("v_cvt_pk_bf16_f32 %0, %1, %2" : "=v"(r) : "v"(lo), "v"(hi)); return r; }

struct EpiBf16 {
    static constexpr bool PERM = true, AFTER_DRAIN = false;
    bf16_t* O; int ldc;
    __device__ __forceinline__ void operator()(const f32x4 (&acc)[2][2][4][2], const Unit& u, int wr, int wc, int fr, int fq) const {
        const int row0 = u.pm * BM + wr * 64 + fr; const int col0 = u.pn * BM + wc * 32 + 8 * fq;
#pragma unroll
        for (int ai = 0; ai < 2; ++ai)
#pragma unroll
            for (int m = 0; m < 4; ++m) { bf16_t* rowp = O + (size_t)(row0 + ai * HALF + m * 16) * ldc + col0;
#pragma unroll
                for (int bj = 0; bj < 2; ++bj) { const f32x4 v0 = acc[ai][bj][m][0], v1 = acc[ai][bj][m][1];
                    u32x4 w; w.x = cvt_pk_bf16(v0[0], v0[1]); w.y = cvt_pk_bf16(v0[2], v0[3]); w.z = cvt_pk_bf16(v1[0], v1[1]); w.w = cvt_pk_bf16(v1[2], v1[3]);
                    *(u32x4*)(rowp + bj * HALF) = w; } }
    }
};
struct EpiSwiglu {
    static constexpr bool PERM = true, AFTER_DRAIN = false;
    bf16_t* O; int ldc;
    __device__ __forceinline__ static float sw(float g, float u) { return g * u / (1.0f + __expf(-g)); }
    __device__ __forceinline__ void operator()(const f32x4 (&acc)[2][2][4][2], const Unit& u, int wr, int wc, int fr, int fq) const {
        const int row0 = u.pm * BM + wr * 64 + fr; const int col0 = (u.pn * BM + wc * 32 + 8 * fq) >> 1;
#pragma unroll
        for (int ai = 0; ai < 2; ++ai)
#pragma unroll
            for (int m = 0; m < 4; ++m) { bf16_t* rowp = O + (size_t)(row0 + ai * HALF + m * 16) * ldc + col0;
#pragma unroll
                for (int bj = 0; bj < 2; ++bj) { const f32x4 v0 = acc[ai][bj][m][0], v1 = acc[ai][bj][m][1];
                    u32x2 w; w.x = cvt_pk_bf16(sw(v0[0], v0[1]), sw(v0[2], v0[3])); w.y = cvt_pk_bf16(sw(v1[0], v1[1]), sw(v1[2], v1[3]));
                    *(u32x2*)(rowp + bj * (HALF / 2)) = w; } }
    }
};
struct EpiRes {
    static constexpr bool PERM = false, AFTER_DRAIN = false;
    const float* base_a; const float* base_b; float* out; const float* gate;
    __device__ __forceinline__ void operator()(const f32x4 (&acc)[2][2][4][2], const Unit& u, int wr, int wc, int fr, int fq) const {
        const int col0 = u.pn * BM + wc * 32 + 4 * fq;
        const int rmod = u.pm < 16 ? 0 : 1 + ((u.pm - 16) >> 2);
        const float* g = gate + (size_t)rmod * 6144 + col0;
        const float* bp = u.pm < 16 ? base_a + (size_t)u.pm * BM * 1024 : base_b + (size_t)(u.pm - 16) * BM * 1024;
        float* op = out + (size_t)u.pm * BM * 1024;
        f32x4 gv[2][2];
#pragma unroll
        for (int bj = 0; bj < 2; ++bj)
#pragma unroll
            for (int n = 0; n < 2; ++n) gv[bj][n] = *(const f32x4*)(g + bj * HALF + n * 16);
#pragma unroll
        for (int ai = 0; ai < 2; ++ai)
#pragma unroll
            for (int m = 0; m < 4; ++m) { const size_t off = (size_t)(ai * HALF + wr * 64 + m * 16 + fr) * 1024 + col0;
#pragma unroll
                for (int bj = 0; bj < 2; ++bj)
#pragma unroll
                    for (int n = 0; n < 2; ++n) { const f32x4 bs = *(const f32x4*)(bp + off + bj * HALF + n * 16);
                        *(f32x4*)(op + off + bj * HALF + n * 16) = bs + gv[bj][n] * acc[ai][bj][m][n]; } }
    }
};

template <class Epi, class Sched, bool ALIGN_EPI = false, bool SP2 = false>
__device__ __forceinline__ void gemm_phase(PG8_LAS unsigned char* lds, const Gemm g, const Sched& S, const Epi& E, const int tid) {
    const int wid = __builtin_amdgcn_readfirstlane(tid >> 6), lane = tid & 63, wr = wid >> 2, wc = wid & 3, fr = lane & 15, fq = lane >> 4;
    const int K = g.K, nt = K / BK;
    unsigned voffA[2], voffB[2];
#pragma unroll
    for (int i = 0; i < 2; ++i) { int R, C; stage_rc(tid * 16 + i * 8192, R, C); const int Rb = Epi::PERM ? ((R & ~31) + perm32(R & 31)) : R;
        voffA[i] = (unsigned)(R * K + C) * 2u; voffB[i] = (unsigned)(Rb * K + C) * 2u; }
    const size_t kstep = (size_t)(BK * 2);
    const size_t hstep = (size_t)HALF * K * 2;
    const size_t tstep = 2 * hstep;
    const unsigned ldsw = (unsigned)wid * 1024u;
    const int aoff = lds_byte(wr * 64 + fr, fq * 8), boff = lds_byte(wc * 32 + fr, fq * 8);
#define PG8_SA(b, h) (((b) * 2 + (h)) * HTB)
#define PG8_SB(b, h) ((4 + (b) * 2 + (h)) * HTB)
#define PG8_STAGE(bufoff, gbase, voff) do { _Pragma("unroll") for (int _i = 0; _i < 2; ++_i) \
        __builtin_amdgcn_global_load_lds((const unsigned*)((const char*)(gbase) + (voff)[_i]), (PG8_LAS unsigned*)(lds + (bufoff) + ldsw + _i * 8192), 16, 0, 0); } while (0)
#define PG8_LDA(dst, b, h) do { _Pragma("unroll") for (int m = 0; m < 4; ++m) _Pragma("unroll") for (int k = 0; k < 2; ++k) dst[m][k] = *(const PG8_LAS bf16x8*)(lds + PG8_SA(b, h) + aoff + m * 2048 + k * 1024); } while (0)
#define PG8_LDB(dst, b, h) do { _Pragma("unroll") for (int n = 0; n < 2; ++n) _Pragma("unroll") for (int k = 0; k < 2; ++k) dst[n][k] = *(const PG8_LAS bf16x8*)(lds + PG8_SB(b, h) + boff + n * 2048 + k * 1024); } while (0)
#define PG8_MMA(ai, bj, At, Bt) do { __builtin_amdgcn_s_setprio(1); _Pragma("unroll") for (int m = 0; m < 4; ++m) _Pragma("unroll") for (int n = 0; n < 2; ++n) _Pragma("unroll") for (int k = 0; k < 2; ++k) \
        acc[ai][bj][m][n] = __builtin_amdgcn_mfma_f32_16x16x32_bf16(Bt[n][k], At[m][k], acc[ai][bj][m][n], 0, 0, 0); __builtin_amdgcn_s_setprio(0); } while (0)
#define PG8_WAIT_V(n) asm volatile("s_waitcnt vmcnt(" #n ")" ::: "memory")
#define PG8_WAIT_L(n) asm volatile("s_waitcnt lgkmcnt(" #n ")" ::: "memory")
#define PG8_BAR __builtin_amdgcn_s_barrier()
#define PG8_SCHED __builtin_amdgcn_sched_barrier(0)
    Unit cur, nxt; int ui = 0;
    if (!S.next(0, cur)) return;
    f32x4 acc[2][2][4][2];
#pragma unroll
    for (int a = 0; a < 2; ++a)
#pragma unroll
        for (int b = 0; b < 2; ++b)
#pragma unroll
            for (int m = 0; m < 4; ++m)
#pragma unroll
                for (int n = 0; n < 2; ++n) acc[a][b][m][n] = (f32x4){0.f, 0.f, 0.f, 0.f};
    bf16x8 At[4][2], B0[2][2], B1[2][2];
    const char* cA = (const char*)g.A + (size_t)cur.pm * tstep; const char* cB = (const char*)g.Bt + (size_t)cur.pn * tstep;
    S.a_ready(cur);
    if constexpr (SP2) {
        PG8_STAGE(PG8_SB(0, 0), cB, voffB); PG8_STAGE(PG8_SB(0, 1), cB + hstep, voffB); PG8_STAGE(PG8_SA(0, 0), cA, voffA); PG8_STAGE(PG8_SA(0, 1), cA + hstep, voffA);
        if (wr == 1) PG8_BAR;
        PG8_WAIT_V(2); PG8_BAR;
        PG8_STAGE(PG8_SB(1, 0), cB + kstep, voffB); PG8_STAGE(PG8_SA(1, 0), cA + kstep, voffA); PG8_STAGE(PG8_SB(1, 1), cB + hstep + kstep, voffB);
        PG8_WAIT_V(6); PG8_BAR;
    } else {
        PG8_STAGE(PG8_SB(0, 0), cB, voffB); PG8_STAGE(PG8_SA(0, 0), cA, voffA); PG8_STAGE(PG8_SB(0, 1), cB + hstep, voffB); PG8_STAGE(PG8_SA(0, 1), cA + hstep, voffA);
        if (wr == 1) PG8_BAR;
        PG8_WAIT_V(4); PG8_BAR;
        PG8_STAGE(PG8_SB(1, 0), cB + kstep, voffB); PG8_STAGE(PG8_SA(1, 0), cA + kstep, voffA); PG8_STAGE(PG8_SB(1, 1), cB + hstep + kstep, voffB);
        PG8_WAIT_V(6); PG8_BAR;
    }
    for (;;) {
        const bool has_next = S.next(ui + 1, nxt);
        const char* nA = has_next ? (const char*)g.A + (size_t)nxt.pm * tstep : cA; const char* nB = has_next ? (const char*)g.Bt + (size_t)nxt.pn * tstep : cB;
        for (int t = 0; t < nt; t += 2) {
            const bool last = (t == nt - 2);
            const char* a1 = cA + (size_t)(t + 1) * kstep;
            const char* a2 = last ? nA : cA + (size_t)(t + 2) * kstep; const char* b2 = last ? nB : cB + (size_t)(t + 2) * kstep;
            const char* a3 = a2 + kstep; const char* b3 = b2 + kstep;
            if (last && has_next) S.a_ready(nxt);
            if constexpr (SP2) {
            PG8_LDB(B0, 0, 0); PG8_LDB(B1, 0, 1); PG8_SCHED; PG8_LDA(At, 0, 0); PG8_STAGE(PG8_SA(1, 1), a1 + hstep, voffA);
            PG8_WAIT_V(8); PG8_WAIT_L(0); PG8_BAR; PG8_MMA(0, 0, At, B0); PG8_MMA(0, 1, At, B1); PG8_BAR; PG8_SCHED;
            PG8_LDA(At, 0, 1); PG8_STAGE(PG8_SB(0, 0), b2, voffB); PG8_STAGE(PG8_SB(0, 1), b2 + hstep, voffB); PG8_STAGE(PG8_SA(0, 0), a2, voffA);
            PG8_WAIT_V(8); PG8_WAIT_L(0); PG8_BAR; PG8_MMA(1, 0, At, B0); PG8_MMA(1, 1, At, B1); PG8_BAR; PG8_SCHED;
            PG8_LDB(B0, 1, 0); PG8_LDB(B1, 1, 1); PG8_SCHED; PG8_LDA(At, 1, 0); PG8_STAGE(PG8_SA(0, 1), a2 + hstep, voffA);
            PG8_WAIT_V(8); PG8_WAIT_L(0); PG8_BAR; PG8_MMA(0, 0, At, B0); PG8_MMA(0, 1, At, B1); PG8_BAR; PG8_SCHED;
            PG8_LDA(At, 1, 1); PG8_STAGE(PG8_SB(1, 0), b3, voffB); PG8_STAGE(PG8_SB(1, 1), b3 + hstep, voffB); PG8_STAGE(PG8_SA(1, 0), a3, voffA);
            PG8_WAIT_V(8); PG8_WAIT_L(0); PG8_BAR; PG8_MMA(1, 0, At, B0); PG8_MMA(1, 1, At, B1); PG8_BAR; PG8_SCHED;
            } else {
            PG8_LDB(B0, 0, 0); PG8_SCHED; PG8_LDA(At, 0, 0); PG8_STAGE(PG8_SA(1, 1), a1 + hstep, voffA);
            PG8_WAIT_L(8); PG8_BAR; PG8_WAIT_L(0); PG8_MMA(0, 0, At, B0); PG8_BAR; PG8_SCHED;
            PG8_LDB(B1, 0, 1); PG8_STAGE(PG8_SB(0, 0), b2, voffB);
            PG8_BAR; PG8_WAIT_L(0); PG8_MMA(0, 1, At, B1); PG8_BAR;
            PG8_LDA(At, 0, 1); PG8_STAGE(PG8_SA(0, 0), a2, voffA);
            PG8_BAR; PG8_WAIT_L(0); PG8_MMA(1, 0, At, B0); PG8_BAR; PG8_SCHED;
            PG8_STAGE(PG8_SB(0, 1), b2 + hstep, voffB);
            PG8_WAIT_V(6); PG8_BAR; PG8_MMA(1, 1, At, B1); PG8_BAR;
            PG8_LDB(B0, 1, 0); PG8_SCHED; PG8_LDA(At, 1, 0); PG8_STAGE(PG8_SA(0, 1), a2 + hstep, voffA);
            PG8_WAIT_L(8); PG8_BAR; PG8_WAIT_L(0); PG8_MMA(0, 0, At, B0); PG8_BAR; PG8_SCHED;
            PG8_LDB(B1, 1, 1); PG8_STAGE(PG8_SB(1, 0), b3, voffB);
            PG8_BAR; PG8_WAIT_L(0); PG8_MMA(0, 1, At, B1); PG8_BAR;
            PG8_LDA(At, 1, 1); PG8_STAGE(PG8_SA(1, 0), a3, voffA);
            PG8_BAR; PG8_WAIT_L(0); PG8_MMA(1, 0, At, B0); PG8_BAR; PG8_SCHED;
            PG8_STAGE(PG8_SB(1, 1), b3 + hstep, voffB);
            PG8_WAIT_V(6); PG8_BAR; PG8_MMA(1, 1, At, B1); PG8_BAR;
            }
        }
        if constexpr (ALIGN_EPI) { if (wr == 0) PG8_BAR; }
        if constexpr (!Epi::AFTER_DRAIN) { E(acc, cur, wr, wc, fr, fq); S.done(cur); }
        if (!has_next) break;
#pragma unroll
        for (int a = 0; a < 2; ++a)
#pragma unroll
            for (int b = 0; b < 2; ++b)
#pragma unroll
                for (int m = 0; m < 4; ++m)
#pragma unroll
                    for (int n = 0; n < 2; ++n) acc[a][b][m][n] = (f32x4){0.f, 0.f, 0.f, 0.f};
        cur = nxt; cA = nA; cB = nB; ++ui;
        if constexpr (ALIGN_EPI) { if (wr == 1) PG8_BAR; }
    }
    PG8_WAIT_V(0);
    if constexpr (!ALIGN_EPI) { if (wr == 0) PG8_BAR; }
    PG8_BAR;
#undef PG8_SA
#undef PG8_SB
#undef PG8_STAGE
#undef PG8_LDA
#undef PG8_LDB
#undef PG8_MMA
#undef PG8_WAIT_V
#undef PG8_WAIT_L
#undef PG8_BAR
#undef PG8_SCHED
}
}

constexpr int NWAVES = 8, NT = 512;
constexpr int DM = 1024, M_CTX = 4096, M_LAT = 8192, MTOK = 12288, DEPTH = 2;
constexpr int ZP = 2816, FF = 2816, NGU = 5632, IN_COLS = 2736;
constexpr int Z_AQ = 0, Z_AK = 256, Z_AV = 384, Z_BQ = 512, Z_BK = 768, Z_BV = 1024, Z_CQKV = 1280, Z_CG = 2048, Z_CA = 2304, Z_CB = 2312, Z_DCQ = 2320, Z_DCKV = 2576, Z_DKR = 2704;
constexpr int NCACHE = 4096;
constexpr int KVROWS = MTOK + NCACHE;
constexpr float LOG2E = 1.4426950408889634f;
constexpr float MLA_SCALE = 0.10206207261596577f;
enum { I_XP = 0, I_XS, I_CGK, I_CGV, I_CNK, I_CNV, I_SDN, I_CCKV, I_CKR, I_C, I_CCTX, I_N1G, I_N2G, I_WMOD, I_BMOD, I_WIN, I_WOUT, I_QNG, I_KNG, I_NAB,
       I_CONV, I_ALOG, I_DTB, I_DNOG, I_MQNG, I_WQUP, I_MKVNG, I_WKVUP, I_WG, I_WU, I_WD, I_FG, N_IN };
constexpr size_t O_YP = 0, O_YS = 4194304, O_GK = 12582912, O_GV = 13631488, O_NK = 14680064, O_NV = 16777216, O_DS = 18874368, O_CKV = 19922944, O_KR = 20971520, O_END = 21233664;

constexpr size_t MiB = 1u << 20;
constexpr size_t WS_CTL = 0, CTL_ZERO_BYTES = 1 * MiB;
constexpr size_t WS_MODS = 1 * MiB;
constexpr size_t WS_ROPE = 1 * MiB + 512 * 1024;
constexpr size_t WS_W = 2 * MiB;
constexpr size_t W_IN = 0, W_OUT = W_IN + (size_t)ZP * 1024 * 2, W_GU = W_OUT + (size_t)1024 * 1024 * 2, W_D = W_GU + (size_t)NGU * 1024 * 2,
                 W_Q = W_D + (size_t)1024 * FF * 2, W_KV = W_Q + (size_t)512 * 256 * 2, W_LEND = W_KV + (size_t)512 * 256 * 2;
static_assert(W_LEND <= 25 * MiB, "weights per layer");
constexpr size_t WS_XN = 27 * MiB;
constexpr size_t WS_UT = 27 * MiB, WS_WN = 39 * MiB;
constexpr size_t WS_Z = 51 * MiB;
constexpr size_t WS_O = 117 * MiB;
constexpr size_t WS_QA = 141 * MiB, WS_KA = 147 * MiB, WS_VA = 151 * MiB;
constexpr size_t WS_DQ = 155 * MiB, WS_DK = 161 * MiB, WS_DV = 167 * MiB;
constexpr size_t WS_BG = 173 * MiB;
constexpr size_t WS_QN = 174 * MiB;
constexpr size_t WS_CKV = 180 * MiB;
constexpr size_t WS_KR = 188 * MiB;
constexpr size_t WS_QM = 189 * MiB;
constexpr size_t WS_KV = 201 * MiB;
constexpr size_t WS_NKB = 217 * MiB, WS_NVB = 219 * MiB;
constexpr size_t WS_ODN = 221 * MiB;
constexpr size_t WS_QKG = 233 * MiB;
constexpr size_t WS_KT = 245 * MiB;
constexpr size_t WS_GC = 251 * MiB;
constexpr size_t WS_END = 252 * MiB;
constexpr int CW_BAR = 4096;

constexpr int RING_BYTES = 131072, LDSCTL_OFF = RING_BYTES, MISC_OFF = LDSCTL_OFF + 320, LDS_BYTES = 147456;

#define GAS __attribute__((address_space(1)))
#define LAS __attribute__((address_space(3)))
typedef unsigned short bf16;
typedef unsigned v4u __attribute__((ext_vector_type(4)));
typedef unsigned v2u __attribute__((ext_vector_type(2)));
typedef float f32x4 __attribute__((ext_vector_type(4)));
__device__ __forceinline__ unsigned f2bf(float f) { unsigned u = __builtin_bit_cast(unsigned, f); return (u + 0x7fffu + ((u >> 16) & 1u)) >> 16; }
__device__ __forceinline__ unsigned pk2(float lo, float hi) { return f2bf(lo) | (f2bf(hi) << 16); }
__device__ __forceinline__ float bf2f(bf16 h) { return __uint_as_float((unsigned)h << 16); }
__device__ __forceinline__ float bflo(unsigned u) { return __uint_as_float(u << 16); }
__device__ __forceinline__ float bfhi(unsigned u) { return __uint_as_float(u & 0xffff0000u); }
#define LDS_WAIT() asm volatile("s_waitcnt lgkmcnt(0)" ::: "memory")

#define XB_TMO      128
#define XB_XCNT(j)  (256  + 64 * (j))
#define XB_XSUB(j)  (1280 + 64 * (j))
#define XB_XGEN(j)  (2304 + 64 * (j))
#define XB_TOP      3328
#define XB_TOPGEN   3392
#define XCD_BAR_WORDS 3456
#define XB_SPIN_CAP (1u << 18)
__device__ __forceinline__ unsigned xb_ld(unsigned* p)              { return __hip_atomic_load(p, __ATOMIC_RELAXED, __HIP_MEMORY_SCOPE_AGENT); }
__device__ __forceinline__ unsigned xb_add(unsigned* p, unsigned v) { return __hip_atomic_fetch_add(p, v, __ATOMIC_RELAXED, __HIP_MEMORY_SCOPE_AGENT); }
__device__ __forceinline__ unsigned xb_xcc_id() { return (unsigned)__builtin_amdgcn_s_getreg((3 << 11) | 20) & 0xFu; }
#define XB_SPIN(cond, bar) do { unsigned _sp = 0; while (cond) { __builtin_amdgcn_s_sleep(1); \
    if ((++_sp & 255u) == 0u) { if (xb_ld(&(bar)[XB_TMO])) break; if (_sp > XB_SPIN_CAP) { atomicAdd(&(bar)[XB_TMO], 1u); break; } } } } while (0)
struct XcdBarrier { unsigned* bar; unsigned x; volatile LAS unsigned* st; };
__device__ __forceinline__ XcdBarrier xcd_barrier_post(unsigned* bar, volatile LAS unsigned* st) {
    XcdBarrier b; b.bar = bar; b.x = xb_xcc_id(); b.st = st;
    if (threadIdx.x == 0) (void)xb_add(&bar[XB_XCNT(b.x)], 1u);
    return b;
}
__device__ __forceinline__ void xcd_barrier_complete(unsigned* bar, unsigned x, unsigned& nloc, unsigned& nx) {
    const unsigned G = gridDim.x * gridDim.y * gridDim.z;
    unsigned sum, cnt, mine, sp = 0u;
    for (;;) {
        sum = 0u; cnt = 0u; mine = 0u;
#pragma unroll
        for (unsigned j = 0; j < 16; ++j) { const unsigned c = xb_ld(&bar[XB_XCNT(j)]); sum += c; cnt += (c > 0u) ? 1u : 0u; mine = (j == x) ? c : mine; }
        if (sum == G) break;
        __builtin_amdgcn_s_sleep(1);
        if ((++sp & 255u) == 0u) { if (xb_ld(&bar[XB_TMO])) break; if (sp > XB_SPIN_CAP) { atomicAdd(&bar[XB_TMO], 1u); break; } }
    }
    nloc = mine > 0u ? mine : 1u; nx = cnt > 0u ? cnt : 1u;
}
__device__ __forceinline__ void xcd_barrier(const XcdBarrier& b) {
    asm volatile("s_waitcnt vmcnt(0)" ::: "memory");
    __syncthreads();
    if (threadIdx.x == 0) {
        unsigned* bar = b.bar;
        __builtin_amdgcn_s_waitcnt(0);
        unsigned nloc = b.st[0], nx = b.st[1];
        if (nloc == 0u) { xcd_barrier_complete(bar, b.x, nloc, nx); b.st[0] = nloc; b.st[1] = nx; }
        const unsigned old = xb_add(&bar[XB_XSUB(b.x)], 1u);
        const unsigned gen = old / nloc;
        if (old + 1u == (gen + 1u) * nloc) {
            __builtin_amdgcn_fence(__ATOMIC_RELEASE, "agent");
            asm volatile("s_waitcnt vmcnt(0)" ::: "memory");
            const unsigned og = xb_add(&bar[XB_TOP], 1u);
            const unsigned tg = og / nx;
            if (og + 1u == (tg + 1u) * nx) xb_add(&bar[XB_TOPGEN], 1u);
            else XB_SPIN(xb_ld(&bar[XB_TOPGEN]) == tg, bar);
            __builtin_amdgcn_fence(__ATOMIC_ACQUIRE, "agent");
            xb_add(&bar[XB_XGEN(b.x)], 1u);
            asm volatile("s_waitcnt vmcnt(0)" ::: "memory");
        } else {
            XB_SPIN(xb_ld(&bar[XB_XGEN(b.x)]) == gen, bar);
            __builtin_amdgcn_fence(__ATOMIC_ACQUIRE, "agent");
            asm volatile("s_waitcnt vmcnt(0)" ::: "memory");
        }
    }
    __syncthreads();
}

struct Args { const float* in[N_IN]; float* out; unsigned char* ws; int ph_lo, ph_hi; };
struct Frame {
    LAS unsigned char* lds;
    int tid, lane, wave, G, bid;
    const float* const* in; float* out; unsigned char* ws;
};
__device__ __forceinline__ float wave_sum(float v) {
#pragma unroll
    for (int o = 1; o < 64; o <<= 1) v += __shfl_xor(v, o);
    return v;
}
__device__ __forceinline__ float silu_f(float x) { return x / (1.0f + __expf(-x)); }

__device__ __forceinline__ void p0_transpose_item(const float* W, int K, int Nsrc, int Npad, int KP, bf16* WT, int row_off, int rmul, LAS float* scr, int item, int lane) {
    const int nblk = Npad / 32, kb = item / nblk, nb = item % nblk, k0 = 64 * kb, n0 = 32 * nb;
    const int nn = n0 + (lane & 31);
#pragma unroll 8
    for (int i = 0; i < 32; ++i) { const int kk = 2 * i + (lane >> 5); scr[kk * 33 + (lane & 31)] = (nn < Nsrc && (k0 + kk) < K) ? W[(size_t)(k0 + kk) * Nsrc + nn] : 0.f; }
    LDS_WAIT(); asm volatile("" ::: "memory");
    const int c = lane & 7;
#pragma unroll
    for (int j = 0; j < 4; ++j) { const int n = (lane >> 3) + 8 * j; const LAS float* s = scr + (8 * c) * 33 + n;
        v4u o; o.x = pk2(s[0 * 33], s[1 * 33]); o.y = pk2(s[2 * 33], s[3 * 33]); o.z = pk2(s[4 * 33], s[5 * 33]); o.w = pk2(s[6 * 33], s[7 * 33]);
        *(v4u*)(WT + (size_t)(row_off + rmul * (n0 + n)) * KP + k0 + 8 * c) = o; }
    LDS_WAIT(); asm volatile("" ::: "memory");
}
__device__ __forceinline__ void p0a(Frame& F) {
    {
        LAS float* sc = (LAS float*)(F.lds);
        LAS float* part = (LAS float*)(F.lds + 9 * 1024 * 4);
        for (int e = F.tid; e < 9 * 1024; e += NT) { const int r = e >> 10, k = e & 1023; const float c = (r == 0) ? F.in[I_CCTX][k] : F.in[I_C][(r - 1) * 1024 + k]; sc[e] = silu_f(c); }
        __syncthreads();
        for (int it = F.bid; it < 2 * 96; it += F.G) {
            const int l = it / 96, n0 = (it % 96) * 64;
            const float* w = F.in[I_WMOD] + (size_t)l * 1024 * 6144 + n0 + F.lane;
            float acc[9];
#pragma unroll
            for (int r = 0; r < 9; ++r) acc[r] = 0.f;
            const int kb = F.wave * 128;
#pragma unroll 8
            for (int k = 0; k < 128; ++k) { const float wv = w[(size_t)(kb + k) * 6144];
#pragma unroll
                for (int r = 0; r < 9; ++r) acc[r] += sc[r * 1024 + kb + k] * wv; }
#pragma unroll
            for (int r = 0; r < 9; ++r) part[(F.wave * 9 + r) * 64 + F.lane] = acc[r];
            __syncthreads();
            for (int e = F.tid; e < 9 * 64; e += NT) { const int r = e >> 6, c = e & 63; float s = 0.f;
#pragma unroll
                for (int w8 = 0; w8 < 8; ++w8) s += part[(w8 * 9 + r) * 64 + c];
                ((float*)(F.ws + WS_MODS))[(size_t)(l * 9 + r) * 6144 + n0 + c] = s + F.in[I_BMOD][l * 6144 + n0 + c]; }
            __syncthreads();
        }
    }
    if (F.bid == F.G - 1) {
        float* tab = (float*)(F.ws + WS_ROPE);
        for (int e = F.tid; e < 64 * 16 + 64 * 8; e += NT) {
            int pos, i, half; float* dst;
            if (e < 1024) { pos = e >> 4; i = e & 15; half = 16; dst = tab + 2 * e; } else { const int e2 = e - 1024; pos = e2 >> 3; i = e2 & 7; half = 8; dst = tab + 2048 + 2 * e2; }
            const float inv = exp2f(-(float)i / (float)half * 13.287712379549449f);
            const float ang = (float)pos * inv;
            const double twopi = 6.283185307179586476925; const double a = (double)ang; const double kq = __builtin_rint(a / twopi); const float rr = (float)(a - kq * twopi);
            dst[0] = __builtin_cosf(rr); dst[1] = __builtin_sinf(rr);
        }
    }
    __syncthreads();
}
__device__ __forceinline__ void convert_weights(Frame& F, int l) {
    LAS float* scr = (LAS float*)(F.lds + F.wave * 16384);
    const int gw = F.bid * NWAVES + F.wave, NGW = F.G * NWAVES;
    constexpr int I_IN = 16 * 88, I_OUT = 16 * 32, I_G = 16 * 88, I_U = 16 * 88, I_D = 44 * 32, I_Q = 4 * 16, I_KV = 4 * 16;
    constexpr int PER_L = I_IN + I_OUT + I_G + I_U + I_D + I_Q + I_KV;
    unsigned char* wl = F.ws + WS_W;
    for (int it = gw; it < PER_L; it += NGW) {
        int r = it;
        if (r < I_IN) { p0_transpose_item(F.in[I_WIN] + (size_t)l * 1024 * IN_COLS, 1024, IN_COLS, ZP, 1024, (bf16*)(wl + W_IN), 0, 1, scr, r, F.lane); continue; } r -= I_IN;
        if (r < I_OUT) { p0_transpose_item(F.in[I_WOUT] + (size_t)l * 1024 * 1024, 1024, 1024, 1024, 1024, (bf16*)(wl + W_OUT), 0, 1, scr, r, F.lane); continue; } r -= I_OUT;
        if (r < I_G) { p0_transpose_item(F.in[I_WG] + (size_t)l * 1024 * FF, 1024, FF, FF, 1024, (bf16*)(wl + W_GU), 0, 2, scr, r, F.lane); continue; } r -= I_G;
        if (r < I_U) { p0_transpose_item(F.in[I_WU] + (size_t)l * 1024 * FF, 1024, FF, FF, 1024, (bf16*)(wl + W_GU), 1, 2, scr, r, F.lane); continue; } r -= I_U;
        if (r < I_D) { p0_transpose_item(F.in[I_WD] + (size_t)l * FF * 1024, FF, 1024, 1024, FF, (bf16*)(wl + W_D), 0, 1, scr, r, F.lane); continue; } r -= I_D;
        if (r < I_Q) { p0_transpose_item(F.in[I_WQUP] + (size_t)l * 256 * 384, 256, 384, 512, 256, (bf16*)(wl + W_Q), 0, 1, scr, r, F.lane); continue; } r -= I_Q;
        p0_transpose_item(F.in[I_WKVUP] + (size_t)l * 128 * 512, 128, 512, 512, 256, (bf16*)(wl + W_KV), 0, 1, scr, r, F.lane);
    }
}

__device__ __forceinline__ const float* xrow_ptr(Frame& F, int m, bool from_in) {
    if (from_in) return m < M_CTX ? F.in[I_XP] + (size_t)m * DM : F.in[I_XS] + (size_t)(m - M_CTX) * DM;
    return F.out + (size_t)m * DM;
}
template <int MODE> __device__ __forceinline__ void norm_rows(Frame& F, bool from_in, const float* g, const float* mods_l  , int sh_off, int sc_off) {
    const int gw = F.bid * NWAVES + F.wave, NGW = F.G * NWAVES;
    for (int m = gw; m < MTOK; m += NGW) {
        const f32x4* xr = (const f32x4*)xrow_ptr(F, m, from_in) + F.lane;
        f32x4 v[4]; float s = 0.f;
#pragma unroll
        for (int j = 0; j < 4; ++j) { v[j] = xr[64 * j]; s += (v[j].x * v[j].x + v[j].y * v[j].y) + (v[j].z * v[j].z + v[j].w * v[j].w); }
        const float rstd = 1.0f / sqrtf(wave_sum(s) * (1.f / DM) + 1e-6f);
        if (MODE == 0) {
            const int rmod = m < M_CTX ? 0 : 1 + ((m - M_CTX) >> 10);
            const float* mr = mods_l + (size_t)rmod * 6144;
            unsigned long long* o8 = (unsigned long long*)((bf16*)(F.ws + WS_XN) + (size_t)m * DM) + F.lane;
#pragma unroll
            for (int j = 0; j < 4; ++j) { const int c = 4 * F.lane + 256 * j; const f32x4 gg = *(const f32x4*)(g + c), sh = *(const f32x4*)(mr + sh_off + c), sc = *(const f32x4*)(mr + sc_off + c);
                const f32x4 y = (v[j] * rstd * gg) * (sc + 1.0f) + sh;
                o8[64 * j] = (unsigned long long)pk2(y.x, y.y) | ((unsigned long long)pk2(y.z, y.w) << 32); }
        } else {
            f32x4* yo = (f32x4*)(F.out + (size_t)m * DM) + F.lane;
#pragma unroll
            for (int j = 0; j < 4; ++j) { const int c = 4 * F.lane + 256 * j; const f32x4 gg = *(const f32x4*)(g + c); yo[64 * j] = v[j] * rstd * gg; }
        }
    }
}

__device__ __forceinline__ void prep_phase(Frame& F, int l) {
    const int gw = F.bid * NWAVES + F.wave, NGW = F.G * NWAVES, lane = F.lane;
    const bf16* Z = (const bf16*)(F.ws + WS_Z);
    bf16* QA = (bf16*)(F.ws + WS_QA); bf16* KA = (bf16*)(F.ws + WS_KA); bf16* VA = (bf16*)(F.ws + WS_VA);
    bf16* DQ = (bf16*)(F.ws + WS_DQ); bf16* DK = (bf16*)(F.ws + WS_DK); bf16* DV = (bf16*)(F.ws + WS_DV);
    float* BG = (float*)(F.ws + WS_BG);
    bf16* QN = (bf16*)(F.ws + WS_QN); bf16* CKV = (bf16*)(F.ws + WS_CKV); bf16* KR = (bf16*)(F.ws + WS_KR);
    const float* tabA = (const float*)(F.ws + WS_ROPE); const float* tabM = tabA + 2048;
    const float qn_g = F.in[I_QNG][l * 64 + lane], kn_g = F.in[I_KNG][l * 64 + lane];
    for (int it = gw; it < MTOK + NCACHE; it += NGW) {
        if (it >= MTOK) {
            const int cr = it - MTOK, b = cr >> 9, j = cr & 511; const size_t src = (size_t)((b * 2 + l) * 512 + j);
            const int krow = M_CTX + b * 1536 + j;
            const float* gk = F.in[I_CGK] + src * 128; const float* gv = F.in[I_CGV] + src * 128; const float* ck = F.in[I_CCKV] + src * 128; const float* kr = F.in[I_CKR] + src * 32;
            KA[(size_t)krow * 128 + lane] = (bf16)f2bf(gk[lane]); KA[(size_t)krow * 128 + 64 + lane] = (bf16)f2bf(gk[64 + lane]);
            VA[(size_t)krow * 128 + lane] = (bf16)f2bf(gv[lane]); VA[(size_t)krow * 128 + 64 + lane] = (bf16)f2bf(gv[64 + lane]);
            CKV[(size_t)it * 256 + lane] = (bf16)f2bf(ck[lane]); CKV[(size_t)it * 256 + 64 + lane] = (bf16)f2bf(ck[64 + lane]);
            CKV[(size_t)it * 256 + 128 + lane] = 0; CKV[(size_t)it * 256 + 192 + lane] = 0;
            if (lane < 32) KR[(size_t)it * 32 + lane] = (bf16)f2bf(kr[lane]);
            { const float* nk = F.in[I_CNK] + src * 256; const float* nv = F.in[I_CNV] + src * 256; bf16* NKB = (bf16*)(F.ws + WS_NKB) + (size_t)cr * 256; bf16* NVB = (bf16*)(F.ws + WS_NVB) + (size_t)cr * 256;
#pragma unroll
              for (int i = 0; i < 4; ++i) { NKB[i * 64 + lane] = (bf16)f2bf(nk[i * 64 + lane]); NVB[i * 64 + lane] = (bf16)f2bf(nv[i * 64 + lane]); } }
            continue;
        }
        const int m = it; const bool lat = m >= M_CTX;
        const int b = lat ? (m - M_CTX) >> 10 : m >> 8, t = lat ? (m - M_CTX) & 1023 : m & 255, L = lat ? 1024 : 256;
        const int pr = t >> 6, pc = t & 63;
        const bf16* zr = Z + (size_t)m * ZP;
        const size_t orow = (size_t)((b * 2 + l) * 256 + t);
        for (int hq = 0; hq < 4; ++hq) {
            const float x = bf2f(zr[Z_AQ + hq * 64 + lane]); const float ss = wave_sum(x * x);
            float y = x * (1.0f / sqrtf(ss * (1.f / 64.f) + 1e-6f)) * qn_g;
            if (lat) { const float yp = __shfl_xor(y, 16); const int pos = lane < 32 ? pr : pc; const float* cs = tabA + (pos * 16 + (lane & 15)) * 2;
                y = (lane & 16) ? y * cs[0] + yp * cs[1] : y * cs[0] - yp * cs[1]; }
            QA[(size_t)m * 256 + hq * 64 + lane] = (bf16)f2bf(y);
        }
        const int krow = lat ? M_CTX + b * 1536 + 512 + t : m;
        for (int kh = 0; kh < 2; ++kh) {
            const float x = bf2f(zr[Z_AK + kh * 64 + lane]); const float ss = wave_sum(x * x);
            float y = x * (1.0f / sqrtf(ss * (1.f / 64.f) + 1e-6f)) * kn_g;
            if (!lat) F.out[O_GK + orow * 128 + kh * 64 + lane] = y;
            if (lat) { const float yp = __shfl_xor(y, 16); const int pos = lane < 32 ? pr : pc; const float* cs = tabA + (pos * 16 + (lane & 15)) * 2;
                y = (lane & 16) ? y * cs[0] + yp * cs[1] : y * cs[0] - yp * cs[1]; }
            KA[(size_t)krow * 128 + kh * 64 + lane] = (bf16)f2bf(y);
            const bf16 vb = zr[Z_AV + kh * 64 + lane];
            VA[(size_t)krow * 128 + kh * 64 + lane] = vb;
            if (!lat) F.out[O_GV + orow * 128 + kh * 64 + lane] = bf2f(vb);
        }
        if (!lat) {
#pragma unroll
            for (int i = 0; i < 4; ++i) { F.out[O_NK + orow * 256 + i * 64 + lane] = bf2f(zr[Z_BK + i * 64 + lane]); F.out[O_NV + orow * 256 + i * 64 + lane] = bf2f(zr[Z_BV + i * 64 + lane]); }
        }
        for (int g = 0; g < 12; ++g) {
            const int ch = g * 64 + lane; float acc = 0.f;
#pragma unroll
            for (int j = 0; j < 4; ++j) { const int tt = t + j - 1; if (tt >= 0 && tt < L) acc += F.in[I_CONV][(size_t)(l * 4 + j) * 768 + ch] * bf2f(zr[(ptrdiff_t)(j - 1) * ZP + Z_CQKV + ch]); }
            float y = silu_f(acc);
            if (g < 8) { const float ss = wave_sum(y * y); y *= 1.0f / sqrtf(ss + 1e-6f); if (g < 4) y *= 0.125f; }
            bf16* dst = g < 4 ? DQ : (g < 8 ? DK : DV);
            dst[(size_t)m * 256 + (ch & 255)] = (bf16)f2bf(y);
        }
        if (lane < 8) {
            const float a = bf2f(zr[Z_CA + lane]), bb = bf2f(zr[Z_CB + lane]);
            const float beta = 1.0f / (1.0f + __expf(-bb));
            const float xx = a + F.in[I_DTB][l * 8 + lane];
            const float sp = fmaxf(xx, 0.f) + log1pf(__expf(-fabsf(xx)));
            BG[(size_t)m * 16 + lane] = beta; BG[(size_t)m * 16 + 8 + lane] = -__expf(F.in[I_ALOG][l * 8 + lane]) * sp;
        }
        {
            float x[4]; float ss = 0.f;
#pragma unroll
            for (int i = 0; i < 4; ++i) { x[i] = bf2f(zr[Z_DCQ + i * 64 + lane]); ss += x[i] * x[i]; }
            const float rstd = 1.0f / sqrtf(wave_sum(ss) * (1.f / 256.f) + 1e-6f);
#pragma unroll
            for (int i = 0; i < 4; ++i) QN[(size_t)m * 256 + i * 64 + lane] = (bf16)f2bf(x[i] * rstd * F.in[I_MQNG][l * 256 + i * 64 + lane]);
            const float c0 = bf2f(zr[Z_DCKV + lane]), c1 = bf2f(zr[Z_DCKV + 64 + lane]);
            const float r2 = 1.0f / sqrtf(wave_sum(c0 * c0 + c1 * c1) * (1.f / 128.f) + 1e-6f);
            const float y0 = c0 * r2 * F.in[I_MKVNG][l * 128 + lane], y1 = c1 * r2 * F.in[I_MKVNG][l * 128 + 64 + lane];
            CKV[(size_t)m * 256 + lane] = (bf16)f2bf(y0); CKV[(size_t)m * 256 + 64 + lane] = (bf16)f2bf(y1); CKV[(size_t)m * 256 + 128 + lane] = 0; CKV[(size_t)m * 256 + 192 + lane] = 0;
            if (!lat) { F.out[O_CKV + orow * 128 + lane] = y0; F.out[O_CKV + orow * 128 + 64 + lane] = y1; }
            const int d = lane & 31; float kr = bf2f(zr[Z_DKR + d]);
            if (!lat) { if (lane < 32) F.out[O_KR + orow * 32 + d] = kr; }
            else { const float kp = __shfl_xor(kr, 8); const int pos = d < 16 ? pr : pc; const float* cs = tabM + (pos * 8 + (d & 7)) * 2;
                kr = (d & 8) ? kr * cs[0] + kp * cs[1] : kr * cs[0] - kp * cs[1]; }
            if (lane < 32) KR[(size_t)m * 32 + d] = (bf16)f2bf(kr);
        }
    }
}

typedef short bf16x8 __attribute__((ext_vector_type(8)));
typedef float f32x16 __attribute__((ext_vector_type(16)));
typedef float f32x2_t __attribute__((ext_vector_type(2))); typedef __bf16 bf16x2_t __attribute__((ext_vector_type(2)));
__device__ __forceinline__ unsigned cvtpk(float lo, float hi) { f32x2_t v = {lo, hi}; bf16x2_t b = __builtin_convertvector(v, bf16x2_t); return __builtin_bit_cast(unsigned, b); }
struct AttDesc {
    const bf16* Q; int qs; int qrow0;
    const bf16 *K0, *K1, *R0, *R1, *V0, *V1; int ks0, ks1, rs0, rs1, vs0, vs1;
    int row00, row01, nt0, nt;
    bf16* O; float scale;
    int qpos0;
    int rlo; const float* nab;
};
constexpr int ATT_KT = 0, ATT_VT = 16384, ATT_NB = 28672, ATT_VROW = 68;
template <int DK, bool NA, bool QROPE>
__device__ __forceinline__ void attn_block(Frame& F, const AttDesc& D) {
    constexpr int KROWB = (DK + 8) * 2, NS = DK / 16;
    const int tid = F.tid, lane = F.lane, w = F.wave, lq = lane & 31, hh = lane >> 5;
    LAS unsigned char* lds = F.lds;
    __syncthreads();
    if constexpr (NA) { for (int e = tid; e < 465; e += NT) ((LAS float*)(lds + ATT_NB))[e] = D.nab[e] * LOG2E; }
    const int qrow = D.qrow0 + 32 * w + lq;
    bf16x8 qf[NS];
#pragma unroll
    for (int s = 0; s < NS; ++s) qf[s] = *(const bf16x8*)(D.Q + (size_t)qrow * D.qs + 16 * s + 8 * hh);
    if constexpr (QROPE) {
        const float* tabM = (const float*)(F.ws + WS_ROPE) + 2048; const int n = D.qpos0 + 32 * w + lq;
#pragma unroll
        for (int sx = 4; sx < 6; ++sx) { const int pos = sx == 4 ? (n >> 6) : (n & 63); const v4u qw = __builtin_bit_cast(v4u, qf[sx]); float res[8];
#pragma unroll
            for (int j = 0; j < 8; ++j) { const unsigned dw = qw[j >> 1]; const float own = (j & 1) ? bfhi(dw) : bflo(dw); const float oth = __shfl_xor(own, 32);
                const float c = tabM[(pos * 8 + j) * 2], sn = tabM[(pos * 8 + j) * 2 + 1]; res[j] = hh ? own * c + oth * sn : own * c - oth * sn; }
            v4u nw; nw.x = cvtpk(res[0], res[1]); nw.y = cvtpk(res[2], res[3]); nw.z = cvtpk(res[4], res[5]); nw.w = cvtpk(res[6], res[7]); qf[sx] = __builtin_bit_cast(bf16x8, nw); }
    }
    const int na_r = (D.qpos0 >> 6) + (w >> 1), na_c = (w & 1) * 32 + lq, na_r0 = min(max(na_r - 4, 0), 8), na_c0 = min(max(na_c - 8, 0), 48);
    f32x16 o0, o1;
#pragma unroll
    for (int r = 0; r < 16; ++r) { o0[r] = 0.f; o1[r] = 0.f; }
    float m = -1e30f, lsum = 0.f;
    v4u kreg, rreg = (v4u){0u, 0u, 0u, 0u}, vreg;
#define ATT_LOAD(t_) do { const int t__ = (t_); const bool sg = t__ >= D.nt0; const int r0_ = sg ? D.row01 + 64 * (t__ - D.nt0) : D.row00 + 64 * t__; \
        const bf16* Kb = sg ? D.K1 : D.K0; const bf16* Vb = sg ? D.V1 : D.V0; const int ks_ = sg ? D.ks1 : D.ks0, vs_ = sg ? D.vs1 : D.vs0; \
        kreg = *(const v4u*)(Kb + (size_t)(r0_ + (tid >> 3)) * ks_ + (tid & 7) * 8); \
        if constexpr (DK == 96) { if (tid < 256) { const bf16* Rb = sg ? D.R1 : D.R0; const int rs_ = sg ? D.rs1 : D.rs0; rreg = *(const v4u*)(Rb + (size_t)(r0_ + (tid >> 2)) * rs_ + (tid & 3) * 8); } } \
        vreg = *(const v4u*)(Vb + (size_t)(r0_ + lane) * vs_ + w * 8); } while (0)
    ATT_LOAD(0);
    for (int t = 0; t < D.nt; ++t) {
        __syncthreads();
        *(LAS v4u*)(lds + ATT_KT + (tid >> 3) * KROWB + (tid & 7) * 16) = kreg;
        if constexpr (DK == 96) { if (tid < 256) *(LAS v4u*)(lds + ATT_KT + (tid >> 2) * KROWB + 128 + (tid & 3) * 16) = rreg; }
        { LAS bf16* vt = (LAS bf16*)(lds + ATT_VT) + (8 * w) * ATT_VROW + lane;
#pragma unroll
          for (int i = 0; i < 8; ++i) { const unsigned dw = vreg[i >> 1]; vt[i * ATT_VROW] = (bf16)((i & 1) ? (dw >> 16) : (dw & 0xffffu)); } }
        __syncthreads();
        if (t + 1 < D.nt) ATT_LOAD(t + 1);
        bool rel = true; int kr = 0; bool local = false;
        if constexpr (NA) { if (t >= D.nt0) { local = true; kr = D.rlo + (t - D.nt0); rel = (kr >= na_r0) && (kr < na_r0 + 8); } }
        if (rel) {
            f32x16 s0, s1;
#pragma unroll
            for (int r = 0; r < 16; ++r) { s0[r] = 0.f; s1[r] = 0.f; }
#pragma unroll
            for (int s = 0; s < NS; ++s) {
                const bf16x8 a0 = *(const LAS bf16x8*)(lds + ATT_KT + lq * KROWB + 32 * s + 16 * hh);
                const bf16x8 a1 = *(const LAS bf16x8*)(lds + ATT_KT + (32 + lq) * KROWB + 32 * s + 16 * hh);
                s0 = __builtin_amdgcn_mfma_f32_32x32x16_bf16(a0, qf[s], s0, 0, 0, 0);
                s1 = __builtin_amdgcn_mfma_f32_32x32x16_bf16(a1, qf[s], s1, 0, 0, 0);
            }
            float tmax = -1e30f;
            if (NA && local) {
                const LAS float* nbp = (const LAS float*)(lds + ATT_NB) + (kr - na_r + 7) * 31 + 15 - na_c;
#pragma unroll
                for (int r = 0; r < 16; ++r) { const int kc0 = (r & 3) + 8 * (r >> 2) + 4 * hh, kc1 = kc0 + 32;
                    const bool al0 = (unsigned)(kc0 - na_c0) < 16u, al1 = (unsigned)(kc1 - na_c0) < 16u;
                    const float b0 = nbp[al0 ? kc0 : na_c], b1 = nbp[al1 ? kc1 : na_c];
                    s0[r] = al0 ? s0[r] * D.scale + b0 : -1e30f; s1[r] = al1 ? s1[r] * D.scale + b1 : -1e30f;
                    tmax = fmaxf(tmax, fmaxf(s0[r], s1[r])); }
            } else {
#pragma unroll
                for (int r = 0; r < 16; ++r) { s0[r] *= D.scale; s1[r] *= D.scale; tmax = fmaxf(tmax, fmaxf(s0[r], s1[r])); }
            }
            tmax = fmaxf(tmax, __shfl_xor(tmax, 32));
            const float mn = fmaxf(m, tmax); const float corr = __builtin_amdgcn_exp2f(m - mn); m = mn;
            float ps = 0.f;
#pragma unroll
            for (int r = 0; r < 16; ++r) { s0[r] = __builtin_amdgcn_exp2f(s0[r] - mn); s1[r] = __builtin_amdgcn_exp2f(s1[r] - mn); ps += s0[r] + s1[r]; }
            lsum = lsum * corr + ps;
#pragma unroll
            for (int r = 0; r < 16; ++r) { o0[r] *= corr; o1[r] *= corr; }
            bf16x8 pf[2][2];
#pragma unroll
            for (int s = 0; s < 2; ++s) { v4u p0, p1;
                p0.x = cvtpk(s0[8 * s + 0], s0[8 * s + 1]); p0.y = cvtpk(s0[8 * s + 2], s0[8 * s + 3]); p0.z = cvtpk(s0[8 * s + 4], s0[8 * s + 5]); p0.w = cvtpk(s0[8 * s + 6], s0[8 * s + 7]);
                p1.x = cvtpk(s1[8 * s + 0], s1[8 * s + 1]); p1.y = cvtpk(s1[8 * s + 2], s1[8 * s + 3]); p1.z = cvtpk(s1[8 * s + 4], s1[8 * s + 5]); p1.w = cvtpk(s1[8 * s + 6], s1[8 * s + 7]);
                pf[0][s] = __builtin_bit_cast(bf16x8, p0); pf[1][s] = __builtin_bit_cast(bf16x8, p1); }
#pragma unroll
            for (int kt = 0; kt < 2; ++kt)
#pragma unroll
                for (int s = 0; s < 2; ++s) {
                    const LAS unsigned char* vb0 = lds + ATT_VT + lq * (ATT_VROW * 2) + 8 * hh + 64 * kt + 32 * s;
                    const LAS unsigned char* vb1 = vb0 + 32 * (ATT_VROW * 2);
                    const v2u l0 = *(const LAS v2u*)(vb0), h0 = *(const LAS v2u*)(vb0 + 16), l1 = *(const LAS v2u*)(vb1), h1 = *(const LAS v2u*)(vb1 + 16);
                    const v4u a0 = {l0.x, l0.y, h0.x, h0.y}, a1 = {l1.x, l1.y, h1.x, h1.y};
                    o0 = __builtin_amdgcn_mfma_f32_32x32x16_bf16(__builtin_bit_cast(bf16x8, a0), pf[kt][s], o0, 0, 0, 0);
                    o1 = __builtin_amdgcn_mfma_f32_32x32x16_bf16(__builtin_bit_cast(bf16x8, a1), pf[kt][s], o1, 0, 0, 0);
                }
        }
    }
#undef ATT_LOAD
    lsum += __shfl_xor(lsum, 32);
    const float rl = 1.0f / lsum;
    bf16* orow = D.O + (size_t)qrow * 1024 + 4 * hh;
#pragma unroll
    for (int g = 0; g < 4; ++g) {
        v2u w0, w1; w0.x = cvtpk(o0[4 * g] * rl, o0[4 * g + 1] * rl); w0.y = cvtpk(o0[4 * g + 2] * rl, o0[4 * g + 3] * rl);
        w1.x = cvtpk(o1[4 * g] * rl, o1[4 * g + 1] * rl); w1.y = cvtpk(o1[4 * g + 2] * rl, o1[4 * g + 3] * rl);
        *(v2u*)(orow + 8 * g) = w0; *(v2u*)(orow + 32 + 8 * g) = w1;
    }
}
__device__ __forceinline__ void att_task(Frame& F, int ly, int mixer, bool lat, int b, int h, int qb) {
    const bf16* Z = (const bf16*)(F.ws + WS_Z);
    AttDesc D;
    D.qrow0 = lat ? M_CTX + b * 1024 + qb * 256 : b * 256; D.qpos0 = qb * 256; D.rlo = 0; D.nab = nullptr;
    D.R0 = nullptr; D.R1 = nullptr; D.rs0 = 0; D.rs1 = 0;
    if (mixer == 0) {
        D.Q = (const bf16*)(F.ws + WS_QA) + h * 64; D.qs = 256;
        D.K0 = D.K1 = (const bf16*)(F.ws + WS_KA) + (h >> 1) * 64; D.V0 = D.V1 = (const bf16*)(F.ws + WS_VA) + (h >> 1) * 64; D.ks0 = D.ks1 = D.vs0 = D.vs1 = 128;
        D.row00 = lat ? M_CTX + b * 1536 : b * 256; D.row01 = 0; D.nt0 = D.nt = lat ? 24 : 4;
        D.O = (bf16*)(F.ws + WS_O) + h * 64; D.scale = 0.125f * LOG2E;
        attn_block<64, false, false>(F, D);
    } else if (mixer == 1) {
        D.Q = Z + Z_BQ + h * 64; D.qs = ZP; D.O = (bf16*)(F.ws + WS_O) + 256 + h * 64; D.scale = 0.125f * LOG2E;
        D.K1 = Z + Z_BK + h * 64; D.V1 = Z + Z_BV + h * 64; D.ks1 = D.vs1 = ZP;
        if (!lat) { D.K0 = D.K1; D.V0 = D.V1; D.ks0 = D.vs0 = ZP; D.row00 = b * 256; D.row01 = 0; D.nt0 = D.nt = 4; attn_block<64, false, false>(F, D); }
        else {
            D.K0 = (const bf16*)(F.ws + WS_NKB) + h * 64; D.V0 = (const bf16*)(F.ws + WS_NVB) + h * 64; D.ks0 = D.vs0 = 256; D.row00 = b * 512; D.nt0 = 8;
            const int r_first = qb * 4, rlo = min(max(r_first - 4, 0), 8), rhi = min(max(r_first + 3 - 4, 0), 8) + 7;
            D.rlo = rlo; D.row01 = M_CTX + b * 1024 + rlo * 64; D.nt = 8 + (rhi - rlo + 1);
            D.nab = F.in[I_NAB] + (size_t)((ly * 4 + h) * 15) * 31;
            attn_block<64, true, false>(F, D);
        }
    } else {
        D.Q = (const bf16*)(F.ws + WS_QM) + h * 96; D.qs = 512; D.O = (bf16*)(F.ws + WS_O) + 768 + h * 64; D.scale = MLA_SCALE * LOG2E;
        D.K0 = D.K1 = (const bf16*)(F.ws + WS_KV) + h * 128; D.V0 = D.V1 = (const bf16*)(F.ws + WS_KV) + h * 128 + 64; D.R0 = D.R1 = (const bf16*)(F.ws + WS_KR);
        D.ks0 = D.ks1 = D.vs0 = D.vs1 = 512; D.rs0 = D.rs1 = 32;
        if (lat) { D.row00 = MTOK + b * 512; D.nt0 = 8; D.row01 = M_CTX + b * 1024; D.nt = 24; attn_block<96, false, true>(F, D); }
        else { D.row00 = b * 256; D.row01 = 0; D.nt0 = D.nt = 4; attn_block<96, false, false>(F, D); }
    }
}

constexpr int DN_KROW = 72, DN_AROW = 68;
constexpr int DNG_K = 0, DNG_Q = 9216, DNG_V = 18432, DNG_A = 27648, DNG_G = 27648 + 64 * DN_AROW * 4, DNG_BYTES = DNG_G + 1024;
static_assert(2 * DNG_BYTES <= RING_BYTES, "DeltaNet phase A LDS");
__device__ __forceinline__ int crow16(int r, int hh) { return (r & 3) + 8 * (r >> 2) + 4 * hh; }
__device__ __forceinline__ void dn_phase_a(Frame& F, int l) {
    const int tid = F.tid, lane = F.lane, lq = lane & 31, hh = lane >> 5, grp = tid >> 8, gt = tid & 255, gw = F.wave & 3;
    LAS unsigned char* gl = F.lds + grp * DNG_BYTES;
    LAS float* gsm = (LAS float*)(gl + DNG_G);
    const bf16* DQ = (const bf16*)(F.ws + WS_DQ); const bf16* DK = (const bf16*)(F.ws + WS_DK); const bf16* DV = (const bf16*)(F.ws + WS_DV); const float* BG = (const float*)(F.ws + WS_BG);
    for (int tp = F.bid; tp < 768; tp += F.G) {
        const int ta = 2 * tp + grp; const bool lat = ta < 1024;
        const int seq = lat ? ta >> 4 : 64 + ((ta - 1024) >> 2), n = lat ? ta & 15 : (ta - 1024) & 3, s2 = lat ? seq : seq - 64;
        const int b = s2 >> 3, h = (s2 >> 1) & 3, dir = s2 & 1, L = lat ? 1024 : 256, row0 = lat ? M_CTX + b * 1024 : b * 256;
        __syncthreads();
#pragma unroll
        for (int i = 0; i < 2; ++i) { const int idx = gt + 256 * i, c = idx >> 3, ch = idx & 7; const int step = 64 * n + c, t = dir ? L - 1 - step : step;
            const size_t src = (size_t)(row0 + t) * 256 + h * 64 + ch * 8;
            *(LAS v4u*)(gl + DNG_Q + c * (DN_KROW * 2) + ch * 16) = *(const v4u*)(DQ + src);
            *(LAS v4u*)(gl + DNG_K + c * (DN_KROW * 2) + ch * 16) = *(const v4u*)(DK + src);
            *(LAS v4u*)(gl + DNG_V + c * (DN_KROW * 2) + ch * 16) = *(const v4u*)(DV + src); }
        if (gw == 0) {
            const int step = 64 * n + lane, t = dir ? L - 1 - step : step; const size_t r = (size_t)(row0 + t) * 16;
            float val = BG[r + 8 + dir * 4 + h];
#pragma unroll
            for (int o = 1; o < 64; o <<= 1) { const float tt = __shfl_up(val, o); if (lane >= o) val += tt; }
            gsm[lane] = val; gsm[64 + lane] = BG[r + dir * 4 + h]; gsm[128 + lane] = __expf(val);
            ((float*)(F.ws + WS_GC))[(size_t)ta * 64 + lane] = val;
        }
        __syncthreads();
        {
            const int mat = gw >> 1, ti = gw & 1;
            const LAS unsigned char* xs = gl + (mat ? DNG_Q : DNG_K);
            const float gj0 = gsm[lq], gj1 = gsm[32 + lq];
#pragma unroll
            for (int tj = 0; tj < 2; ++tj) {
                f32x16 acc;
#pragma unroll
                for (int r = 0; r < 16; ++r) acc[r] = 0.f;
#pragma unroll
                for (int s = 0; s < 4; ++s) {
                    const bf16x8 av = *(const LAS bf16x8*)(xs + (32 * ti + lq) * (DN_KROW * 2) + 32 * s + 16 * hh);
                    const bf16x8 bv = *(const LAS bf16x8*)(gl + DNG_K + (32 * tj + lq) * (DN_KROW * 2) + 32 * s + 16 * hh);
                    acc = __builtin_amdgcn_mfma_f32_32x32x16_bf16(av, bv, acc, 0, 0, 0);
                }
                const int j = 32 * tj + lq; const float gj = tj ? gj1 : gj0;
                if (mat == 0) {
#pragma unroll
                    for (int r = 0; r < 16; ++r) { const int i = 32 * ti + crow16(r, hh); const float v = (j < i) ? gsm[64 + i] * acc[r] * __expf(gsm[i] - gj) : 0.f;
                        ((LAS float*)(gl + DNG_A))[i * DN_AROW + j] = v; }
                } else {
                    bf16* qkg = (bf16*)(F.ws + WS_QKG) + (size_t)ta * 4096;
#pragma unroll
                    for (int r = 0; r < 16; ++r) { const int i = 32 * ti + crow16(r, hh); const float v = (j <= i) ? acc[r] * __expf(gsm[i] - gj) : 0.f;
                        qkg[i * 64 + j] = (bf16)f2bf(v); }
                }
            }
        }
        __syncthreads();
        if (gw < 2) {
            const int cc = gt & 63; const bool isw = gt >= 64;
            const LAS bf16* src = (const LAS bf16*)(gl + (isw ? DNG_K : DNG_V)) + cc;
            const LAS float* As = (const LAS float*)(gl + DNG_A);
            float x[64];
#pragma unroll
            for (int i = 0; i < 64; ++i) x[i] = 0.f;
#pragma unroll
            for (int i = 0; i < 64; ++i) {
                float rv = bf2f(src[i * DN_KROW]) * gsm[64 + i]; if (isw) rv *= gsm[128 + i];
#pragma unroll
                for (int j4 = 0; j4 < (i + 3) / 4; ++j4) { const f32x4 a4 = *(const LAS f32x4*)(As + i * DN_AROW + 4 * j4);
                    rv -= a4.x * x[4 * j4]; rv -= a4.y * x[4 * j4 + 1]; rv -= a4.z * x[4 * j4 + 2]; rv -= a4.w * x[4 * j4 + 3]; }
                x[i] = rv;
                asm volatile("" : "+v"(x[i]) :: "memory");
            }
            if (!isw) {
                v4u* dst = (v4u*)((bf16*)(F.ws + WS_UT) + (size_t)ta * 4096 + cc * 64);
#pragma unroll
                for (int q8 = 0; q8 < 8; ++q8) { v4u w; w.x = pk2(x[8 * q8], x[8 * q8 + 1]); w.y = pk2(x[8 * q8 + 2], x[8 * q8 + 3]); w.z = pk2(x[8 * q8 + 4], x[8 * q8 + 5]); w.w = pk2(x[8 * q8 + 6], x[8 * q8 + 7]); dst[q8] = w; }
            } else {
                bf16* dst = (bf16*)(F.ws + WS_WN) + (size_t)ta * 4096 + cc;
#pragma unroll
                for (int i = 0; i < 64; ++i) dst[i * 64] = (bf16)f2bf(-x[i]);
            }
        } else if (dir == 0) {
            const int u = gt - 128, dk = u & 63, half = u >> 6;
            const int slot = lat ? (seq >> 1) * 16 + n : 512 + ((seq - 64) >> 1) * 4 + n;
            v4u* dst = (v4u*)((bf16*)(F.ws + WS_KT) + (size_t)slot * 4096 + dk * 64 + 32 * half);
            const LAS bf16* ks = (const LAS bf16*)(gl + DNG_K) + (32 * half) * DN_KROW + dk;
#pragma unroll
            for (int q8 = 0; q8 < 4; ++q8) { v4u w;
                w.x = (unsigned)ks[(8 * q8 + 0) * DN_KROW] | ((unsigned)ks[(8 * q8 + 1) * DN_KROW] << 16); w.y = (unsigned)ks[(8 * q8 + 2) * DN_KROW] | ((unsigned)ks[(8 * q8 + 3) * DN_KROW] << 16);
                w.z = (unsigned)ks[(8 * q8 + 4) * DN_KROW] | ((unsigned)ks[(8 * q8 + 5) * DN_KROW] << 16); w.w = (unsigned)ks[(8 * q8 + 6) * DN_KROW] | ((unsigned)ks[(8 * q8 + 7) * DN_KROW] << 16);
                dst[q8] = w; }
        }
    }
    __syncthreads();
}
__device__ __forceinline__ bf16x8 pack8(const f32x16& x, int s) {
    v4u p; p.x = cvtpk(x[8 * s + 0], x[8 * s + 1]); p.y = cvtpk(x[8 * s + 2], x[8 * s + 3]); p.z = cvtpk(x[8 * s + 4], x[8 * s + 5]); p.w = cvtpk(x[8 * s + 6], x[8 * s + 7]);
    return __builtin_bit_cast(bf16x8, p);
}
__device__ __forceinline__ bf16x8 ld_frag(const bf16* p) {
    const v2u lo = *(const v2u*)p, hi = *(const v2u*)(p + 8); const v4u a = {lo.x, lo.y, hi.x, hi.y}; return __builtin_bit_cast(bf16x8, a);
}
__device__ __forceinline__ bf16x8 ld_frag_rev(const bf16* p) {
    const v2u lo = *(const v2u*)p, hi = *(const v2u*)(p - 8);
    const v4u a = {(lo.y >> 16) | (lo.y << 16), (lo.x >> 16) | (lo.x << 16), (hi.y >> 16) | (hi.y << 16), (hi.x >> 16) | (hi.x << 16)}; return __builtin_bit_cast(bf16x8, a);
}
__device__ __forceinline__ void dn_scan_wave(Frame& F, int l, int seq, int ds) {
    const int lane = F.lane, lq = lane & 31, hh = lane >> 5;
    const bool lat = seq < 64; const int s2 = lat ? seq : seq - 64;
    const int b = s2 >> 3, h = (s2 >> 1) & 3, dir = s2 & 1, L = lat ? 1024 : 256, row0 = lat ? M_CTX + b * 1024 : b * 256, nch = L >> 6;
    const int dv = 32 * ds + lq;
    const bf16* DQ = (const bf16*)(F.ws + WS_DQ) + h * 64;
    bf16* ODN = (bf16*)(F.ws + WS_ODN) + (size_t)dir * MTOK * 256 + h * 64 + dv;
    f32x16 S0, S1;
    {   const float* s0p = F.in[I_SDN] + ((size_t)(((b * 2 + l) * 2 + dir) * 4 + h) * 64) * 64 + dv + 4 * hh * 64;
#pragma unroll
        for (int r = 0; r < 16; ++r) { S0[r] = lat ? s0p[0] : 0.f; S1[r] = lat ? s0p[32 * 64] : 0.f; s0p += ((r & 3) == 3) ? 5 * 64 : 64; asm volatile("" : "+v"(s0p)); } }
    for (int n = 0; n < nch; ++n) {
        const int ta = lat ? seq * 16 + n : 1024 + (seq - 64) * 4 + n;
        const int tch = dir ? nch - 1 - n : n; const int kslot = lat ? (seq >> 1) * 16 + tch : 512 + ((seq - 64) >> 1) * 4 + tch;
        const float* gc = (const float*)(F.ws + WS_GC) + (size_t)ta * 64;
        const bf16* UT = (const bf16*)(F.ws + WS_UT) + (size_t)ta * 4096 + dv * 64;
        const bf16* WN = (const bf16*)(F.ws + WS_WN) + (size_t)ta * 4096;
        const bf16* QK = (const bf16*)(F.ws + WS_QKG) + (size_t)ta * 4096;
        const bf16* KT = (const bf16*)(F.ws + WS_KT) + (size_t)kslot * 4096;
        const float gl = gc[63];
        const int c0 = lq, c1 = 32 + lq;
        const int t0 = dir ? L - 1 - (64 * n + c0) : 64 * n + c0, t1 = dir ? L - 1 - (64 * n + c1) : 64 * n + c1;
        bf16x8 sb[4]; sb[0] = pack8(S0, 0); sb[1] = pack8(S0, 1); sb[2] = pack8(S1, 0); sb[3] = pack8(S1, 1);
        bf16x8 wa0[4], wa1[4], qa0[4], qa1[4];
#pragma unroll
        for (int s = 0; s < 4; ++s) { wa0[s] = ld_frag(WN + c0 * 64 + 16 * s + 4 * hh); wa1[s] = ld_frag(WN + c1 * 64 + 16 * s + 4 * hh);
            qa0[s] = ld_frag(DQ + (size_t)(row0 + t0) * 256 + 16 * s + 4 * hh); qa1[s] = ld_frag(DQ + (size_t)(row0 + t1) * 256 + 16 * s + 4 * hh); }
        f32x16 vn0, vn1;
#pragma unroll
        for (int g = 0; g < 4; ++g) { const v2u a = *(const v2u*)(UT + 8 * g + 4 * hh), c2 = *(const v2u*)(UT + 32 + 8 * g + 4 * hh);
            vn0[4 * g] = bflo(a.x); vn0[4 * g + 1] = bfhi(a.x); vn0[4 * g + 2] = bflo(a.y); vn0[4 * g + 3] = bfhi(a.y);
            vn1[4 * g] = bflo(c2.x); vn1[4 * g + 1] = bfhi(c2.x); vn1[4 * g + 2] = bflo(c2.y); vn1[4 * g + 3] = bfhi(c2.y); }
#pragma unroll
        for (int s = 0; s < 4; ++s) { vn0 = __builtin_amdgcn_mfma_f32_32x32x16_bf16(wa0[s], sb[s], vn0, 0, 0, 0); vn1 = __builtin_amdgcn_mfma_f32_32x32x16_bf16(wa1[s], sb[s], vn1, 0, 0, 0); }
        asm volatile("" : "+v"(vn0), "+v"(vn1) :: "memory");
        f32x16 o0, o1;
#pragma unroll
        for (int r = 0; r < 16; ++r) { o0[r] = 0.f; o1[r] = 0.f; }
#pragma unroll
        for (int s = 0; s < 4; ++s) { o0 = __builtin_amdgcn_mfma_f32_32x32x16_bf16(qa0[s], sb[s], o0, 0, 0, 0); o1 = __builtin_amdgcn_mfma_f32_32x32x16_bf16(qa1[s], sb[s], o1, 0, 0, 0); }
#pragma unroll
        for (int g = 0; g < 4; ++g) { const f32x4 a = *(const f32x4*)(gc + 8 * g + 4 * hh), c2 = *(const f32x4*)(gc + 32 + 8 * g + 4 * hh);
            o0[4 * g] *= __expf(a.x); o0[4 * g + 1] *= __expf(a.y); o0[4 * g + 2] *= __expf(a.z); o0[4 * g + 3] *= __expf(a.w);
            o1[4 * g] *= __expf(c2.x); o1[4 * g + 1] *= __expf(c2.y); o1[4 * g + 2] *= __expf(c2.z); o1[4 * g + 3] *= __expf(c2.w); }
        asm volatile("" : "+v"(o0), "+v"(o1) :: "memory");
        bf16x8 ka0[4], ka1[4];
#pragma unroll
        for (int s = 0; s < 4; ++s) { ka0[s] = ld_frag(QK + c0 * 64 + 16 * s + 4 * hh); ka1[s] = ld_frag(QK + c1 * 64 + 16 * s + 4 * hh); }
        bf16x8 kt0[4], kt1[4];
#pragma unroll
        for (int s = 0; s < 4; ++s) {
            if (dir == 0) { kt0[s] = ld_frag(KT + lq * 64 + 16 * s + 4 * hh); kt1[s] = ld_frag(KT + (32 + lq) * 64 + 16 * s + 4 * hh); }
            else { kt0[s] = ld_frag_rev(KT + lq * 64 + 60 - 16 * s - 4 * hh); kt1[s] = ld_frag_rev(KT + (32 + lq) * 64 + 60 - 16 * s - 4 * hh); } }
        {
            bf16x8 vb[4]; vb[0] = pack8(vn0, 0); vb[1] = pack8(vn0, 1); vb[2] = pack8(vn1, 0); vb[3] = pack8(vn1, 1);
#pragma unroll
            for (int s = 0; s < 4; ++s) { o0 = __builtin_amdgcn_mfma_f32_32x32x16_bf16(ka0[s], vb[s], o0, 0, 0, 0); o1 = __builtin_amdgcn_mfma_f32_32x32x16_bf16(ka1[s], vb[s], o1, 0, 0, 0); }
        }
        {
            const ptrdiff_t rs = dir ? -256 : 256;
            bf16* op = ODN + (ptrdiff_t)(row0 + (dir ? L - 1 - 64 * n : 64 * n)) * 256 + rs * (4 * hh);
#pragma unroll
            for (int r = 0; r < 16; ++r) { op[0] = (bf16)f2bf(o0[r]); op[rs * 32] = (bf16)f2bf(o1[r]); op += ((r & 3) == 3) ? rs * 5 : rs; asm volatile("" : "+v"(op)); }
        }
#pragma unroll
        for (int g = 0; g < 4; ++g) { const f32x4 a = *(const f32x4*)(gc + 8 * g + 4 * hh), c2 = *(const f32x4*)(gc + 32 + 8 * g + 4 * hh);
            vn0[4 * g] *= __expf(gl - a.x); vn0[4 * g + 1] *= __expf(gl - a.y); vn0[4 * g + 2] *= __expf(gl - a.z); vn0[4 * g + 3] *= __expf(gl - a.w);
            vn1[4 * g] *= __expf(gl - c2.x); vn1[4 * g + 1] *= __expf(gl - c2.y); vn1[4 * g + 2] *= __expf(gl - c2.z); vn1[4 * g + 3] *= __expf(gl - c2.w); }
        {
            bf16x8 vb[4]; vb[0] = pack8(vn0, 0); vb[1] = pack8(vn0, 1); vb[2] = pack8(vn1, 0); vb[3] = pack8(vn1, 1);
            const float egl = __expf(gl);
#pragma unroll
            for (int r = 0; r < 16; ++r) { S0[r] *= egl; S1[r] *= egl; }
#pragma unroll
            for (int s = 0; s < 4; ++s) { S0 = __builtin_amdgcn_mfma_f32_32x32x16_bf16(kt0[s], vb[s], S0, 0, 0, 0); S1 = __builtin_amdgcn_mfma_f32_32x32x16_bf16(kt1[s], vb[s], S1, 0, 0, 0); }
        }
        asm volatile("" : "+v"(S0), "+v"(S1) :: "memory");
    }
    if (!lat) {
        float* dst = F.out + O_DS + ((size_t)(((b * 2 + l) * 2 + dir) * 4 + h) * 64) * 64 + dv + 4 * hh * 64;
#pragma unroll
        for (int r = 0; r < 16; ++r) { dst[0] = S0[r]; dst[32 * 64] = S1[r]; dst += ((r & 3) == 3) ? 5 * 64 : 64; asm volatile("" : "+v"(dst)); }
    }
}
__device__ __forceinline__ void dn_scan_task(Frame& F, int l, int j) {
    const int wt = 8 * j + F.wave;
    if (wt < 128) dn_scan_wave(F, l, wt >> 1, wt & 1); else dn_scan_wave(F, l, 64 + ((wt - 128) >> 1), wt & 1);
}

__device__ __forceinline__ void mixer_phase(Frame& F, int l) {
    { const int j = F.G - 1 - F.bid; if (j < 48) dn_scan_task(F, l, j); }
    for (int task = F.bid; task < 576; task += F.G) {
        int mixer, b, h, qb = 0; bool lat = true;
        if (task < 128) { mixer = 2; b = task >> 4; h = (task >> 2) & 3; qb = task & 3; }
        else if (task < 256) { const int t = task - 128; mixer = 0; b = t >> 4; h = (t >> 2) & 3; qb = t & 3; }
        else if (task < 384) { const int t = task - 256; mixer = 1; b = t >> 4; h = (t >> 2) & 3; qb = t & 3; }
        else { const int t = (task - 384) & 63; mixer = (task - 384) >> 6; lat = false; b = t >> 2; h = t & 3; }
        att_task(F, l, mixer, lat, b, h, qb);
    }
}

__device__ __forceinline__ void dn_combine(Frame& F, int l) {
    const int gw = F.bid * NWAVES + F.wave, NGW = F.G * NWAVES, lane = F.lane;
    const bf16* Z = (const bf16*)(F.ws + WS_Z); bf16* O = (bf16*)(F.ws + WS_O);
    const bf16* O0 = (const bf16*)(F.ws + WS_ODN); const bf16* O1 = O0 + (size_t)MTOK * 256;
    const float g = F.in[I_DNOG][l * 64 + lane];
    for (int m = gw; m < MTOK; m += NGW) {
#pragma unroll
        for (int h = 0; h < 4; ++h) {
            const float v = bf2f(O0[(size_t)m * 256 + h * 64 + lane]) + bf2f(O1[(size_t)m * 256 + h * 64 + lane]);
            const float ss = wave_sum(v * v);
            const float y = v * (1.0f / sqrtf(ss * (1.f / 64.f) + 1e-6f)) * g * silu_f(bf2f(Z[(size_t)m * ZP + Z_CG + h * 64 + lane]));
            O[(size_t)m * 1024 + 512 + h * 64 + lane] = (bf16)f2bf(y);
        }
    }
}

constexpr int N_PHASES = 2 + 10 * DEPTH;
__global__ void __launch_bounds__(NT, 2) hybrid_fwd(Args args) {
    extern __shared__ __attribute__((aligned(16))) unsigned char lds_raw[];
    Frame F;
    F.lds = (LAS unsigned char*)lds_raw;
    F.tid = threadIdx.x; F.lane = F.tid & 63; F.wave = __builtin_amdgcn_readfirstlane(F.tid >> 6);
    F.G = gridDim.x; F.bid = blockIdx.x;
    F.in = args.in; F.out = args.out; F.ws = args.ws;
    volatile LAS unsigned* MISC = (volatile LAS unsigned*)(F.lds + MISC_OFF);
    for (int u = F.tid; u < (LDS_BYTES - LDSCTL_OFF) / 4; u += NT) ((LAS unsigned*)(F.lds + LDSCTL_OFF))[u] = 0u;
    __syncthreads();
    XcdBarrier bar; bar.bar = (unsigned*)(F.ws + WS_CTL) + CW_BAR; bar.x = 0; bar.st = nullptr;
#if !MK_PER_PHASE
    bar = xcd_barrier_post((unsigned*)(F.ws + WS_CTL) + CW_BAR, MISC + 8);
#endif
    for (int ph = args.ph_lo; ph < args.ph_hi; ++ph) {
        {
            int tid_ = threadIdx.x, bid_ = blockIdx.x; unsigned char* ws_ = args.ws; float* out_ = args.out;
            asm volatile("" : "+v"(tid_)); asm volatile("" : "+s"(bid_)); asm volatile("" : "+s"(ws_)); asm volatile("" : "+s"(out_));
            F.tid = tid_; F.lane = tid_ & 63; F.wave = __builtin_amdgcn_readfirstlane(tid_ >> 6); F.bid = bid_; F.ws = ws_; F.out = out_;
        }
        const float* mods = (const float*)(F.ws + WS_MODS);
        if (ph == 0) { p0a(F); convert_weights(F, 0); }
        else if (ph == 1) norm_rows<0>(F, true, F.in[I_N1G], mods, 0, 1024);
        else {
            const int l = (ph - 2) / 10, sp = (ph - 2) % 10;
            unsigned char* wl = F.ws + WS_W;
            const float* mods_l = mods + (size_t)l * 9 * 6144;
            if (sp == 0) {
                pg8::Gemm g{(const bf16*)(F.ws + WS_XN), (const bf16*)(wl + W_IN), MTOK, ZP, 1024}; pg8::StaticOrder S; S.init(MTOK, ZP, F.G, F.bid);
                pg8::EpiBf16 E{(bf16*)(F.ws + WS_Z), ZP};
                pg8::gemm_phase<pg8::EpiBf16, pg8::StaticOrder, true, true>(F.lds, g, S, E, F.tid);
            } else if (sp == 1) prep_phase(F, l);
            else if (sp == 2) {
                { pg8::Gemm g{(const bf16*)(F.ws + WS_QN), (const bf16*)(wl + W_Q), MTOK, 512, 256}; pg8::StaticOrder S; S.init(MTOK, 512, F.G, F.bid);
                  pg8::EpiBf16 E{(bf16*)(F.ws + WS_QM), 512};
                  pg8::gemm_phase<pg8::EpiBf16, pg8::StaticOrder, true, true>(F.lds, g, S, E, F.tid); }
                { pg8::Gemm g{(const bf16*)(F.ws + WS_CKV), (const bf16*)(wl + W_KV), KVROWS, 512, 256}; pg8::StaticOrder S; S.init(KVROWS, 512, F.G, (F.bid + F.G - 96) % F.G);
                  pg8::EpiBf16 E{(bf16*)(F.ws + WS_KV), 512};
                  pg8::gemm_phase<pg8::EpiBf16, pg8::StaticOrder, true, true>(F.lds, g, S, E, F.tid); }
                dn_phase_a(F, l);
            } else if (sp == 3) mixer_phase(F, l);
            else if (sp == 4) dn_combine(F, l);
            else if (sp == 5) {
                pg8::Gemm g{(const bf16*)(F.ws + WS_O), (const bf16*)(wl + W_OUT), MTOK, 1024, 1024}; pg8::StaticOrder S; S.init(MTOK, 1024, F.G, F.bid);
                pg8::EpiRes E{l == 0 ? F.in[I_XP] : F.out, l == 0 ? F.in[I_XS] : F.out + (size_t)M_CTX * DM, F.out, mods_l + 2 * 1024};
                pg8::gemm_phase<pg8::EpiRes, pg8::StaticOrder, true, true>(F.lds, g, S, E, F.tid);
            } else if (sp == 6) norm_rows<0>(F, false, F.in[I_N2G] + l * 1024, mods_l, 3 * 1024, 4 * 1024);
            else if (sp == 7) {
                pg8::Gemm g{(const bf16*)(F.ws + WS_XN), (const bf16*)(wl + W_GU), MTOK, NGU, 1024}; pg8::StaticOrder S; S.init(MTOK, NGU, F.G, F.bid);
                pg8::EpiSwiglu E{(bf16*)(F.ws + WS_Z), FF};
                pg8::gemm_phase<pg8::EpiSwiglu, pg8::StaticOrder, true, true>(F.lds, g, S, E, F.tid);
            } else if (sp == 8) {
                pg8::Gemm g{(const bf16*)(F.ws + WS_Z), (const bf16*)(wl + W_D), MTOK, 1024, FF}; pg8::StaticOrder S; S.init(MTOK, 1024, F.G, F.bid);
                pg8::EpiRes E{F.out, F.out + (size_t)M_CTX * DM, F.out, mods_l + 5 * 1024};
                pg8::gemm_phase<pg8::EpiRes, pg8::StaticOrder, true, true>(F.lds, g, S, E, F.tid);
            } else {
                if (l + 1 < DEPTH) { norm_rows<0>(F, false, F.in[I_N1G] + (l + 1) * 1024, mods_l + 9 * 6144, 0, 1024); convert_weights(F, l + 1); }
                else norm_rows<1>(F, false, F.in[I_FG], nullptr, 0, 0);
            }
        }
#if !MK_PER_PHASE
        if (ph + 1 < args.ph_hi) xcd_barrier(bar);
#endif
    }
}

extern "C" void kernel_launch(void* const* d_in, const int* in_sizes, int n_in, void* d_out, int out_size, void* d_ws, size_t ws_size, hipStream_t stream) {
    static int grid = 0;
    if (grid == 0) {
        if (n_in != N_IN || out_size != (int)O_END || ws_size < WS_END) { fprintf(stderr, "kernel_launch: unexpected shapes: n_in %d out %d ws %zu\n", n_in, out_size, ws_size); grid = -1; return; }
        int dev = 0, cus = 0, per_cu = 0;
        if (hipGetDevice(&dev) != hipSuccess || hipDeviceGetAttribute(&cus, hipDeviceAttributeMultiprocessorCount, dev) != hipSuccess) { grid = -1; return; }
        if (hipFuncSetAttribute((const void*)hybrid_fwd, hipFuncAttributeMaxDynamicSharedMemorySize, LDS_BYTES) != hipSuccess) { fprintf(stderr, "kernel_launch: hipFuncSetAttribute failed\n"); grid = -1; return; }
        if (hipOccupancyMaxActiveBlocksPerMultiprocessor(&per_cu, (const void*)hybrid_fwd, NT, LDS_BYTES) != hipSuccess || per_cu < 1) { fprintf(stderr, "kernel_launch: occupancy query says %d\n", per_cu); }
        (void)hipGetLastError();
        grid = cus;
    }
    if (grid < 0) return;
    (void)hipMemsetAsync((char*)d_ws + WS_CTL, 0, CTL_ZERO_BYTES, stream);
    Args a{};
    for (int i = 0; i < N_IN; ++i) a.in[i] = (const float*)d_in[i];
    a.out = (float*)d_out; a.ws = (unsigned char*)d_ws;
#if MK_PER_PHASE
    for (int ph = 0; ph < N_PHASES; ++ph) { a.ph_lo = ph; a.ph_hi = ph + 1; hipLaunchKernelGGL(hybrid_fwd, dim3(grid), dim3(NT), LDS_BYTES, stream, a); }
#else
    a.ph_lo = 0; a.ph_hi = N_PHASES;
    void* kargs[] = {&a};
    hipError_t e = hipLaunchCooperativeKernel((const void*)hybrid_fwd, dim3(grid), dim3(NT), kargs, LDS_BYTES, stream);
    if (e != hipSuccess) fprintf(stderr, "kernel_launch: cooperative launch failed: %s (grid %d)\n", hipGetErrorString(e), grid);
#endif
}
```

```cpp
#include <hip/hip_runtime.h>
#include <cstdio>
#include <cstdint>

#ifndef REPEAT_MASK
#define REPEAT_MASK 0
#endif
#ifndef MK_PER_PHASE
#define MK_PER_PHASE 0
#endif

namespace pg8 {
#define PG8_LAS __attribute__((address_space(3)))
typedef unsigned short bf16_t;
typedef short bf16x8 __attribute__((ext_vector_type(8)));
typedef float f32x4 __attribute__((ext_vector_type(4)));
typedef unsigned u32x4 __attribute__((ext_vector_type(4)));
typedef unsigned u32x2 __attribute__((ext_vector_type(2)));
constexpr int BM = 256, BK = 64, HALF = 128, HTB = HALF * BK * 2, STAGE_BYTES = 8 * HTB, NXCD = 8, WGM = 8;

__host__ __device__ __forceinline__ int lds_byte(int r, int c) { const int st = (r >> 4) * 2 + (c >> 5), rr = r & 15, cc = c & 31, ob = rr * 64 + cc * 2; return st * 1024 + (ob ^ (((ob >> 9) & 1) << 5)); }
__host__ __device__ __forceinline__ void stage_rc(int b, int& R, int& C) { const int st = b / 1024, sb = b % 1024, swz = sb ^ (((sb >> 9) & 1) << 5); R = (st >> 1) * 16 + swz / 64; C = (st & 1) * 32 + (swz % 64) / 2; }
__host__ __device__ __forceinline__ int perm32(int rho) { const int n = rho >> 4, i = rho & 15; return 8 * (i >> 2) + 4 * n + (i & 3); }

struct Unit { int pm, pn; };
struct Gemm { const bf16_t* A; const bf16_t* Bt; int M, N, K; };

struct StaticOrder {
    int nM, nN, nwg, G, c;
    __host__ __device__ void init(int M, int N, int G_, int c_) { nM = M / BM; nN = N / BM; nwg = nM * nN; G = G_; c = c_; }
    __host__ __device__ bool next(int i, Unit& u) const {
        const long L = (long)i * G + c; if (L >= nwg) return false;
        int wgid = (int)L; { const int q = nwg / NXCD, r = nwg % NXCD, xcd = wgid % NXCD, off = wgid / NXCD; wgid = (xcd < r ? xcd * (q + 1) : r * (q + 1) + (xcd - r) * q) + off; }
        const int nig = WGM * nN, gid = wgid / nig, fm = gid * WGM, gsz = (nM - fm) < WGM ? (nM - fm) : WGM;
        u.pm = fm + ((wgid % nig) % gsz); u.pn = (wgid % nig) / gsz; return true;
    }
    __device__ __forceinline__ void a_ready(const Unit&) const {}
    __device__ __forceinline__ void done(const Unit&) const {}
};

__device__ __forceinline__ unsigned cvt_pk_bf16(float lo, float hi) { unsigned r; asm volatile("v_cvt_pk_bf16_f32 %0, %1, %2" : "=v"(r) : "v"(lo), "v"(hi)); return r; }

struct EpiBf16 {
    static constexpr bool PERM = true, AFTER_DRAIN = false;
    bf16_t* O; int ldc;
    __device__ __forceinline__ void operator()(const f32x4 (&acc)[2][2][4][2], const Unit& u, int wr, int wc, int fr, int fq) const {
        const int row0 = u.pm * BM + wr * 64 + fr; const int col0 = u.pn * BM + wc * 32 + 8 * fq;
#pragma unroll
        for (int ai = 0; ai < 2; ++ai)
#pragma unroll
            for (int m = 0; m < 4; ++m) { bf16_t* rowp = O + (size_t)(row0 + ai * HALF + m * 16) * ldc + col0;
#pragma unroll
                for (int bj = 0; bj < 2; ++bj) { const f32x4 v0 = acc[ai][bj][m][0], v1 = acc[ai][bj][m][1];
                    u32x4 w; w.x = cvt_pk_bf16(v0[0], v0[1]); w.y = cvt_pk_bf16(v0[2], v0[3]); w.z = cvt_pk_bf16(v1[0], v1[1]); w.w = cvt_pk_bf16(v1[2], v1[3]);
                    *(u32x4*)(rowp + bj * HALF) = w; } }
    }
};
struct EpiSwiglu {
    static constexpr bool PERM = true, AFTER_DRAIN = false;
    bf16_t* O; int ldc;
    __device__ __forceinline__ static float sw(float g, float u) { return g * u / (1.0f + __expf(-g)); }
    __device__ __forceinline__ void operator()(const f32x4 (&acc)[2][2][4][2], const Unit& u, int wr, int wc, int fr, int fq) const {
        const int row0 = u.pm * BM + wr * 64 + fr; const int col0 = (u.pn * BM + wc * 32 + 8 * fq) >> 1;
#pragma unroll
        for (int ai = 0; ai < 2; ++ai)
#pragma unroll
            for (int m = 0; m < 4; ++m) { bf16_t* rowp = O + (size_t)(row0 + ai * HALF + m * 16) * ldc + col0;
#pragma unroll
                for (int bj = 0; bj < 2; ++bj) { const f32x4 v0 = acc[ai][bj][m][0], v1 = acc[ai][bj][m][1];
                    u32x2 w; w.x = cvt_pk_bf16(sw(v0[0], v0[1]), sw(v0[2], v0[3])); w.y = cvt_pk_bf16(sw(v1[0], v1[1]), sw(v1[2], v1[3]));
                    *(u32x2*)(rowp + bj * (HALF / 2)) = w; } }
    }
};
struct EpiRes {
    static constexpr bool PERM = false, AFTER_DRAIN = false;
    const float* base_a; const float* base_b; float* out; const float* gate;
    __device__ __forceinline__ void operator()(const f32x4 (&acc)[2][2][4][2], const Unit& u, int wr, int wc, int fr, int fq) const {
        const int col0 = u.pn * BM + wc * 32 + 4 * fq;
        const int rmod = u.pm < 16 ? 0 : 1 + ((u.pm - 16) >> 2);
        const float* g = gate + (size_t)rmod * 6144 + col0;
        const float* bp = u.pm < 16 ? base_a + (size_t)u.pm * BM * 1024 : base_b + (size_t)(u.pm - 16) * BM * 1024;
        float* op = out + (size_t)u.pm * BM * 1024;
        f32x4 gv[2][2];
#pragma unroll
        for (int bj = 0; bj < 2; ++bj)
#pragma unroll
            for (int n = 0; n < 2; ++n) gv[bj][n] = *(const f32x4*)(g + bj * HALF + n * 16);
#pragma unroll
        for (int ai = 0; ai < 2; ++ai)
#pragma unroll
            for (int m = 0; m < 4; ++m) { const size_t off = (size_t)(ai * HALF + wr * 64 + m * 16 + fr) * 1024 + col0;
#pragma unroll
                for (int bj = 0; bj < 2; ++bj)
#pragma unroll
                    for (int n = 0; n < 2; ++n) { const f32x4 bs = *(const f32x4*)(bp + off + bj * HALF + n * 16);
                        *(f32x4*)(op + off + bj * HALF + n * 16) = bs + gv[bj][n] * acc[ai][bj][m][n]; } }
    }
};

template <class Epi, class Sched, bool ALIGN_EPI = false, bool SP2 = false>
__device__ __forceinline__ void gemm_phase(PG8_LAS unsigned char* lds, const Gemm g, const Sched& S, const Epi& E, const int tid) {
    const int wid = __builtin_amdgcn_readfirstlane(tid >> 6), lane = tid & 63, wr = wid >> 2, wc = wid & 3, fr = lane & 15, fq = lane >> 4;
    const int K = g.K, nt = K / BK;
    unsigned voffA[2], voffB[2];
#pragma unroll
    for (int i = 0; i < 2; ++i) { int R, C; stage_rc(tid * 16 + i * 8192, R, C); const int Rb = Epi::PERM ? ((R & ~31) + perm32(R & 31)) : R;
        voffA[i] = (unsigned)(R * K + C) * 2u; voffB[i] = (unsigned)(Rb * K + C) * 2u; }
    const size_t kstep = (size_t)(BK * 2);
    const size_t hstep = (size_t)HALF * K * 2;
    const size_t tstep = 2 * hstep;
    const unsigned ldsw = (unsigned)wid * 1024u;
    const int aoff = lds_byte(wr * 64 + fr, fq * 8), boff = lds_byte(wc * 32 + fr, fq * 8);
#define PG8_SA(b, h) (((b) * 2 + (h)) * HTB)
#define PG8_SB(b, h) ((4 + (b) * 2 + (h)) * HTB)
#define PG8_STAGE(bufoff, gbase, voff) do { _Pragma("unroll") for (int _i = 0; _i < 2; ++_i) \
        __builtin_amdgcn_global_load_lds((const unsigned*)((const char*)(gbase) + (voff)[_i]), (PG8_LAS unsigned*)(lds + (bufoff) + ldsw + _i * 8192), 16, 0, 0); } while (0)
#define PG8_LDA(dst, b, h) do { _Pragma("unroll") for (int m = 0; m < 4; ++m) _Pragma("unroll") for (int k = 0; k < 2; ++k) dst[m][k] = *(const PG8_LAS bf16x8*)(lds + PG8_SA(b, h) + aoff + m * 2048 + k * 1024); } while (0)
#define PG8_LDB(dst, b, h) do { _Pragma("unroll") for (int n = 0; n < 2; ++n) _Pragma("unroll") for (int k = 0; k < 2; ++k) dst[n][k] = *(const PG8_LAS bf16x8*)(lds + PG8_SB(b, h) + boff + n * 2048 + k * 1024); } while (0)
#define PG8_MMA(ai, bj, At, Bt) do { __builtin_amdgcn_s_setprio(1); _Pragma("unroll") for (int m = 0; m < 4; ++m) _Pragma("unroll") for (int n = 0; n < 2; ++n) _Pragma("unroll") for (int k = 0; k < 2; ++k) \
        acc[ai][bj][m][n] = __builtin_amdgcn_mfma_f32_16x16x32_bf16(Bt[n][k], At[m][k], acc[ai][bj][m][n], 0, 0, 0); __builtin_amdgcn_s_setprio(0); } while (0)
#define PG8_WAIT_V(n) asm volatile("s_waitcnt vmcnt(" #n ")" ::: "memory")
#define PG8_WAIT_L(n) asm volatile("s_waitcnt lgkmcnt(" #n ")" ::: "memory")
#define PG8_BAR __builtin_amdgcn_s_barrier()
#define PG8_SCHED __builtin_amdgcn_sched_barrier(0)
    Unit cur, nxt; int ui = 0;
    if (!S.next(0, cur)) return;
    f32x4 acc[2][2][4][2];
#pragma unroll
    for (int a = 0; a < 2; ++a)
#pragma unroll
        for (int b = 0; b < 2; ++b)
#pragma unroll
            for (int m = 0; m < 4; ++m)
#pragma unroll
                for (int n = 0; n < 2; ++n) acc[a][b][m][n] = (f32x4){0.f, 0.f, 0.f, 0.f};
    bf16x8 At[4][2], B0[2][2], B1[2][2];
    const char* cA = (const char*)g.A + (size_t)cur.pm * tstep; const char* cB = (const char*)g.Bt + (size_t)cur.pn * tstep;
    S.a_ready(cur);
    if constexpr (SP2) {
        PG8_STAGE(PG8_SB(0, 0), cB, voffB); PG8_STAGE(PG8_SB(0, 1), cB + hstep, voffB); PG8_STAGE(PG8_SA(0, 0), cA, voffA); PG8_STAGE(PG8_SA(0, 1), cA + hstep, voffA);
        if (wr == 1) PG8_BAR;
        PG8_WAIT_V(2); PG8_BAR;
        PG8_STAGE(PG8_SB(1, 0), cB + kstep, voffB); PG8_STAGE(PG8_SA(1, 0), cA + kstep, voffA); PG8_STAGE(PG8_SB(1, 1), cB + hstep + kstep, voffB);
        PG8_WAIT_V(6); PG8_BAR;
    } else {
        PG8_STAGE(PG8_SB(0, 0), cB, voffB); PG8_STAGE(PG8_SA(0, 0), cA, voffA); PG8_STAGE(PG8_SB(0, 1), cB + hstep, voffB); PG8_STAGE(PG8_SA(0, 1), cA + hstep, voffA);
        if (wr == 1) PG8_BAR;
        PG8_WAIT_V(4); PG8_BAR;
        PG8_STAGE(PG8_SB(1, 0), cB + kstep, voffB); PG8_STAGE(PG8_SA(1, 0), cA + kstep, voffA); PG8_STAGE(PG8_SB(1, 1), cB + hstep + kstep, voffB);
        PG8_WAIT_V(6); PG8_BAR;
    }
    for (;;) {
        const bool has_next = S.next(ui + 1, nxt);
        const char* nA = has_next ? (const char*)g.A + (size_t)nxt.pm * tstep : cA; const char* nB = has_next ? (const char*)g.Bt + (size_t)nxt.pn * tstep : cB;
        for (int t = 0; t < nt; t += 2) {
            const bool last = (t == nt - 2);
            const char* a1 = cA + (size_t)(t + 1) * kstep;
            const char* a2 = last ? nA : cA + (size_t)(t + 2) * kstep; const char* b2 = last ? nB : cB + (size_t)(t + 2) * kstep;
            const char* a3 = a2 + kstep; const char* b3 = b2 + kstep;
            if (last && has_next) S.a_ready(nxt);
            if constexpr (SP2) {
            PG8_LDB(B0, 0, 0); PG8_LDB(B1, 0, 1); PG8_SCHED; PG8_LDA(At, 0, 0); PG8_STAGE(PG8_SA(1, 1), a1 + hstep, voffA);
            PG8_WAIT_V(8); PG8_WAIT_L(0); PG8_BAR; PG8_MMA(0, 0, At, B0); PG8_MMA(0, 1, At, B1); PG8_BAR; PG8_SCHED;
            PG8_LDA(At, 0, 1); PG8_STAGE(PG8_SB(0, 0), b2, voffB); PG8_STAGE(PG8_SB(0, 1), b2 + hstep, voffB); PG8_STAGE(PG8_SA(0, 0), a2, voffA);
            PG8_WAIT_V(8); PG8_WAIT_L(0); PG8_BAR; PG8_MMA(1, 0, At, B0); PG8_MMA(1, 1, At, B1); PG8_BAR; PG8_SCHED;
            PG8_LDB(B0, 1, 0); PG8_LDB(B1, 1, 1); PG8_SCHED; PG8_LDA(At, 1, 0); PG8_STAGE(PG8_SA(0, 1), a2 + hstep, voffA);
            PG8_WAIT_V(8); PG8_WAIT_L(0); PG8_BAR; PG8_MMA(0, 0, At, B0); PG8_MMA(0, 1, At, B1); PG8_BAR; PG8_SCHED;
            PG8_LDA(At, 1, 1); PG8_STAGE(PG8_SB(1, 0), b3, voffB); PG8_STAGE(PG8_SB(1, 1), b3 + hstep, voffB); PG8_STAGE(PG8_SA(1, 0), a3, voffA);
            PG8_WAIT_V(8); PG8_WAIT_L(0); PG8_BAR; PG8_MMA(1, 0, At, B0); PG8_MMA(1, 1, At, B1); PG8_BAR; PG8_SCHED;
            } else {
            PG8_LDB(B0, 0, 0); PG8_SCHED; PG8_LDA(At, 0, 0); PG8_STAGE(PG8_SA(1, 1), a1 + hstep, voffA);
            PG8_WAIT_L(8); PG8_BAR; PG8_WAIT_L(0); PG8_MMA(0, 0, At, B0); PG8_BAR; PG8_SCHED;
            PG8_LDB(B1, 0, 1); PG8_STAGE(PG8_SB(0, 0), b2, voffB);
            PG8_BAR; PG8_WAIT_L(0); PG8_MMA(0, 1, At, B1); PG8_BAR;
            PG8_LDA(At, 0, 1); PG8_STAGE(PG8_SA(0, 0), a2, voffA);
            PG8_BAR; PG8_WAIT_L(0); PG8_MMA(1, 0, At, B0); PG8_BAR; PG8_SCHED;
            PG8_STAGE(PG8_SB(0, 1), b2 + hstep, voffB);
            PG8_WAIT_V(6); PG8_BAR; PG8_MMA(1, 1, At, B1); PG8_BAR;
            PG8_LDB(B0, 1, 0); PG8_SCHED; PG8_LDA(At, 1, 0); PG8_STAGE(PG8_SA(0, 1), a2 + hstep, voffA);
            PG8_WAIT_L(8); PG8_BAR; PG8_WAIT_L(0); PG8_MMA(0, 0, At, B0); PG8_BAR; PG8_SCHED;
            PG8_LDB(B1, 1, 1); PG8_STAGE(PG8_SB(1, 0), b3, voffB);
            PG8_BAR; PG8_WAIT_L(0); PG8_MMA(0, 1, At, B1); PG8_BAR;
            PG8_LDA(At, 1, 1); PG8_STAGE(PG8_SA(1, 0), a3, voffA);
            PG8_BAR; PG8_WAIT_L(0); PG8_MMA(1, 0, At, B0); PG8_BAR; PG8_SCHED;
            PG8_STAGE(PG8_SB(1, 1), b3 + hstep, voffB);
            PG8_WAIT_V(6); PG8_BAR; PG8_MMA(1, 1, At, B1); PG8_BAR;
            }
        }
        if constexpr (ALIGN_EPI) { if (wr == 0) PG8_BAR; }
        if constexpr (!Epi::AFTER_DRAIN) { E(acc, cur, wr, wc, fr, fq); S.done(cur); }
        if (!has_next) break;
#pragma unroll
        for (int a = 0; a < 2; ++a)
#pragma unroll
            for (int b = 0; b < 2; ++b)
#pragma unroll
                for (int m = 0; m < 4; ++m)
#pragma unroll
                    for (int n = 0; n < 2; ++n) acc[a][b][m][n] = (f32x4){0.f, 0.f, 0.f, 0.f};
        cur = nxt; cA = nA; cB = nB; ++ui;
        if constexpr (ALIGN_EPI) { if (wr == 1) PG8_BAR; }
    }
    PG8_WAIT_V(0);
    if constexpr (!ALIGN_EPI) { if (wr == 0) PG8_BAR; }
    PG8_BAR;
#undef PG8_SA
#undef PG8_SB
#undef PG8_STAGE
#undef PG8_LDA
#undef PG8_LDB
#undef PG8_MMA
#undef PG8_WAIT_V
#undef PG8_WAIT_L
#undef PG8_BAR
#undef PG8_SCHED
}
}

constexpr int NWAVES = 8, NT = 512;
constexpr int DM = 1024, M_CTX = 4096, M_LAT = 8192, MTOK = 12288, DEPTH = 2;
constexpr int ZP = 2816, FF = 2816, NGU = 5632, IN_COLS = 2736;
constexpr int Z_AQ = 0, Z_AK = 256, Z_AV = 384, Z_BQ = 512, Z_BK = 768, Z_BV = 1024, Z_CQKV = 1280, Z_CG = 2048, Z_CA = 2304, Z_CB = 2312, Z_DCQ = 2320, Z_DCKV = 2576, Z_DKR = 2704;
constexpr int NCACHE = 4096;
constexpr int KVROWS = MTOK + NCACHE;
constexpr float LOG2E = 1.4426950408889634f;
constexpr float MLA_SCALE = 0.10206207261596577f;
enum { I_XP = 0, I_XS, I_CGK, I_CGV, I_CNK, I_CNV, I_SDN, I_CCKV, I_CKR, I_C, I_CCTX, I_N1G, I_N2G, I_WMOD, I_BMOD, I_WIN, I_WOUT, I_QNG, I_KNG, I_NAB,
       I_CONV, I_ALOG, I_DTB, I_DNOG, I_MQNG, I_WQUP, I_MKVNG, I_WKVUP, I_WG, I_WU, I_WD, I_FG, N_IN };
constexpr size_t O_YP = 0, O_YS = 4194304, O_GK = 12582912, O_GV = 13631488, O_NK = 14680064, O_NV = 16777216, O_DS = 18874368, O_CKV = 19922944, O_KR = 20971520, O_END = 21233664;

constexpr size_t MiB = 1u << 20;
constexpr size_t WS_CTL = 0, CTL_ZERO_BYTES = 1 * MiB;
constexpr size_t WS_MODS = 1 * MiB;
constexpr size_t WS_ROPE = 1 * MiB + 512 * 1024;
constexpr size_t WS_W = 2 * MiB;
constexpr size_t W_IN = 0, W_OUT = W_IN + (size_t)ZP * 1024 * 2, W_GU = W_OUT + (size_t)1024 * 1024 * 2, W_D = W_GU + (size_t)NGU * 1024 * 2,
                 W_Q = W_D + (size_t)1024 * FF * 2, W_KV = W_Q + (size_t)512 * 256 * 2, W_LEND = W_KV + (size_t)512 * 256 * 2;
static_assert(W_LEND <= 25 * MiB, "weights per layer");
constexpr size_t WS_XN = 27 * MiB;
constexpr size_t WS_UT = 27 * MiB, WS_WN = 39 * MiB;
constexpr size_t WS_Z = 51 * MiB;
constexpr size_t WS_O = 117 * MiB;
constexpr size_t WS_QA = 141 * MiB, WS_KA = 147 * MiB, WS_VA = 151 * MiB;
constexpr size_t WS_DQ = 155 * MiB, WS_DK = 161 * MiB, WS_DV = 167 * MiB;
constexpr size_t WS_BG = 173 * MiB;
constexpr size_t WS_QN = 174 * MiB;
constexpr size_t WS_CKV = 180 * MiB;
constexpr size_t WS_KR = 188 * MiB;
constexpr size_t WS_QM = 189 * MiB;
constexpr size_t WS_KV = 201 * MiB;
constexpr size_t WS_NKB = 217 * MiB, WS_NVB = 219 * MiB;
constexpr size_t WS_ODN = 221 * MiB;
constexpr size_t WS_QKG = 233 * MiB;
constexpr size_t WS_KT = 245 * MiB;
constexpr size_t WS_GC = 251 * MiB;
constexpr size_t WS_END = 252 * MiB;
constexpr int CW_BAR = 4096;

constexpr int RING_BYTES = 131072, LDSCTL_OFF = RING_BYTES, MISC_OFF = LDSCTL_OFF + 320, LDS_BYTES = 147456;

#define GAS __attribute__((address_space(1)))
#define LAS __attribute__((address_space(3)))
typedef unsigned short bf16;
typedef unsigned v4u __attribute__((ext_vector_type(4)));
typedef unsigned v2u __attribute__((ext_vector_type(2)));
typedef float f32x4 __attribute__((ext_vector_type(4)));
__device__ __forceinline__ unsigned f2bf(float f) { unsigned u = __builtin_bit_cast(unsigned, f); return (u + 0x7fffu + ((u >> 16) & 1u)) >> 16; }
__device__ __forceinline__ unsigned pk2(float lo, float hi) { return f2bf(lo) | (f2bf(hi) << 16); }
__device__ __forceinline__ float bf2f(bf16 h) { return __uint_as_float((unsigned)h << 16); }
__device__ __forceinline__ float bflo(unsigned u) { return __uint_as_float(u << 16); }
__device__ __forceinline__ float bfhi(unsigned u) { return __uint_as_float(u & 0xffff0000u); }
#define LDS_WAIT() asm volatile("s_waitcnt lgkmcnt(0)" ::: "memory")

#define XB_TMO      128
#define XB_XCNT(j)  (256  + 64 * (j))
#define XB_XSUB(j)  (1280 + 64 * (j))
#define XB_XGEN(j)  (2304 + 64 * (j))
#define XB_TOP      3328
#define XB_TOPGEN   3392
#define XCD_BAR_WORDS 3456
#define XB_SPIN_CAP (1u << 18)
__device__ __forceinline__ unsigned xb_ld(unsigned* p)              { return __hip_atomic_load(p, __ATOMIC_RELAXED, __HIP_MEMORY_SCOPE_AGENT); }
__device__ __forceinline__ unsigned xb_add(unsigned* p, unsigned v) { return __hip_atomic_fetch_add(p, v, __ATOMIC_RELAXED, __HIP_MEMORY_SCOPE_AGENT); }
__device__ __forceinline__ unsigned xb_xcc_id() { return (unsigned)__builtin_amdgcn_s_getreg((3 << 11) | 20) & 0xFu; }
#define XB_SPIN(cond, bar) do { unsigned _sp = 0; while (cond) { __builtin_amdgcn_s_sleep(1); \
    if ((++_sp & 255u) == 0u) { if (xb_ld(&(bar)[XB_TMO])) break; if (_sp > XB_SPIN_CAP) { atomicAdd(&(bar)[XB_TMO], 1u); break; } } } } while (0)
struct XcdBarrier { unsigned* bar; unsigned x; volatile LAS unsigned* st; };
__device__ __forceinline__ XcdBarrier xcd_barrier_post(unsigned* bar, volatile LAS unsigned* st) {
    XcdBarrier b; b.bar = bar; b.x = xb_xcc_id(); b.st = st;
    if (threadIdx.x == 0) (void)xb_add(&bar[XB_XCNT(b.x)], 1u);
    return b;
}
__device__ __forceinline__ void xcd_barrier_complete(unsigned* bar, unsigned x, unsigned& nloc, unsigned& nx) {
    const unsigned G = gridDim.x * gridDim.y * gridDim.z;
    unsigned sum, cnt, mine, sp = 0u;
    for (;;) {
        sum = 0u; cnt = 0u; mine = 0u;
#pragma unroll
        for (unsigned j = 0; j < 16; ++j) { const unsigned c = xb_ld(&bar[XB_XCNT(j)]); sum += c; cnt += (c > 0u) ? 1u : 0u; mine = (j == x) ? c : mine; }
        if (sum == G) break;
        __builtin_amdgcn_s_sleep(1);
        if ((++sp & 255u) == 0u) { if (xb_ld(&bar[XB_TMO])) break; if (sp > XB_SPIN_CAP) { atomicAdd(&bar[XB_TMO], 1u); break; } }
    }
    nloc = mine > 0u ? mine : 1u; nx = cnt > 0u ? cnt : 1u;
}
__device__ __forceinline__ void xcd_barrier(const XcdBarrier& b) {
    asm volatile("s_waitcnt vmcnt(0)" ::: "memory");
    __syncthreads();
    if (threadIdx.x == 0) {
        unsigned* bar = b.bar;
        __builtin_amdgcn_s_waitcnt(0);
        unsigned nloc = b.st[0], nx = b.st[1];
        if (nloc == 0u) { xcd_barrier_complete(bar, b.x, nloc, nx); b.st[0] = nloc; b.st[1] = nx; }
        const unsigned old = xb_add(&bar[XB_XSUB(b.x)], 1u);
        const unsigned gen = old / nloc;
        if (old + 1u == (gen + 1u) * nloc) {
            __builtin_amdgcn_fence(__ATOMIC_RELEASE, "agent");
            asm volatile("s_waitcnt vmcnt(0)" ::: "memory");
            const unsigned og = xb_add(&bar[XB_TOP], 1u);
            const unsigned tg = og / nx;
            if (og + 1u == (tg + 1u) * nx) xb_add(&bar[XB_TOPGEN], 1u);
            else XB_SPIN(xb_ld(&bar[XB_TOPGEN]) == tg, bar);
            __builtin_amdgcn_fence(__ATOMIC_ACQUIRE, "agent");
            xb_add(&bar[XB_XGEN(b.x)], 1u);
            asm volatile("s_waitcnt vmcnt(0)" ::: "memory");
        } else {
            XB_SPIN(xb_ld(&bar[XB_XGEN(b.x)]) == gen, bar);
            __builtin_amdgcn_fence(__ATOMIC_ACQUIRE, "agent");
            asm volatile("s_waitcnt vmcnt(0)" ::: "memory");
        }
    }
    __syncthreads();
}

struct Args { const float* in[N_IN]; float* out; unsigned char* ws; int ph_lo, ph_hi; };
struct Frame {
    LAS unsigned char* lds;
    int tid, lane, wave, G, bid;
    const float* const* in; float* out; unsigned char* ws;
};
__device__ __forceinline__ float wave_sum(float v) {
#pragma unroll
    for (int o = 1; o < 64; o <<= 1) v += __shfl_xor(v, o);
    return v;
}
__device__ __forceinline__ float silu_f(float x) { return x / (1.0f + __expf(-x)); }

__device__ __forceinline__ void p0_transpose_item(const float* W, int K, int Nsrc, int Npad, int KP, bf16* WT, int row_off, int rmul, LAS float* scr, int item, int lane) {
    const int nblk = Npad / 32, kb = item / nblk, nb = item % nblk, k0 = 64 * kb, n0 = 32 * nb;
    const int nn = n0 + (lane & 31);
#pragma unroll 8
    for (int i = 0; i < 32; ++i) { const int kk = 2 * i + (lane >> 5); scr[kk * 33 + (lane & 31)] = (nn < Nsrc && (k0 + kk) < K) ? W[(size_t)(k0 + kk) * Nsrc + nn] : 0.f; }
    LDS_WAIT(); asm volatile("" ::: "memory");
    const int c = lane & 7;
#pragma unroll
    for (int j = 0; j < 4; ++j) { const int n = (lane >> 3) + 8 * j; const LAS float* s = scr + (8 * c) * 33 + n;
        v4u o; o.x = pk2(s[0 * 33], s[1 * 33]); o.y = pk2(s[2 * 33], s[3 * 33]); o.z = pk2(s[4 * 33], s[5 * 33]); o.w = pk2(s[6 * 33], s[7 * 33]);
        *(v4u*)(WT + (size_t)(row_off + rmul * (n0 + n)) * KP + k0 + 8 * c) = o; }
    LDS_WAIT(); asm volatile("" ::: "memory");
}
__device__ __forceinline__ void p0a(Frame& F) {
    {
        LAS float* sc = (LAS float*)(F.lds);
        LAS float* part = (LAS float*)(F.lds + 9 * 1024 * 4);
        for (int e = F.tid; e < 9 * 1024; e += NT) { const int r = e >> 10, k = e & 1023; const float c = (r == 0) ? F.in[I_CCTX][k] : F.in[I_C][(r - 1) * 1024 + k]; sc[e] = silu_f(c); }
        __syncthreads();
        for (int it = F.bid; it < 2 * 96; it += F.G) {
            const int l = it / 96, n0 = (it % 96) * 64;
            const float* w = F.in[I_WMOD] + (size_t)l * 1024 * 6144 + n0 + F.lane;
            float acc[9];
#pragma unroll
            for (int r = 0; r < 9; ++r) acc[r] = 0.f;
            const int kb = F.wave * 128;
#pragma unroll 8
            for (int k = 0; k < 128; ++k) { const float wv = w[(size_t)(kb + k) * 6144];
#pragma unroll
                for (int r = 0; r < 9; ++r) acc[r] += sc[r * 1024 + kb + k] * wv; }
#pragma unroll
            for (int r = 0; r < 9; ++r) part[(F.wave * 9 + r) * 64 + F.lane] = acc[r];
            __syncthreads();
            for (int e = F.tid; e < 9 * 64; e += NT) { const int r = e >> 6, c = e & 63; float s = 0.f;
#pragma unroll
                for (int w8 = 0; w8 < 8; ++w8) s += part[(w8 * 9 + r) * 64 + c];
                ((float*)(F.ws + WS_MODS))[(size_t)(l * 9 + r) * 6144 + n0 + c] = s + F.in[I_BMOD][l * 6144 + n0 + c]; }
            __syncthreads();
        }
    }
    if (F.bid == F.G - 1) {
        float* tab = (float*)(F.ws + WS_ROPE);
        for (int e = F.tid; e < 64 * 16 + 64 * 8; e += NT) {
            int pos, i, half; float* dst;
            if (e < 1024) { pos = e >> 4; i = e & 15; half = 16; dst = tab + 2 * e; } else { const int e2 = e - 1024; pos = e2 >> 3; i = e2 & 7; half = 8; dst = tab + 2048 + 2 * e2; }
            const float inv = exp2f(-(float)i / (float)half * 13.287712379549449f);
            const float ang = (float)pos * inv;
            const double twopi = 6.283185307179586476925; const double a = (double)ang; const double kq = __builtin_rint(a / twopi); const float rr = (float)(a - kq * twopi);
            dst[0] = __builtin_cosf(rr); dst[1] = __builtin_sinf(rr);
        }
    }
    __syncthreads();
}
__device__ __forceinline__ void convert_weights(Frame& F, int l) {
    LAS float* scr = (LAS float*)(F.lds + F.wave * 16384);
    const int gw = F.bid * NWAVES + F.wave, NGW = F.G * NWAVES;
    constexpr int I_IN = 16 * 88, I_OUT = 16 * 32, I_G = 16 * 88, I_U = 16 * 88, I_D = 44 * 32, I_Q = 4 * 16, I_KV = 4 * 16;
    constexpr int PER_L = I_IN + I_OUT + I_G + I_U + I_D + I_Q + I_KV;
    unsigned char* wl = F.ws + WS_W;
    for (int it = gw; it < PER_L; it += NGW) {
        int r = it;
        if (r < I_IN) { p0_transpose_item(F.in[I_WIN] + (size_t)l * 1024 * IN_COLS, 1024, IN_COLS, ZP, 1024, (bf16*)(wl + W_IN), 0, 1, scr, r, F.lane); continue; } r -= I_IN;
        if (r < I_OUT) { p0_transpose_item(F.in[I_WOUT] + (size_t)l * 1024 * 1024, 1024, 1024, 1024, 1024, (bf16*)(wl + W_OUT), 0, 1, scr, r, F.lane); continue; } r -= I_OUT;
        if (r < I_G) { p0_transpose_item(F.in[I_WG] + (size_t)l * 1024 * FF, 1024, FF, FF, 1024, (bf16*)(wl + W_GU), 0, 2, scr, r, F.lane); continue; } r -= I_G;
        if (r < I_U) { p0_transpose_item(F.in[I_WU] + (size_t)l * 1024 * FF, 1024, FF, FF, 1024, (bf16*)(wl + W_GU), 1, 2, scr, r, F.lane); continue; } r -= I_U;
        if (r < I_D) { p0_transpose_item(F.in[I_WD] + (size_t)l * FF * 1024, FF, 1024, 1024, FF, (bf16*)(wl + W_D), 0, 1, scr, r, F.lane); continue; } r -= I_D;
        if (r < I_Q) { p0_transpose_item(F.in[I_WQUP] + (size_t)l * 256 * 384, 256, 384, 512, 256, (bf16*)(wl + W_Q), 0, 1, scr, r, F.lane); continue; } r -= I_Q;
        p0_transpose_item(F.in[I_WKVUP] + (size_t)l * 128 * 512, 128, 512, 512, 256, (bf16*)(wl + W_KV), 0, 1, scr, r, F.lane);
    }
}

__device__ __forceinline__ const float* xrow_ptr(Frame& F, int m, bool from_in) {
    if (from_in) return m < M_CTX ? F.in[I_XP] + (size_t)m * DM : F.in[I_XS] + (size_t)(m - M_CTX) * DM;
    return F.out + (size_t)m * DM;
}
template <int MODE> __device__ __forceinline__ void norm_rows(Frame& F, bool from_in, const float* g, const float* mods_l  , int sh_off, int sc_off) {
    const int gw = F.bid * NWAVES + F.wave, NGW = F.G * NWAVES;
    for (int m = gw; m < MTOK; m += NGW) {
        const f32x4* xr = (const f32x4*)xrow_ptr(F, m, from_in) + F.lane;
        f32x4 v[4]; float s = 0.f;
#pragma unroll
        for (int j = 0; j < 4; ++j) { v[j] = xr[64 * j]; s += (v[j].x * v[j].x + v[j].y * v[j].y) + (v[j].z * v[j].z + v[j].w * v[j].w); }
        const float rstd = 1.0f / sqrtf(wave_sum(s) * (1.f / DM) + 1e-6f);
        if (MODE == 0) {
            const int rmod = m < M_CTX ? 0 : 1 + ((m - M_CTX) >> 10);
            const float* mr = mods_l + (size_t)rmod * 6144;
            unsigned long long* o8 = (unsigned long long*)((bf16*)(F.ws + WS_XN) + (size_t)m * DM) + F.lane;
#pragma unroll
            for (int j = 0; j < 4; ++j) { const int c = 4 * F.lane + 256 * j; const f32x4 gg = *(const f32x4*)(g + c), sh = *(const f32x4*)(mr + sh_off + c), sc = *(const f32x4*)(mr + sc_off + c);
                const f32x4 y = (v[j] * rstd * gg) * (sc + 1.0f) + sh;
                o8[64 * j] = (unsigned long long)pk2(y.x, y.y) | ((unsigned long long)pk2(y.z, y.w) << 32); }
        } else {
            f32x4* yo = (f32x4*)(F.out + (size_t)m * DM) + F.lane;
#pragma unroll
            for (int j = 0; j < 4; ++j) { const int c = 4 * F.lane + 256 * j; const f32x4 gg = *(const f32x4*)(g + c); yo[64 * j] = v[j] * rstd * gg; }
        }
    }
}

__device__ __forceinline__ void prep_phase(Frame& F, int l) {
    const int gw = F.bid * NWAVES + F.wave, NGW = F.G * NWAVES, lane = F.lane;
    const bf16* Z = (const bf16*)(F.ws + WS_Z);
    bf16* QA = (bf16*)(F.ws + WS_QA); bf16* KA = (bf16*)(F.ws + WS_KA); bf16* VA = (bf16*)(F.ws + WS_VA);
    bf16* DQ = (bf16*)(F.ws + WS_DQ); bf16* DK = (bf16*)(F.ws + WS_DK); bf16* DV = (bf16*)(F.ws + WS_DV);
    float* BG = (float*)(F.ws + WS_BG);
    bf16* QN = (bf16*)(F.ws + WS_QN); bf16* CKV = (bf16*)(F.ws + WS_CKV); bf16* KR = (bf16*)(F.ws + WS_KR);
    const float* tabA = (const float*)(F.ws + WS_ROPE); const float* tabM = tabA + 2048;
    const float qn_g = F.in[I_QNG][l * 64 + lane], kn_g = F.in[I_KNG][l * 64 + lane];
    for (int it = gw; it < MTOK + NCACHE; it += NGW) {
        if (it >= MTOK) {
            const int cr = it - MTOK, b = cr >> 9, j = cr & 511; const size_t src = (size_t)((b * 2 + l) * 512 + j);
            const int krow = M_CTX + b * 1536 + j;
            const float* gk = F.in[I_CGK] + src * 128; const float* gv = F.in[I_CGV] + src * 128; const float* ck = F.in[I_CCKV] + src * 128; const float* kr = F.in[I_CKR] + src * 32;
            KA[(size_t)krow * 128 + lane] = (bf16)f2bf(gk[lane]); KA[(size_t)krow * 128 + 64 + lane] = (bf16)f2bf(gk[64 + lane]);
            VA[(size_t)krow * 128 + lane] = (bf16)f2bf(gv[lane]); VA[(size_t)krow * 128 + 64 + lane] = (bf16)f2bf(gv[64 + lane]);
            CKV[(size_t)it * 256 + lane] = (bf16)f2bf(ck[lane]); CKV[(size_t)it * 256 + 64 + lane] = (bf16)f2bf(ck[64 + lane]);
            CKV[(size_t)it * 256 + 128 + lane] = 0; CKV[(size_t)it * 256 + 192 + lane] = 0;
            if (lane < 32) KR[(size_t)it * 32 + lane] = (bf16)f2bf(kr[lane]);
            { const float* nk = F.in[I_CNK] + src * 256; const float* nv = F.in[I_CNV] + src * 256; bf16* NKB = (bf16*)(F.ws + WS_NKB) + (size_t)cr * 256; bf16* NVB = (bf16*)(F.ws + WS_NVB) + (size_t)cr * 256;
#pragma unroll
              for (int i = 0; i < 4; ++i) { NKB[i * 64 + lane] = (bf16)f2bf(nk[i * 64 + lane]); NVB[i * 64 + lane] = (bf16)f2bf(nv[i * 64 + lane]); } }
            continue;
        }
        const int m = it; const bool lat = m >= M_CTX;
        const int b = lat ? (m - M_CTX) >> 10 : m >> 8, t = lat ? (m - M_CTX) & 1023 : m & 255, L = lat ? 1024 : 256;
        const int pr = t >> 6, pc = t & 63;
        const bf16* zr = Z + (size_t)m * ZP;
        const size_t orow = (size_t)((b * 2 + l) * 256 + t);
        for (int hq = 0; hq < 4; ++hq) {
            const float x = bf2f(zr[Z_AQ + hq * 64 + lane]); const float ss = wave_sum(x * x);
            float y = x * (1.0f / sqrtf(ss * (1.f / 64.f) + 1e-6f)) * qn_g;
            if (lat) { const float yp = __shfl_xor(y, 16); const int pos = lane < 32 ? pr : pc; const float* cs = tabA + (pos * 16 + (lane & 15)) * 2;
                y = (lane & 16) ? y * cs[0] + yp * cs[1] : y * cs[0] - yp * cs[1]; }
            QA[(size_t)m * 256 + hq * 64 + lane] = (bf16)f2bf(y);
        }
        const int krow = lat ? M_CTX + b * 1536 + 512 + t : m;
        for (int kh = 0; kh < 2; ++kh) {
            const float x = bf2f(zr[Z_AK + kh * 64 + lane]); const float ss = wave_sum(x * x);
            float y = x * (1.0f / sqrtf(ss * (1.f / 64.f) + 1e-6f)) * kn_g;
            if (!lat) F.out[O_GK + orow * 128 + kh * 64 + lane] = y;
            if (lat) { const float yp = __shfl_xor(y, 16); const int pos = lane < 32 ? pr : pc; const float* cs = tabA + (pos * 16 + (lane & 15)) * 2;
                y = (lane & 16) ? y * cs[0] + yp * cs[1] : y * cs[0] - yp * cs[1]; }
            KA[(size_t)krow * 128 + kh * 64 + lane] = (bf16)f2bf(y);
            const bf16 vb = zr[Z_AV + kh * 64 + lane];
            VA[(size_t)krow * 128 + kh * 64 + lane] = vb;
            if (!lat) F.out[O_GV + orow * 128 + kh * 64 + lane] = bf2f(vb);
        }
        if (!lat) {
#pragma unroll
            for (int i = 0; i < 4; ++i) { F.out[O_NK + orow * 256 + i * 64 + lane] = bf2f(zr[Z_BK + i * 64 + lane]); F.out[O_NV + orow * 256 + i * 64 + lane] = bf2f(zr[Z_BV + i * 64 + lane]); }
        }
        for (int g = 0; g < 12; ++g) {
            const int ch = g * 64 + lane; float acc = 0.f;
#pragma unroll
            for (int j = 0; j < 4; ++j) { const int tt = t + j - 1; if (tt >= 0 && tt < L) acc += F.in[I_CONV][(size_t)(l * 4 + j) * 768 + ch] * bf2f(zr[(ptrdiff_t)(j - 1) * ZP + Z_CQKV + ch]); }
            float y = silu_f(acc);
            if (g < 8) { const float ss = wave_sum(y * y); y *= 1.0f / sqrtf(ss + 1e-6f); if (g < 4) y *= 0.125f; }
            bf16* dst = g < 4 ? DQ : (g < 8 ? DK : DV);
            dst[(size_t)m * 256 + (ch & 255)] = (bf16)f2bf(y);
        }
        if (lane < 8) {
            const float a = bf2f(zr[Z_CA + lane]), bb = bf2f(zr[Z_CB + lane]);
            const float beta = 1.0f / (1.0f + __expf(-bb));
            const float xx = a + F.in[I_DTB][l * 8 + lane];
            const float sp = fmaxf(xx, 0.f) + log1pf(__expf(-fabsf(xx)));
            BG[(size_t)m * 16 + lane] = beta; BG[(size_t)m * 16 + 8 + lane] = -__expf(F.in[I_ALOG][l * 8 + lane]) * sp;
        }
        {
            float x[4]; float ss = 0.f;
#pragma unroll
            for (int i = 0; i < 4; ++i) { x[i] = bf2f(zr[Z_DCQ + i * 64 + lane]); ss += x[i] * x[i]; }
            const float rstd = 1.0f / sqrtf(wave_sum(ss) * (1.f / 256.f) + 1e-6f);
#pragma unroll
            for (int i = 0; i < 4; ++i) QN[(size_t)m * 256 + i * 64 + lane] = (bf16)f2bf(x[i] * rstd * F.in[I_MQNG][l * 256 + i * 64 + lane]);
            const float c0 = bf2f(zr[Z_DCKV + lane]), c1 = bf2f(zr[Z_DCKV + 64 + lane]);
            const float r2 = 1.0f / sqrtf(wave_sum(c0 * c0 + c1 * c1) * (1.f / 128.f) + 1e-6f);
            const float y0 = c0 * r2 * F.in[I_MKVNG][l * 128 + lane], y1 = c1 * r2 * F.in[I_MKVNG][l * 128 + 64 + lane];
            CKV[(size_t)m * 256 + lane] = (bf16)f2bf(y0); CKV[(size_t)m * 256 + 64 + lane] = (bf16)f2bf(y1); CKV[(size_t)m * 256 + 128 + lane] = 0; CKV[(size_t)m * 256 + 192 + lane] = 0;
            if (!lat) { F.out[O_CKV + orow * 128 + lane] = y0; F.out[O_CKV + orow * 128 + 64 + lane] = y1; }
            const int d = lane & 31; float kr = bf2f(zr[Z_DKR + d]);
            if (!lat) { if (lane < 32) F.out[O_KR + orow * 32 + d] = kr; }
            else { const float kp = __shfl_xor(kr, 8); const int pos = d < 16 ? pr : pc; const float* cs = tabM + (pos * 8 + (d & 7)) * 2;
                kr = (d & 8) ? kr * cs[0] + kp * cs[1] : kr * cs[0] - kp * cs[1]; }
            if (lane < 32) KR[(size_t)m * 32 + d] = (bf16)f2bf(kr);
        }
    }
}

typedef short bf16x8 __attribute__((ext_vector_type(8)));
typedef float f32x16 __attribute__((ext_vector_type(16)));
typedef float f32x2_t __attribute__((ext_vector_type(2))); typedef __bf16 bf16x2_t __attribute__((ext_vector_type(2)));
__device__ __forceinline__ unsigned cvtpk(float lo, float hi) { f32x2_t v = {lo, hi}; bf16x2_t b = __builtin_convertvector(v, bf16x2_t); return __builtin_bit_cast(unsigned, b); }
struct AttDesc {
    const bf16* Q; int qs; int qrow0;
    const bf16 *K0, *K1, *R0, *R1, *V0, *V1; int ks0, ks1, rs0, rs1, vs0, vs1;
    int row00, row01, nt0, nt;
    bf16* O; float scale;
    int qpos0;
    int rlo; const float* nab;
};
constexpr int ATT_KT = 0, ATT_VT = 16384, ATT_NB = 28672, ATT_VROW = 68;
template <int DK, bool NA, bool QROPE>
__device__ __forceinline__ void attn_block(Frame& F, const AttDesc& D) {
    constexpr int KROWB = (DK + 8) * 2, NS = DK / 16;
    const int tid = F.tid, lane = F.lane, w = F.wave, lq = lane & 31, hh = lane >> 5;
    LAS unsigned char* lds = F.lds;
    __syncthreads();
    if constexpr (NA) { for (int e = tid; e < 465; e += NT) ((LAS float*)(lds + ATT_NB))[e] = D.nab[e] * LOG2E; }
    const int qrow = D.qrow0 + 32 * w + lq;
    bf16x8 qf[NS];
#pragma unroll
    for (int s = 0; s < NS; ++s) qf[s] = *(const bf16x8*)(D.Q + (size_t)qrow * D.qs + 16 * s + 8 * hh);
    if constexpr (QROPE) {
        const float* tabM = (const float*)(F.ws + WS_ROPE) + 2048; const int n = D.qpos0 + 32 * w + lq;
#pragma unroll
        for (int sx = 4; sx < 6; ++sx) { const int pos = sx == 4 ? (n >> 6) : (n & 63); const v4u qw = __builtin_bit_cast(v4u, qf[sx]); float res[8];
#pragma unroll
            for (int j = 0; j < 8; ++j) { const unsigned dw = qw[j >> 1]; const float own = (j & 1) ? bfhi(dw) : bflo(dw); const float oth = __shfl_xor(own, 32);
                const float c = tabM[(pos * 8 + j) * 2], sn = tabM[(pos * 8 + j) * 2 + 1]; res[j] = hh ? own * c + oth * sn : own * c - oth * sn; }
            v4u nw; nw.x = cvtpk(res[0], res[1]); nw.y = cvtpk(res[2], res[3]); nw.z = cvtpk(res[4], res[5]); nw.w = cvtpk(res[6], res[7]); qf[sx] = __builtin_bit_cast(bf16x8, nw); }
    }
    const int na_r = (D.qpos0 >> 6) + (w >> 1), na_c = (w & 1) * 32 + lq, na_r0 = min(max(na_r - 4, 0), 8), na_c0 = min(max(na_c - 8, 0), 48);
    f32x16 o0, o1;
#pragma unroll
    for (int r = 0; r < 16; ++r) { o0[r] = 0.f; o1[r] = 0.f; }
    float m = -1e30f, lsum = 0.f;
    v4u kreg, rreg = (v4u){0u, 0u, 0u, 0u}, vreg;
#define ATT_LOAD(t_) do { const int t__ = (t_); const bool sg = t__ >= D.nt0; const int r0_ = sg ? D.row01 + 64 * (t__ - D.nt0) : D.row00 + 64 * t__; \
        const bf16* Kb = sg ? D.K1 : D.K0; const bf16* Vb = sg ? D.V1 : D.V0; const int ks_ = sg ? D.ks1 : D.ks0, vs_ = sg ? D.vs1 : D.vs0; \
        kreg = *(const v4u*)(Kb + (size_t)(r0_ + (tid >> 3)) * ks_ + (tid & 7) * 8); \
        if constexpr (DK == 96) { if (tid < 256) { const bf16* Rb = sg ? D.R1 : D.R0; const int rs_ = sg ? D.rs1 : D.rs0; rreg = *(const v4u*)(Rb + (size_t)(r0_ + (tid >> 2)) * rs_ + (tid & 3) * 8); } } \
        vreg = *(const v4u*)(Vb + (size_t)(r0_ + lane) * vs_ + w * 8); } while (0)
    ATT_LOAD(0);
    for (int t = 0; t < D.nt; ++t) {
        __syncthreads();
        *(LAS v4u*)(lds + ATT_KT + (tid >> 3) * KROWB + (tid & 7) * 16) = kreg;
        if constexpr (DK == 96) { if (tid < 256) *(LAS v4u*)(lds + ATT_KT + (tid >> 2) * KROWB + 128 + (tid & 3) * 16) = rreg; }
        { LAS bf16* vt = (LAS bf16*)(lds + ATT_VT) + (8 * w) * ATT_VROW + lane;
#pragma unroll
          for (int i = 0; i < 8; ++i) { const unsigned dw = vreg[i >> 1]; vt[i * ATT_VROW] = (bf16)((i & 1) ? (dw >> 16) : (dw & 0xffffu)); } }
        __syncthreads();
        if (t + 1 < D.nt) ATT_LOAD(t + 1);
        bool rel = true; int kr = 0; bool local = false;
        if constexpr (NA) { if (t >= D.nt0) { local = true; kr = D.rlo + (t - D.nt0); rel = (kr >= na_r0) && (kr < na_r0 + 8); } }
        if (rel) {
            f32x16 s0, s1;
#pragma unroll
            for (int r = 0; r < 16; ++r) { s0[r] = 0.f; s1[r] = 0.f; }
#pragma unroll
            for (int s = 0; s < NS; ++s) {
                const bf16x8 a0 = *(const LAS bf16x8*)(lds + ATT_KT + lq * KROWB + 32 * s + 16 * hh);
                const bf16x8 a1 = *(const LAS bf16x8*)(lds + ATT_KT + (32 + lq) * KROWB + 32 * s + 16 * hh);
                s0 = __builtin_amdgcn_mfma_f32_32x32x16_bf16(a0, qf[s], s0, 0, 0, 0);
                s1 = __builtin_amdgcn_mfma_f32_32x32x16_bf16(a1, qf[s], s1, 0, 0, 0);
            }
            float tmax = -1e30f;
            if (NA && local) {
                const LAS float* nbp = (const LAS float*)(lds + ATT_NB) + (kr - na_r + 7) * 31 + 15 - na_c;
#pragma unroll
                for (int r = 0; r < 16; ++r) { const int kc0 = (r & 3) + 8 * (r >> 2) + 4 * hh, kc1 = kc0 + 32;
                    const bool al0 = (unsigned)(kc0 - na_c0) < 16u, al1 = (unsigned)(kc1 - na_c0) < 16u;
                    const float b0 = nbp[al0 ? kc0 : na_c], b1 = nbp[al1 ? kc1 : na_c];
                    s0[r] = al0 ? s0[r] * D.scale + b0 : -1e30f; s1[r] = al1 ? s1[r] * D.scale + b1 : -1e30f;
                    tmax = fmaxf(tmax, fmaxf(s0[r], s1[r])); }
            } else {
#pragma unroll
                for (int r = 0; r < 16; ++r) { s0[r] *= D.scale; s1[r] *= D.scale; tmax = fmaxf(tmax, fmaxf(s0[r], s1[r])); }
            }
            tmax = fmaxf(tmax, __shfl_xor(tmax, 32));
            const float mn = fmaxf(m, tmax); const float corr = __builtin_amdgcn_exp2f(m - mn); m = mn;
            float ps = 0.f;
#pragma unroll
            for (int r = 0; r < 16; ++r) { s0[r] = __builtin_amdgcn_exp2f(s0[r] - mn); s1[r] = __builtin_amdgcn_exp2f(s1[r] - mn); ps += s0[r] + s1[r]; }
            lsum = lsum * corr + ps;
#pragma unroll
            for (int r = 0; r < 16; ++r) { o0[r] *= corr; o1[r] *= corr; }
            bf16x8 pf[2][2];
#pragma unroll
            for (int s = 0; s < 2; ++s) { v4u p0, p1;
                p0.x = cvtpk(s0[8 * s + 0], s0[8 * s + 1]); p0.y = cvtpk(s0[8 * s + 2], s0[8 * s + 3]); p0.z = cvtpk(s0[8 * s + 4], s0[8 * s + 5]); p0.w = cvtpk(s0[8 * s + 6], s0[8 * s + 7]);
                p1.x = cvtpk(s1[8 * s + 0], s1[8 * s + 1]); p1.y = cvtpk(s1[8 * s + 2], s1[8 * s + 3]); p1.z = cvtpk(s1[8 * s + 4], s1[8 * s + 5]); p1.w = cvtpk(s1[8 * s + 6], s1[8 * s + 7]);
                pf[0][s] = __builtin_bit_cast(bf16x8, p0); pf[1][s] = __builtin_bit_cast(bf16x8, p1); }
#pragma unroll
            for (int kt = 0; kt < 2; ++kt)
#pragma unroll
                for (int s = 0; s < 2; ++s) {
                    const LAS unsigned char* vb0 = lds + ATT_VT + lq * (ATT_VROW * 2) + 8 * hh + 64 * kt + 32 * s;
                    const LAS unsigned char* vb1 = vb0 + 32 * (ATT_VROW * 2);
                    const v2u l0 = *(const LAS v2u*)(vb0), h0 = *(const LAS v2u*)(vb0 + 16), l1 = *(const LAS v2u*)(vb1), h1 = *(const LAS v2u*)(vb1 + 16);
                    const v4u a0 = {l0.x, l0.y, h0.x, h0.y}, a1 = {l1.x, l1.y, h1.x, h1.y};
                    o0 = __builtin_amdgcn_mfma_f32_32x32x16_bf16(__builtin_bit_cast(bf16x8, a0), pf[kt][s], o0, 0, 0, 0);
                    o1 = __builtin_amdgcn_mfma_f32_32x32x16_bf16(__builtin_bit_cast(bf16x8, a1), pf[kt][s], o1, 0, 0, 0);
                }
        }
    }
#undef ATT_LOAD
    lsum += __shfl_xor(lsum, 32);
    const float rl = 1.0f / lsum;
    bf16* orow = D.O + (size_t)qrow * 1024 + 4 * hh;
#pragma unroll
    for (int g = 0; g < 4; ++g) {
        v2u w0, w1; w0.x = cvtpk(o0[4 * g] * rl, o0[4 * g + 1] * rl); w0.y = cvtpk(o0[4 * g + 2] * rl, o0[4 * g + 3] * rl);
        w1.x = cvtpk(o1[4 * g] * rl, o1[4 * g + 1] * rl); w1.y = cvtpk(o1[4 * g + 2] * rl, o1[4 * g + 3] * rl);
        *(v2u*)(orow + 8 * g) = w0; *(v2u*)(orow + 32 + 8 * g) = w1;
    }
}
__device__ __forceinline__ void att_task(Frame& F, int ly, int mixer, bool lat, int b, int h, int qb) {
    const bf16* Z = (const bf16*)(F.ws + WS_Z);
    AttDesc D;
    D.qrow0 = lat ? M_CTX + b * 1024 + qb * 256 : b * 256; D.qpos0 = qb * 256; D.rlo = 0; D.nab = nullptr;
    D.R0 = nullptr; D.R1 = nullptr; D.rs0 = 0; D.rs1 = 0;
    if (mixer == 0) {
        D.Q = (const bf16*)(F.ws + WS_QA) + h * 64; D.qs = 256;
        D.K0 = D.K1 = (const bf16*)(F.ws + WS_KA) + (h >> 1) * 64; D.V0 = D.V1 = (const bf16*)(F.ws + WS_VA) + (h >> 1) * 64; D.ks0 = D.ks1 = D.vs0 = D.vs1 = 128;
        D.row00 = lat ? M_CTX + b * 1536 : b * 256; D.row01 = 0; D.nt0 = D.nt = lat ? 24 : 4;
        D.O = (bf16*)(F.ws + WS_O) + h * 64; D.scale = 0.125f * LOG2E;
        attn_block<64, false, false>(F, D);
    } else if (mixer == 1) {
        D.Q = Z + Z_BQ + h * 64; D.qs = ZP; D.O = (bf16*)(F.ws + WS_O) + 256 + h * 64; D.scale = 0.125f * LOG2E;
        D.K1 = Z + Z_BK + h * 64; D.V1 = Z + Z_BV + h * 64; D.ks1 = D.vs1 = ZP;
        if (!lat) { D.K0 = D.K1; D.V0 = D.V1; D.ks0 = D.vs0 = ZP; D.row00 = b * 256; D.row01 = 0; D.nt0 = D.nt = 4; attn_block<64, false, false>(F, D); }
        else {
            D.K0 = (const bf16*)(F.ws + WS_NKB) + h * 64; D.V0 = (const bf16*)(F.ws + WS_NVB) + h * 64; D.ks0 = D.vs0 = 256; D.row00 = b * 512; D.nt0 = 8;
            const int r_first = qb * 4, rlo = min(max(r_first - 4, 0), 8), rhi = min(max(r_first + 3 - 4, 0), 8) + 7;
            D.rlo = rlo; D.row01 = M_CTX + b * 1024 + rlo * 64; D.nt = 8 + (rhi - rlo + 1);
            D.nab = F.in[I_NAB] + (size_t)((ly * 4 + h) * 15) * 31;
            attn_block<64, true, false>(F, D);
        }
    } else {
        D.Q = (const bf16*)(F.ws + WS_QM) + h * 96; D.qs = 512; D.O = (bf16*)(F.ws + WS_O) + 768 + h * 64; D.scale = MLA_SCALE * LOG2E;
        D.K0 = D.K1 = (const bf16*)(F.ws + WS_KV) + h * 128; D.V0 = D.V1 = (const bf16*)(F.ws + WS_KV) + h * 128 + 64; D.R0 = D.R1 = (const bf16*)(F.ws + WS_KR);
        D.ks0 = D.ks1 = D.vs0 = D.vs1 = 512; D.rs0 = D.rs1 = 32;
        if (lat) { D.row00 = MTOK + b * 512; D.nt0 = 8; D.row01 = M_CTX + b * 1024; D.nt = 24; attn_block<96, false, true>(F, D); }
        else { D.row00 = b * 256; D.row01 = 0; D.nt0 = D.nt = 4; attn_block<96, false, false>(F, D); }
    }
}

constexpr int DN_KROW = 72, DN_AROW = 68;
constexpr int DNG_K = 0, DNG_Q = 9216, DNG_V = 18432, DNG_A = 27648, DNG_G = 27648 + 64 * DN_AROW * 4, DNG_BYTES = DNG_G + 1024;
static_assert(2 * DNG_BYTES <= RING_BYTES, "DeltaNet phase A LDS");
__device__ __forceinline__ int crow16(int r, int hh) { return (r & 3) + 8 * (r >> 2) + 4 * hh; }
__device__ __forceinline__ void dn_phase_a(Frame& F, int l) {
    const int tid = F.tid, lane = F.lane, lq = lane & 31, hh = lane >> 5, grp = tid >> 8, gt = tid & 255, gw = F.wave & 3;
    LAS unsigned char* gl = F.lds + grp * DNG_BYTES;
    LAS float* gsm = (LAS float*)(gl + DNG_G);
    const bf16* DQ = (const bf16*)(F.ws + WS_DQ); const bf16* DK = (const bf16*)(F.ws + WS_DK); const bf16* DV = (const bf16*)(F.ws + WS_DV); const float* BG = (const float*)(F.ws + WS_BG);
    for (int tp = F.bid; tp < 768; tp += F.G) {
        const int ta = 2 * tp + grp; const bool lat = ta < 1024;
        const int seq = lat ? ta >> 4 : 64 + ((ta - 1024) >> 2), n = lat ? ta & 15 : (ta - 1024) & 3, s2 = lat ? seq : seq - 64;
        const int b = s2 >> 3, h = (s2 >> 1) & 3, dir = s2 & 1, L = lat ? 1024 : 256, row0 = lat ? M_CTX + b * 1024 : b * 256;
        __syncthreads();
#pragma unroll
        for (int i = 0; i < 2; ++i) { const int idx = gt + 256 * i, c = idx >> 3, ch = idx & 7; const int step = 64 * n + c, t = dir ? L - 1 - step : step;
            const size_t src = (size_t)(row0 + t) * 256 + h * 64 + ch * 8;
            *(LAS v4u*)(gl + DNG_Q + c * (DN_KROW * 2) + ch * 16) = *(const v4u*)(DQ + src);
            *(LAS v4u*)(gl + DNG_K + c * (DN_KROW * 2) + ch * 16) = *(const v4u*)(DK + src);
            *(LAS v4u*)(gl + DNG_V + c * (DN_KROW * 2) + ch * 16) = *(const v4u*)(DV + src); }
        if (gw == 0) {
            const int step = 64 * n + lane, t = dir ? L - 1 - step : step; const size_t r = (size_t)(row0 + t) * 16;
            float val = BG[r + 8 + dir * 4 + h];
#pragma unroll
            for (int o = 1; o < 64; o <<= 1) { const float tt = __shfl_up(val, o); if (lane >= o) val += tt; }
            gsm[lane] = val; gsm[64 + lane] = BG[r + dir * 4 + h]; gsm[128 + lane] = __expf(val);
            ((float*)(F.ws + WS_GC))[(size_t)ta * 64 + lane] = val;
        }
        __syncthreads();
        {
            const int mat = gw >> 1, ti = gw & 1;
            const LAS unsigned char* xs = gl + (mat ? DNG_Q : DNG_K);
            const float gj0 = gsm[lq], gj1 = gsm[32 + lq];
#pragma unroll
            for (int tj = 0; tj < 2; ++tj) {
                f32x16 acc;
#pragma unroll
                for (int r = 0; r < 16; ++r) acc[r] = 0.f;
#pragma unroll
                for (int s = 0; s < 4; ++s) {
                    const bf16x8 av = *(const LAS bf16x8*)(xs + (32 * ti + lq) * (DN_KROW * 2) + 32 * s + 16 * hh);
                    const bf16x8 bv = *(const LAS bf16x8*)(gl + DNG_K + (32 * tj + lq) * (DN_KROW * 2) + 32 * s + 16 * hh);
                    acc = __builtin_amdgcn_mfma_f32_32x32x16_bf16(av, bv, acc, 0, 0, 0);
                }
                const int j = 32 * tj + lq; const float gj = tj ? gj1 : gj0;
                if (mat == 0) {
#pragma unroll
                    for (int r = 0; r < 16; ++r) { const int i = 32 * ti + crow16(r, hh); const float v = (j < i) ? gsm[64 + i] * acc[r] * __expf(gsm[i] - gj) : 0.f;
                        ((LAS float*)(gl + DNG_A))[i * DN_AROW + j] = v; }
                } else {
                    bf16* qkg = (bf16*)(F.ws + WS_QKG) + (size_t)ta * 4096;
#pragma unroll
                    for (int r = 0; r < 16; ++r) { const int i = 32 * ti + crow16(r, hh); const float v = (j <= i) ? acc[r] * __expf(gsm[i] - gj) : 0.f;
                        qkg[i * 64 + j] = (bf16)f2bf(v); }
                }
            }
        }
        __syncthreads();
        if (gw < 2) {
            const int cc = gt & 63; const bool isw = gt >= 64;
            const LAS bf16* src = (const LAS bf16*)(gl + (isw ? DNG_K : DNG_V)) + cc;
            const LAS float* As = (const LAS float*)(gl + DNG_A);
            float x[64];
#pragma unroll
            for (int i = 0; i < 64; ++i) x[i] = 0.f;
#pragma unroll
            for (int i = 0; i < 64; ++i) {
                float rv = bf2f(src[i * DN_KROW]) * gsm[64 + i]; if (isw) rv *= gsm[128 + i];
#pragma unroll
                for (int j4 = 0; j4 < (i + 3) / 4; ++j4) { const f32x4 a4 = *(const LAS f32x4*)(As + i * DN_AROW + 4 * j4);
                    rv -= a4.x * x[4 * j4]; rv -= a4.y * x[4 * j4 + 1]; rv -= a4.z * x[4 * j4 + 2]; rv -= a4.w * x[4 * j4 + 3]; }
                x[i] = rv;
                asm volatile("" : "+v"(x[i]) :: "memory");
            }
            if (!isw) {
                v4u* dst = (v4u*)((bf16*)(F.ws + WS_UT) + (size_t)ta * 4096 + cc * 64);
#pragma unroll
                for (int q8 = 0; q8 < 8; ++q8) { v4u w; w.x = pk2(x[8 * q8], x[8 * q8 + 1]); w.y = pk2(x[8 * q8 + 2], x[8 * q8 + 3]); w.z = pk2(x[8 * q8 + 4], x[8 * q8 + 5]); w.w = pk2(x[8 * q8 + 6], x[8 * q8 + 7]); dst[q8] = w; }
            } else {
                bf16* dst = (bf16*)(F.ws + WS_WN) + (size_t)ta * 4096 + cc;
#pragma unroll
                for (int i = 0; i < 64; ++i) dst[i * 64] = (bf16)f2bf(-x[i]);
            }
        } else if (dir == 0) {
            const int u = gt - 128, dk = u & 63, half = u >> 6;
            const int slot = lat ? (seq >> 1) * 16 + n : 512 + ((seq - 64) >> 1) * 4 + n;
            v4u* dst = (v4u*)((bf16*)(F.ws + WS_KT) + (size_t)slot * 4096 + dk * 64 + 32 * half);
            const LAS bf16* ks = (const LAS bf16*)(gl + DNG_K) + (32 * half) * DN_KROW + dk;
#pragma unroll
            for (int q8 = 0; q8 < 4; ++q8) { v4u w;
                w.x = (unsigned)ks[(8 * q8 + 0) * DN_KROW] | ((unsigned)ks[(8 * q8 + 1) * DN_KROW] << 16); w.y = (unsigned)ks[(8 * q8 + 2) * DN_KROW] | ((unsigned)ks[(8 * q8 + 3) * DN_KROW] << 16);
                w.z = (unsigned)ks[(8 * q8 + 4) * DN_KROW] | ((unsigned)ks[(8 * q8 + 5) * DN_KROW] << 16); w.w = (unsigned)ks[(8 * q8 + 6) * DN_KROW] | ((unsigned)ks[(8 * q8 + 7) * DN_KROW] << 16);
                dst[q8] = w; }
        }
    }
    __syncthreads();
}
__device__ __forceinline__ bf16x8 pack8(const f32x16& x, int s) {
    v4u p; p.x = cvtpk(x[8 * s + 0], x[8 * s + 1]); p.y = cvtpk(x[8 * s + 2], x[8 * s + 3]); p.z = cvtpk(x[8 * s + 4], x[8 * s + 5]); p.w = cvtpk(x[8 * s + 6], x[8 * s + 7]);
    return __builtin_bit_cast(bf16x8, p);
}
constexpr int SC_ROWB = 136, SC_TILE = 64 * SC_ROWB, SC_STAGE = 5 * SC_TILE, SC_GC = MISC_OFF + 192;
static_assert(3 * SC_STAGE <= RING_BYTES && SC_GC + 768 <= LDS_BYTES, "scan LDS");
__device__ __forceinline__ bf16x8 lds_frag(const LAS unsigned char* p) {
    const v2u lo = *(const LAS v2u*)p, hi = *(const LAS v2u*)(p + 16); const v4u a = {lo.x, lo.y, hi.x, hi.y}; return __builtin_bit_cast(bf16x8, a);
}
__device__ __forceinline__ unsigned rot16(unsigned x) { return (x >> 16) | (x << 16); }
struct ScanSeq { int b, h, dir, L, row0, nch, seq; bool lat; };
__device__ __forceinline__ void scan_ld_init(Frame& F, const ScanSeq& Q, int lt, const bf16* (&p)[7], int (&stride)[7], int (&dst)[7], const float*& gcp) {
    const int ta0 = Q.lat ? Q.seq * 16 : 1024 + (Q.seq - 64) * 4;
    const int ks0 = (Q.lat ? (Q.seq >> 1) * 16 : 512 + ((Q.seq - 64) >> 1) * 4) + (Q.dir ? Q.nch - 1 : 0);
#pragma unroll
    for (int i = 0; i < 7; ++i) {
        const int it = lt + 384 * i, tile = (it >> 9) > 4 ? 4 : (it >> 9), row = (it >> 3) & 63, ch = it & 7;
        const bf16* src; int st;
        if (tile == 0) { src = (const bf16*)(F.ws + WS_WN) + (size_t)ta0 * 4096 + row * 64 + ch * 8; st = 4096; }
        else if (tile == 1) { const int t = Q.dir ? Q.L - 1 - row : row; src = (const bf16*)(F.ws + WS_DQ) + Q.h * 64 + (size_t)(Q.row0 + t) * 256 + ch * 8; st = Q.dir ? -64 * 256 : 64 * 256; }
        else if (tile == 2) { src = (const bf16*)(F.ws + WS_QKG) + (size_t)ta0 * 4096 + row * 64 + ch * 8; st = 4096; }
        else if (tile == 3) { src = (const bf16*)(F.ws + WS_KT) + (size_t)ks0 * 4096 + row * 64 + (Q.dir ? 7 - ch : ch) * 8; st = Q.dir ? -4096 : 4096; }
        else { src = (const bf16*)(F.ws + WS_UT) + (size_t)ta0 * 4096 + row * 64 + ch * 8; st = 4096; }
        p[i] = src; stride[i] = st; dst[i] = tile * SC_TILE + row * SC_ROWB + ch * 16 + ((tile == 3 && Q.dir) ? (1 << 30) : 0);
    }
    gcp = (const float*)(F.ws + WS_GC) + (size_t)ta0 * 64 + (lt & 63);
}
__device__ __forceinline__ void scan_fetch(int lt, const bf16* (&p)[7], const int (&stride)[7], const int (&dst)[7], const float*& gcp, v4u (&r)[7], float& gcv) {
#pragma unroll
    for (int i = 0; i < 7; ++i) {
        if (i < 6 || lt < 256) {
            v4u w = *(const v4u*)p[i];
            if (dst[i] >> 30) w = (v4u){rot16(w.w), rot16(w.z), rot16(w.y), rot16(w.x)};
            r[i] = w; p[i] += stride[i];
        }
    }
    if (lt < 64) { gcv = *gcp; gcp += 64; }
}
__device__ __forceinline__ void scan_put(Frame& F, int stage, int lt, const int (&dst)[7], const v4u (&r)[7], float gcv) {
    LAS unsigned char* st = F.lds + stage * SC_STAGE;
#pragma unroll
    for (int i = 0; i < 7; ++i) { if (i < 6 || lt < 256) *(LAS v4u*)(st + (dst[i] & 0xfffffff)) = r[i]; }
    if (lt < 64) ((LAS float*)(F.lds + SC_GC))[stage * 64 + lt] = gcv;
}
__device__ __forceinline__ void scan_chunk(Frame& F, const ScanSeq& Q, int n, int stage, int ds, f32x16& S0, f32x16& S1, bf16* ODN) {
    const int lane = F.lane, lq = lane & 31, hh = lane >> 5;
    const LAS unsigned char* st = F.lds + stage * SC_STAGE;
    const LAS float* gc = (const LAS float*)(F.lds + SC_GC) + stage * 64;
    const LAS unsigned char* r0p = st + lq * SC_ROWB + 8 * hh;
    const float gl = gc[63];
    bf16x8 sb[4]; sb[0] = pack8(S0, 0); sb[1] = pack8(S0, 1); sb[2] = pack8(S1, 0); sb[3] = pack8(S1, 1);
    f32x16 vn0, vn1;
    { const LAS unsigned char* up = st + 4 * SC_TILE + (32 * ds + lq) * SC_ROWB + 8 * hh;
#pragma unroll
      for (int g = 0; g < 4; ++g) { const v2u a = *(const LAS v2u*)(up + 16 * g), c2 = *(const LAS v2u*)(up + 64 + 16 * g);
        vn0[4 * g] = bflo(a.x); vn0[4 * g + 1] = bfhi(a.x); vn0[4 * g + 2] = bflo(a.y); vn0[4 * g + 3] = bfhi(a.y);
        vn1[4 * g] = bflo(c2.x); vn1[4 * g + 1] = bfhi(c2.x); vn1[4 * g + 2] = bflo(c2.y); vn1[4 * g + 3] = bfhi(c2.y); } }
    f32x16 o0, o1;
#pragma unroll
    for (int r = 0; r < 16; ++r) { o0[r] = 0.f; o1[r] = 0.f; }
#pragma unroll
    for (int s = 0; s < 4; ++s) {
        vn0 = __builtin_amdgcn_mfma_f32_32x32x16_bf16(lds_frag(r0p + 32 * s), sb[s], vn0, 0, 0, 0);
        vn1 = __builtin_amdgcn_mfma_f32_32x32x16_bf16(lds_frag(r0p + 32 * SC_ROWB + 32 * s), sb[s], vn1, 0, 0, 0);
        o0 = __builtin_amdgcn_mfma_f32_32x32x16_bf16(lds_frag(r0p + SC_TILE + 32 * s), sb[s], o0, 0, 0, 0);
        o1 = __builtin_amdgcn_mfma_f32_32x32x16_bf16(lds_frag(r0p + SC_TILE + 32 * SC_ROWB + 32 * s), sb[s], o1, 0, 0, 0);
    }
    asm volatile("" : "+v"(vn0), "+v"(vn1), "+v"(o0), "+v"(o1) :: "memory");
#pragma unroll
    for (int g = 0; g < 4; ++g) { const f32x4 a = *(const LAS f32x4*)(gc + 8 * g + 4 * hh), c2 = *(const LAS f32x4*)(gc + 32 + 8 * g + 4 * hh);
        o0[4 * g] *= __expf(a.x); o0[4 * g + 1] *= __expf(a.y); o0[4 * g + 2] *= __expf(a.z); o0[4 * g + 3] *= __expf(a.w);
        o1[4 * g] *= __expf(c2.x); o1[4 * g + 1] *= __expf(c2.y); o1[4 * g + 2] *= __expf(c2.z); o1[4 * g + 3] *= __expf(c2.w); }
    {
        bf16x8 vb[4]; vb[0] = pack8(vn0, 0); vb[1] = pack8(vn0, 1); vb[2] = pack8(vn1, 0); vb[3] = pack8(vn1, 1);
#pragma unroll
        for (int s = 0; s < 4; ++s) {
            o0 = __builtin_amdgcn_mfma_f32_32x32x16_bf16(lds_frag(r0p + 2 * SC_TILE + 32 * s), vb[s], o0, 0, 0, 0);
            o1 = __builtin_amdgcn_mfma_f32_32x32x16_bf16(lds_frag(r0p + 2 * SC_TILE + 32 * SC_ROWB + 32 * s), vb[s], o1, 0, 0, 0);
        }
    }
    asm volatile("" : "+v"(o0), "+v"(o1) :: "memory");
    {
        const ptrdiff_t rs = Q.dir ? -256 : 256;
        bf16* op = ODN + (ptrdiff_t)(Q.row0 + (Q.dir ? Q.L - 1 - 64 * n : 64 * n)) * 256 + rs * (4 * hh);
#pragma unroll
        for (int r = 0; r < 16; ++r) { op[0] = (bf16)f2bf(o0[r]); op[rs * 32] = (bf16)f2bf(o1[r]); op += ((r & 3) == 3) ? rs * 5 : rs; asm volatile("" : "+v"(op)); }
    }
#pragma unroll
    for (int g = 0; g < 4; ++g) { const f32x4 a = *(const LAS f32x4*)(gc + 8 * g + 4 * hh), c2 = *(const LAS f32x4*)(gc + 32 + 8 * g + 4 * hh);
        vn0[4 * g] *= __expf(gl - a.x); vn0[4 * g + 1] *= __expf(gl - a.y); vn0[4 * g + 2] *= __expf(gl - a.z); vn0[4 * g + 3] *= __expf(gl - a.w);
        vn1[4 * g] *= __expf(gl - c2.x); vn1[4 * g + 1] *= __expf(gl - c2.y); vn1[4 * g + 2] *= __expf(gl - c2.z); vn1[4 * g + 3] *= __expf(gl - c2.w); }
    {
        bf16x8 vb[4]; vb[0] = pack8(vn0, 0); vb[1] = pack8(vn0, 1); vb[2] = pack8(vn1, 0); vb[3] = pack8(vn1, 1);
        const float egl = __expf(gl);
#pragma unroll
        for (int r = 0; r < 16; ++r) { S0[r] *= egl; S1[r] *= egl; }
#pragma unroll
        for (int s = 0; s < 4; ++s) {
            S0 = __builtin_amdgcn_mfma_f32_32x32x16_bf16(lds_frag(r0p + 3 * SC_TILE + 32 * s), vb[s], S0, 0, 0, 0);
            S1 = __builtin_amdgcn_mfma_f32_32x32x16_bf16(lds_frag(r0p + 3 * SC_TILE + 32 * SC_ROWB + 32 * s), vb[s], S1, 0, 0, 0);
        }
    }
}
__device__ __forceinline__ void dn_scan_task(Frame& F, int l, int seq) {
    ScanSeq Q; Q.seq = seq; Q.lat = seq < 64; const int s2 = Q.lat ? seq : seq - 64;
    Q.b = s2 >> 3; Q.h = (s2 >> 1) & 3; Q.dir = s2 & 1; Q.L = Q.lat ? 1024 : 256; Q.row0 = Q.lat ? M_CTX + Q.b * 1024 : Q.b * 256; Q.nch = Q.L >> 6;
    const int lane = F.lane, lq = lane & 31, hh = lane >> 5, w = F.wave, lt = F.tid - 128;
    const bool loader = w >= 2;
    const int dv = 32 * (w & 1) + lq;
    bf16* ODN = (bf16*)(F.ws + WS_ODN) + (size_t)Q.dir * MTOK * 256 + Q.h * 64 + dv;
    __syncthreads();
    if (loader) {
        v4u ra[7], rb[7]; float ga = 0.f, gb = 0.f;
        const bf16* lp[7]; int lstride[7], ldst[7]; const float* gcp;
        scan_ld_init(F, Q, lt, lp, lstride, ldst, gcp);
#pragma unroll
        for (int i = 0; i < 7; ++i) { ra[i] = (v4u){0u, 0u, 0u, 0u}; rb[i] = (v4u){0u, 0u, 0u, 0u}; }
        scan_fetch(lt, lp, lstride, ldst, gcp, ra, ga); scan_fetch(lt, lp, lstride, ldst, gcp, rb, gb);
        scan_put(F, 0, lt, ldst, ra, ga); scan_put(F, 1, lt, ldst, rb, gb);
        scan_fetch(lt, lp, lstride, ldst, gcp, ra, ga); scan_fetch(lt, lp, lstride, ldst, gcp, rb, gb);
        __syncthreads();
        for (int n = 0; n < Q.nch; n += 2) {
            if (n + 2 < Q.nch) scan_put(F, (n + 2) % 3, lt, ldst, ra, ga);
            if (n + 4 < Q.nch) scan_fetch(lt, lp, lstride, ldst, gcp, ra, ga);
            __syncthreads();
            if (n + 3 < Q.nch) scan_put(F, (n + 3) % 3, lt, ldst, rb, gb);
            if (n + 5 < Q.nch) scan_fetch(lt, lp, lstride, ldst, gcp, rb, gb);
            __syncthreads();
        }
    } else {
        f32x16 S0, S1;
#pragma unroll
        for (int r = 0; r < 16; ++r) { S0[r] = 0.f; S1[r] = 0.f; }
        if (Q.lat) {
            const float* s0p = F.in[I_SDN] + ((size_t)(((Q.b * 2 + l) * 2 + Q.dir) * 4 + Q.h) * 64) * 64 + dv + 4 * hh * 64;
#pragma unroll
            for (int r = 0; r < 16; ++r) { S0[r] = s0p[0]; S1[r] = s0p[32 * 64]; s0p += ((r & 3) == 3) ? 5 * 64 : 64; asm volatile("" : "+v"(s0p)); }
        }
        __syncthreads();
        for (int n = 0; n < Q.nch; n += 2) {
            scan_chunk(F, Q, n, n % 3, w, S0, S1, ODN);
            __syncthreads();
            scan_chunk(F, Q, n + 1, (n + 1) % 3, w, S0, S1, ODN);
            __syncthreads();
        }
        if (!Q.lat) {
            float* dst = F.out + O_DS + ((size_t)(((Q.b * 2 + l) * 2 + Q.dir) * 4 + Q.h) * 64) * 64 + dv + 4 * hh * 64;
#pragma unroll
            for (int r = 0; r < 16; ++r) { dst[0] = S0[r]; dst[32 * 64] = S1[r]; dst += ((r & 3) == 3) ? 5 * 64 : 64; asm volatile("" : "+v"(dst)); }
        }
    }
}

__device__ __forceinline__ void mixer_phase(Frame& F, int l) {
    for (int task = F.bid; task < 768; task += F.G) if (task >= 384 && task < 576) dn_scan_task(F, l, task - 384);
    for (int task = F.bid; task < 768; task += F.G) {
        if (task >= 384 && task < 576) continue;
        int mixer, b, h, qb = 0; bool lat = true;
        if (task < 128) { mixer = 2; b = task >> 4; h = (task >> 2) & 3; qb = task & 3; }
        else if (task < 256) { const int t = task - 128; mixer = 0; b = t >> 4; h = (t >> 2) & 3; qb = t & 3; }
        else if (task < 384) { const int t = task - 256; mixer = 1; b = t >> 4; h = (t >> 2) & 3; qb = t & 3; }
        else { const int t = (task - 576) & 63; mixer = (task - 576) >> 6; lat = false; b = t >> 2; h = t & 3; }
        att_task(F, l, mixer, lat, b, h, qb);
    }
}

__device__ __forceinline__ void dn_combine(Frame& F, int l) {
    const int gw = F.bid * NWAVES + F.wave, NGW = F.G * NWAVES, lane = F.lane;
    const bf16* Z = (const bf16*)(F.ws + WS_Z); bf16* O = (bf16*)(F.ws + WS_O);
    const bf16* O0 = (const bf16*)(F.ws + WS_ODN); const bf16* O1 = O0 + (size_t)MTOK * 256;
    const float g = F.in[I_DNOG][l * 64 + lane];
    for (int m = gw; m < MTOK; m += NGW) {
#pragma unroll
        for (int h = 0; h < 4; ++h) {
            const float v = bf2f(O0[(size_t)m * 256 + h * 64 + lane]) + bf2f(O1[(size_t)m * 256 + h * 64 + lane]);
            const float ss = wave_sum(v * v);
            const float y = v * (1.0f / sqrtf(ss * (1.f / 64.f) + 1e-6f)) * g * silu_f(bf2f(Z[(size_t)m * ZP + Z_CG + h * 64 + lane]));
            O[(size_t)m * 1024 + 512 + h * 64 + lane] = (bf16)f2bf(y);
        }
    }
}

constexpr int N_PHASES = 2 + 10 * DEPTH;
__global__ void __launch_bounds__(NT, 2) hybrid_fwd(Args args) {
    extern __shared__ __attribute__((aligned(16))) unsigned char lds_raw[];
    Frame F;
    F.lds = (LAS unsigned char*)lds_raw;
    F.tid = threadIdx.x; F.lane = F.tid & 63; F.wave = __builtin_amdgcn_readfirstlane(F.tid >> 6);
    F.G = gridDim.x; F.bid = blockIdx.x;
    F.in = args.in; F.out = args.out; F.ws = args.ws;
    volatile LAS unsigned* MISC = (volatile LAS unsigned*)(F.lds + MISC_OFF);
    for (int u = F.tid; u < (LDS_BYTES - LDSCTL_OFF) / 4; u += NT) ((LAS unsigned*)(F.lds + LDSCTL_OFF))[u] = 0u;
    __syncthreads();
    XcdBarrier bar; bar.bar = (unsigned*)(F.ws + WS_CTL) + CW_BAR; bar.x = 0; bar.st = nullptr;
#if !MK_PER_PHASE
    bar = xcd_barrier_post((unsigned*)(F.ws + WS_CTL) + CW_BAR, MISC + 8);
#endif
    int redo = 0;
    for (int ph = args.ph_lo; ph < args.ph_hi; ++ph) {
        {
            int tid_ = threadIdx.x, bid_ = blockIdx.x; unsigned char* ws_ = args.ws; float* out_ = args.out;
            asm volatile("" : "+v"(tid_)); asm volatile("" : "+s"(bid_)); asm volatile("" : "+s"(ws_)); asm volatile("" : "+s"(out_));
            F.tid = tid_; F.lane = tid_ & 63; F.wave = __builtin_amdgcn_readfirstlane(tid_ >> 6); F.bid = bid_; F.ws = ws_; F.out = out_;
        }
        const float* mods = (const float*)(F.ws + WS_MODS);
        if (ph == 0) { p0a(F); convert_weights(F, 0); }
        else if (ph == 1) norm_rows<0>(F, true, F.in[I_N1G], mods, 0, 1024);
        else {
            const int l = (ph - 2) / 10, sp = (ph - 2) % 10;
            unsigned char* wl = F.ws + WS_W;
            const float* mods_l = mods + (size_t)l * 9 * 6144;
            if (sp == 0) {
                pg8::Gemm g{(const bf16*)(F.ws + WS_XN), (const bf16*)(wl + W_IN), MTOK, ZP, 1024}; pg8::StaticOrder S; S.init(MTOK, ZP, F.G, F.bid);
                pg8::EpiBf16 E{(bf16*)(F.ws + WS_Z), ZP};
                pg8::gemm_phase<pg8::EpiBf16, pg8::StaticOrder, true, true>(F.lds, g, S, E, F.tid);
            } else if (sp == 1) prep_phase(F, l);
            else if (sp == 2) {
                { pg8::Gemm g{(const bf16*)(F.ws + WS_QN), (const bf16*)(wl + W_Q), MTOK, 512, 256}; pg8::StaticOrder S; S.init(MTOK, 512, F.G, F.bid);
                  pg8::EpiBf16 E{(bf16*)(F.ws + WS_QM), 512};
                  pg8::gemm_phase<pg8::EpiBf16, pg8::StaticOrder, true, true>(F.lds, g, S, E, F.tid); }
                { pg8::Gemm g{(const bf16*)(F.ws + WS_CKV), (const bf16*)(wl + W_KV), KVROWS, 512, 256}; pg8::StaticOrder S; S.init(KVROWS, 512, F.G, (F.bid + F.G - 96) % F.G);
                  pg8::EpiBf16 E{(bf16*)(F.ws + WS_KV), 512};
                  pg8::gemm_phase<pg8::EpiBf16, pg8::StaticOrder, true, true>(F.lds, g, S, E, F.tid); }
                dn_phase_a(F, l);
            } else if (sp == 3) mixer_phase(F, l);
            else if (sp == 4) dn_combine(F, l);
            else if (sp == 5) {
                pg8::Gemm g{(const bf16*)(F.ws + WS_O), (const bf16*)(wl + W_OUT), MTOK, 1024, 1024}; pg8::StaticOrder S; S.init(MTOK, 1024, F.G, F.bid);
                pg8::EpiRes E{l == 0 ? F.in[I_XP] : F.out, l == 0 ? F.in[I_XS] : F.out + (size_t)M_CTX * DM, F.out, mods_l + 2 * 1024};
                pg8::gemm_phase<pg8::EpiRes, pg8::StaticOrder, true, true>(F.lds, g, S, E, F.tid);
            } else if (sp == 6) norm_rows<0>(F, false, F.in[I_N2G] + l * 1024, mods_l, 3 * 1024, 4 * 1024);
            else if (sp == 7) {
                pg8::Gemm g{(const bf16*)(F.ws + WS_XN), (const bf16*)(wl + W_GU), MTOK, NGU, 1024}; pg8::StaticOrder S; S.init(MTOK, NGU, F.G, F.bid);
                pg8::EpiSwiglu E{(bf16*)(F.ws + WS_Z), FF};
                pg8::gemm_phase<pg8::EpiSwiglu, pg8::StaticOrder, true, true>(F.lds, g, S, E, F.tid);
            } else if (sp == 8) {
                pg8::Gemm g{(const bf16*)(F.ws + WS_Z), (const bf16*)(wl + W_D), MTOK, 1024, FF}; pg8::StaticOrder S; S.init(MTOK, 1024, F.G, F.bid);
                pg8::EpiRes E{F.out, F.out + (size_t)M_CTX * DM, F.out, mods_l + 5 * 1024};
                pg8::gemm_phase<pg8::EpiRes, pg8::StaticOrder, true, true>(F.lds, g, S, E, F.tid);
            } else {
                if (l + 1 < DEPTH) { norm_rows<0>(F, false, F.in[I_N1G] + (l + 1) * 1024, mods_l + 9 * 6144, 0, 1024); convert_weights(F, l + 1); }
                else norm_rows<1>(F, false, F.in[I_FG], nullptr, 0, 0);
            }
        }
#if !MK_PER_PHASE
        if (ph + 1 < args.ph_hi) xcd_barrier(bar);
#endif
        if (REPEAT_MASK) { const int bit = ph == 0 ? 10 : (ph == 1 ? 11 : (ph - 2) % 10); if ((REPEAT_MASK >> bit) & 1) { if (!redo) { redo = 1; --ph; } else redo = 0; } }
    }
}

extern "C" void kernel_launch(void* const* d_in, const int* in_sizes, int n_in, void* d_out, int out_size, void* d_ws, size_t ws_size, hipStream_t stream) {
    static int grid = 0;
    if (grid == 0) {
        if (n_in != N_IN || out_size != (int)O_END || ws_size < WS_END) { fprintf(stderr, "kernel_launch: unexpected shapes: n_in %d out %d ws %zu\n", n_in, out_size, ws_size); grid = -1; return; }
        int dev = 0, cus = 0, per_cu = 0;
        if (hipGetDevice(&dev) != hipSuccess || hipDeviceGetAttribute(&cus, hipDeviceAttributeMultiprocessorCount, dev) != hipSuccess) { grid = -1; return; }
        if (hipFuncSetAttribute((const void*)hybrid_fwd, hipFuncAttributeMaxDynamicSharedMemorySize, LDS_BYTES) != hipSuccess) { fprintf(stderr, "kernel_launch: hipFuncSetAttribute failed\n"); grid = -1; return; }
        if (hipOccupancyMaxActiveBlocksPerMultiprocessor(&per_cu, (const void*)hybrid_fwd, NT, LDS_BYTES) != hipSuccess || per_cu < 1) { fprintf(stderr, "kernel_launch: occupancy query says %d\n", per_cu); }
        (void)hipGetLastError();
        grid = cus;
    }
    if (grid < 0) return;
    (void)hipMemsetAsync((char*)d_ws + WS_CTL, 0, CTL_ZERO_BYTES, stream);
    Args a{};
    for (int i = 0; i < N_IN; ++i) a.in[i] = (const float*)d_in[i];
    a.out = (float*)d_out; a.ws = (unsigned char*)d_ws;
#if MK_PER_PHASE
    for (int ph = 0; ph < N_PHASES; ++ph) { a.ph_lo = ph; a.ph_hi = ph + 1; hipLaunchKernelGGL(hybrid_fwd, dim3(grid), dim3(NT), LDS_BYTES, stream, a); }
#else
    a.ph_lo = 0; a.ph_hi = N_PHASES;
    void* kargs[] = {&a};
    hipError_t e = hipLaunchCooperativeKernel((const void*)hybrid_fwd, dim3(grid), dim3(NT), kargs, LDS_BYTES, stream);
    if (e != hipSuccess) fprintf(stderr, "kernel_launch: cooperative launch failed: %s (grid %d)\n", hipGetErrorString(e), grid);
#endif
}
```

```cpp
#include <hip/hip_runtime.h>
#include <cstdio>
#include <cstdint>

#ifndef REPEAT_MASK
#define REPEAT_MASK 0
#endif
#ifndef MK_PER_PHASE
#define MK_PER_PHASE 0
#endif

namespace pg8 {
#define PG8_LAS __attribute__((address_space(3)))
typedef unsigned short bf16_t;
typedef short bf16x8 __attribute__((ext_vector_type(8)));
typedef float f32x4 __attribute__((ext_vector_type(4)));
typedef unsigned u32x4 __attribute__((ext_vector_type(4)));
typedef unsigned u32x2 __attribute__((ext_vector_type(2)));
constexpr int BM = 256, BK = 64, HALF = 128, HTB = HALF * BK * 2, STAGE_BYTES = 8 * HTB, NXCD = 8, WGM = 8;

__host__ __device__ __forceinline__ int lds_byte(int r, int c) { const int st = (r >> 4) * 2 + (c >> 5), rr = r & 15, cc = c & 31, ob = rr * 64 + cc * 2; return st * 1024 + (ob ^ (((ob >> 9) & 1) << 5)); }
__host__ __device__ __forceinline__ void stage_rc(int b, int& R, int& C) { const int st = b / 1024, sb = b % 1024, swz = sb ^ (((sb >> 9) & 1) << 5); R = (st >> 1) * 16 + swz / 64; C = (st & 1) * 32 + (swz % 64) / 2; }
__host__ __device__ __forceinline__ int perm32(int rho) { const int n = rho >> 4, i = rho & 15; return 8 * (i >> 2) + 4 * n + (i & 3); }

struct Unit { int pm, pn; };
struct Gemm { const bf16_t* A; const bf16_t* Bt; int M, N, K; };

struct StaticOrder {
    int nM, nN, nwg, G, c;
    __host__ __device__ void init(int M, int N, int G_, int c_) { nM = M / BM; nN = N / BM; nwg = nM * nN; G = G_; c = c_; }
    __host__ __device__ bool next(int i, Unit& u) const {
        const long L = (long)i * G + c; if (L >= nwg) return false;
        int wgid = (int)L; { const int q = nwg / NXCD, r = nwg % NXCD, xcd = wgid % NXCD, off = wgid / NXCD; wgid = (xcd < r ? xcd * (q + 1) : r * (q + 1) + (xcd - r) * q) + off; }
        const int nig = WGM * nN, gid = wgid / nig, fm = gid * WGM, gsz = (nM - fm) < WGM ? (nM - fm) : WGM;
        u.pm = fm + ((wgid % nig) % gsz); u.pn = (wgid % nig) / gsz; return true;
    }
    __device__ __forceinline__ void a_ready(const Unit&) const {}
    __device__ __forceinline__ void done(const Unit&) const {}
};

__device__ __forceinline__ unsigned cvt_pk_bf16(float lo, float hi) { unsigned r; asm volatile("v_cvt_pk_bf16_f32 %0, %1, %2" : "=v"(r) : "v"(lo), "v"(hi)); return r; }

struct EpiBf16 {
    static constexpr bool PERM = true, AFTER_DRAIN = false;
    bf16_t* O; int ldc;
    __device__ __forceinline__ void operator()(const f32x4 (&acc)[2][2][4][2], const Unit& u, int wr, int wc, int fr, int fq) const {
        const int row0 = u.pm * BM + wr * 64 + fr; const int col0 = u.pn * BM + wc * 32 + 8 * fq;
#pragma unroll
        for (int ai = 0; ai < 2; ++ai)
#pragma unroll
            for (int m = 0; m < 4; ++m) { bf16_t* rowp = O + (size_t)(row0 + ai * HALF + m * 16) * ldc + col0;
#pragma unroll
                for (int bj = 0; bj < 2; ++bj) { const f32x4 v0 = acc[ai][bj][m][0], v1 = acc[ai][bj][m][1];
                    u32x4 w; w.x = cvt_pk_bf16(v0[0], v0[1]); w.y = cvt_pk_bf16(v0[2], v0[3]); w.z = cvt_pk_bf16(v1[0], v1[1]); w.w = cvt_pk_bf16(v1[2], v1[3]);
                    *(u32x4*)(rowp + bj * HALF) = w; } }
    }
};
struct EpiSwiglu {
    static constexpr bool PERM = true, AFTER_DRAIN = false;
    bf16_t* O; int ldc;
    __device__ __forceinline__ static float sw(float g, float u) { return g * u / (1.0f + __expf(-g)); }
    __device__ __forceinline__ void operator()(const f32x4 (&acc)[2][2][4][2], const Unit& u, int wr, int wc, int fr, int fq) const {
        const int row0 = u.pm * BM + wr * 64 + fr; const int col0 = (u.pn * BM + wc * 32 + 8 * fq) >> 1;
#pragma unroll
        for (int ai = 0; ai < 2; ++ai)
#pragma unroll
            for (int m = 0; m < 4; ++m) { bf16_t* rowp = O + (size_t)(row0 + ai * HALF + m * 16) * ldc + col0;
#pragma unroll
                for (int bj = 0; bj < 2; ++bj) { const f32x4 v0 = acc[ai][bj][m][0], v1 = acc[ai][bj][m][1];
                    u32x2 w; w.x = cvt_pk_bf16(sw(v0[0], v0[1]), sw(v0[2], v0[3])); w.y = cvt_pk_bf16(sw(v1[0], v1[1]), sw(v1[2], v1[3]));
                    *(u32x2*)(rowp + bj * (HALF / 2)) = w; } }
    }
};
struct EpiRes {
    static constexpr bool PERM = false, AFTER_DRAIN = false;
    const float* base_a; const float* base_b; float* out; const float* gate;
    __device__ __forceinline__ void operator()(const f32x4 (&acc)[2][2][4][2], const Unit& u, int wr, int wc, int fr, int fq) const {
        const int col0 = u.pn * BM + wc * 32 + 4 * fq;
        const int rmod = u.pm < 16 ? 0 : 1 + ((u.pm - 16) >> 2);
        const float* g = gate + (size_t)rmod * 6144 + col0;
        const float* bp = u.pm < 16 ? base_a + (size_t)u.pm * BM * 1024 : base_b + (size_t)(u.pm - 16) * BM * 1024;
        float* op = out + (size_t)u.pm * BM * 1024;
        f32x4 gv[2][2];
#pragma unroll
        for (int bj = 0; bj < 2; ++bj)
#pragma unroll
            for (int n = 0; n < 2; ++n) gv[bj][n] = *(const f32x4*)(g + bj * HALF + n * 16);
#pragma unroll
        for (int ai = 0; ai < 2; ++ai)
#pragma unroll
            for (int m = 0; m < 4; ++m) { const size_t off = (size_t)(ai * HALF + wr * 64 + m * 16 + fr) * 1024 + col0;
#pragma unroll
                for (int bj = 0; bj < 2; ++bj)
#pragma unroll
                    for (int n = 0; n < 2; ++n) { const f32x4 bs = *(const f32x4*)(bp + off + bj * HALF + n * 16);
                        *(f32x4*)(op + off + bj * HALF + n * 16) = bs + gv[bj][n] * acc[ai][bj][m][n]; } }
    }
};

template <class Epi, class Sched, bool ALIGN_EPI = false, bool SP2 = false>
__device__ __forceinline__ void gemm_phase(PG8_LAS unsigned char* lds, const Gemm g, const Sched& S, const Epi& E, const int tid) {
    const int wid = __builtin_amdgcn_readfirstlane(tid >> 6), lane = tid & 63, wr = wid >> 2, wc = wid & 3, fr = lane & 15, fq = lane >> 4;
    const int K = g.K, nt = K / BK;
    unsigned voffA[2], voffB[2];
#pragma unroll
    for (int i = 0; i < 2; ++i) { int R, C; stage_rc(tid * 16 + i * 8192, R, C); const int Rb = Epi::PERM ? ((R & ~31) + perm32(R & 31)) : R;
        voffA[i] = (unsigned)(R * K + C) * 2u; voffB[i] = (unsigned)(Rb * K + C) * 2u; }
    const size_t kstep = (size_t)(BK * 2);
    const size_t hstep = (size_t)HALF * K * 2;
    const size_t tstep = 2 * hstep;
    const unsigned ldsw = (unsigned)wid * 1024u;
    const int aoff = lds_byte(wr * 64 + fr, fq * 8), boff = lds_byte(wc * 32 + fr, fq * 8);
#define PG8_SA(b, h) (((b) * 2 + (h)) * HTB)
#define PG8_SB(b, h) ((4 + (b) * 2 + (h)) * HTB)
#define PG8_STAGE(bufoff, gbase, voff) do { _Pragma("unroll") for (int _i = 0; _i < 2; ++_i) \
        __builtin_amdgcn_global_load_lds((const unsigned*)((const char*)(gbase) + (voff)[_i]), (PG8_LAS unsigned*)(lds + (bufoff) + ldsw + _i * 8192), 16, 0, 0); } while (0)
#define PG8_LDA(dst, b, h) do { _Pragma("unroll") for (int m = 0; m < 4; ++m) _Pragma("unroll") for (int k = 0; k < 2; ++k) dst[m][k] = *(const PG8_LAS bf16x8*)(lds + PG8_SA(b, h) + aoff + m * 2048 + k * 1024); } while (0)
#define PG8_LDB(dst, b, h) do { _Pragma("unroll") for (int n = 0; n < 2; ++n) _Pragma("unroll") for (int k = 0; k < 2; ++k) dst[n][k] = *(const PG8_LAS bf16x8*)(lds + PG8_SB(b, h) + boff + n * 2048 + k * 1024); } while (0)
#define PG8_MMA(ai, bj, At, Bt) do { __builtin_amdgcn_s_setprio(1); _Pragma("unroll") for (int m = 0; m < 4; ++m) _Pragma("unroll") for (int n = 0; n < 2; ++n) _Pragma("unroll") for (int k = 0; k < 2; ++k) \
        acc[ai][bj][m][n] = __builtin_amdgcn_mfma_f32_16x16x32_bf16(Bt[n][k], At[m][k], acc[ai][bj][m][n], 0, 0, 0); __builtin_amdgcn_s_setprio(0); } while (0)
#define PG8_WAIT_V(n) asm volatile("s_waitcnt vmcnt(" #n ")" ::: "memory")
#define PG8_WAIT_L(n) asm volatile("s_waitcnt lgkmcnt(" #n ")" ::: "memory")
#define PG8_BAR __builtin_amdgcn_s_barrier()
#define PG8_SCHED __builtin_amdgcn_sched_barrier(0)
    Unit cur, nxt; int ui = 0;
    if (!S.next(0, cur)) return;
    f32x4 acc[2][2][4][2];
#pragma unroll
    for (int a = 0; a < 2; ++a)
#pragma unroll
        for (int b = 0; b < 2; ++b)
#pragma unroll
            for (int m = 0; m < 4; ++m)
#pragma unroll
                for (int n = 0; n < 2; ++n) acc[a][b][m][n] = (f32x4){0.f, 0.f, 0.f, 0.f};
    bf16x8 At[4][2], B0[2][2], B1[2][2];
    const char* cA = (const char*)g.A + (size_t)cur.pm * tstep; const char* cB = (const char*)g.Bt + (size_t)cur.pn * tstep;
    S.a_ready(cur);
    if constexpr (SP2) {
        PG8_STAGE(PG8_SB(0, 0), cB, voffB); PG8_STAGE(PG8_SB(0, 1), cB + hstep, voffB); PG8_STAGE(PG8_SA(0, 0), cA, voffA); PG8_STAGE(PG8_SA(0, 1), cA + hstep, voffA);
        if (wr == 1) PG8_BAR;
        PG8_WAIT_V(2); PG8_BAR;
        PG8_STAGE(PG8_SB(1, 0), cB + kstep, voffB); PG8_STAGE(PG8_SA(1, 0), cA + kstep, voffA); PG8_STAGE(PG8_SB(1, 1), cB + hstep + kstep, voffB);
        PG8_WAIT_V(6); PG8_BAR;
    } else {
        PG8_STAGE(PG8_SB(0, 0), cB, voffB); PG8_STAGE(PG8_SA(0, 0), cA, voffA); PG8_STAGE(PG8_SB(0, 1), cB + hstep, voffB); PG8_STAGE(PG8_SA(0, 1), cA + hstep, voffA);
        if (wr == 1) PG8_BAR;
        PG8_WAIT_V(4); PG8_BAR;
        PG8_STAGE(PG8_SB(1, 0), cB + kstep, voffB); PG8_STAGE(PG8_SA(1, 0), cA + kstep, voffA); PG8_STAGE(PG8_SB(1, 1), cB + hstep + kstep, voffB);
        PG8_WAIT_V(6); PG8_BAR;
    }
    for (;;) {
        const bool has_next = S.next(ui + 1, nxt);
        const char* nA = has_next ? (const char*)g.A + (size_t)nxt.pm * tstep : cA; const char* nB = has_next ? (const char*)g.Bt + (size_t)nxt.pn * tstep : cB;
        for (int t = 0; t < nt; t += 2) {
            const bool last = (t == nt - 2);
            const char* a1 = cA + (size_t)(t + 1) * kstep;
            const char* a2 = last ? nA : cA + (size_t)(t + 2) * kstep; const char* b2 = last ? nB : cB + (size_t)(t + 2) * kstep;
            const char* a3 = a2 + kstep; const char* b3 = b2 + kstep;
            if (last && has_next) S.a_ready(nxt);
            if constexpr (SP2) {
            PG8_LDB(B0, 0, 0); PG8_LDB(B1, 0, 1); PG8_SCHED; PG8_LDA(At, 0, 0); PG8_STAGE(PG8_SA(1, 1), a1 + hstep, voffA);
            PG8_WAIT_V(8); PG8_WAIT_L(0); PG8_BAR; PG8_MMA(0, 0, At, B0); PG8_MMA(0, 1, At, B1); PG8_BAR; PG8_SCHED;
            PG8_LDA(At, 0, 1); PG8_STAGE(PG8_SB(0, 0), b2, voffB); PG8_STAGE(PG8_SB(0, 1), b2 + hstep, voffB); PG8_STAGE(PG8_SA(0, 0), a2, voffA);
            PG8_WAIT_V(8); PG8_WAIT_L(0); PG8_BAR; PG8_MMA(1, 0, At, B0); PG8_MMA(1, 1, At, B1); PG8_BAR; PG8_SCHED;
            PG8_LDB(B0, 1, 0); PG8_LDB(B1, 1, 1); PG8_SCHED; PG8_LDA(At, 1, 0); PG8_STAGE(PG8_SA(0, 1), a2 + hstep, voffA);
            PG8_WAIT_V(8); PG8_WAIT_L(0); PG8_BAR; PG8_MMA(0, 0, At, B0); PG8_MMA(0, 1, At, B1); PG8_BAR; PG8_SCHED;
            PG8_LDA(At, 1, 1); PG8_STAGE(PG8_SB(1, 0), b3, voffB); PG8_STAGE(PG8_SB(1, 1), b3 + hstep, voffB); PG8_STAGE(PG8_SA(1, 0), a3, voffA);
            PG8_WAIT_V(8); PG8_WAIT_L(0); PG8_BAR; PG8_MMA(1, 0, At, B0); PG8_MMA(1, 1, At, B1); PG8_BAR; PG8_SCHED;
            } else {
            PG8_LDB(B0, 0, 0); PG8_SCHED; PG8_LDA(At, 0, 0); PG8_STAGE(PG8_SA(1, 1), a1 + hstep, voffA);
            PG8_WAIT_L(8); PG8_BAR; PG8_WAIT_L(0); PG8_MMA(0, 0, At, B0); PG8_BAR; PG8_SCHED;
            PG8_LDB(B1, 0, 1); PG8_STAGE(PG8_SB(0, 0), b2, voffB);
            PG8_BAR; PG8_WAIT_L(0); PG8_MMA(0, 1, At, B1); PG8_BAR;
            PG8_LDA(At, 0, 1); PG8_STAGE(PG8_SA(0, 0), a2, voffA);
            PG8_BAR; PG8_WAIT_L(0); PG8_MMA(1, 0, At, B0); PG8_BAR; PG8_SCHED;
            PG8_STAGE(PG8_SB(0, 1), b2 + hstep, voffB);
            PG8_WAIT_V(6); PG8_BAR; PG8_MMA(1, 1, At, B1); PG8_BAR;
            PG8_LDB(B0, 1, 0); PG8_SCHED; PG8_LDA(At, 1, 0); PG8_STAGE(PG8_SA(0, 1), a2 + hstep, voffA);
            PG8_WAIT_L(8); PG8_BAR; PG8_WAIT_L(0); PG8_MMA(0, 0, At, B0); PG8_BAR; PG8_SCHED;
            PG8_LDB(B1, 1, 1); PG8_STAGE(PG8_SB(1, 0), b3, voffB);
            PG8_BAR; PG8_WAIT_L(0); PG8_MMA(0, 1, At, B1); PG8_BAR;
            PG8_LDA(At, 1, 1); PG8_STAGE(PG8_SA(1, 0), a3, voffA);
            PG8_BAR; PG8_WAIT_L(0); PG8_MMA(1, 0, At, B0); PG8_BAR; PG8_SCHED;
            PG8_STAGE(PG8_SB(1, 1), b3 + hstep, voffB);
            PG8_WAIT_V(6); PG8_BAR; PG8_MMA(1, 1, At, B1); PG8_BAR;
            }
        }
        if constexpr (ALIGN_EPI) { if (wr == 0) PG8_BAR; }
        if constexpr (!Epi::AFTER_DRAIN) { E(acc, cur, wr, wc, fr, fq); S.done(cur); }
        if (!has_next) break;
#pragma unroll
        for (int a = 0; a < 2; ++a)
#pragma unroll
            for (int b = 0; b < 2; ++b)
#pragma unroll
                for (int m = 0; m < 4; ++m)
#pragma unroll
                    for (int n = 0; n < 2; ++n) acc[a][b][m][n] = (f32x4){0.f, 0.f, 0.f, 0.f};
        cur = nxt; cA = nA; cB = nB; ++ui;
        if constexpr (ALIGN_EPI) { if (wr == 1) PG8_BAR; }
    }
    PG8_WAIT_V(0);
    if constexpr (!ALIGN_EPI) { if (wr == 0) PG8_BAR; }
    PG8_BAR;
#undef PG8_SA
#undef PG8_SB
#undef PG8_STAGE
#undef PG8_LDA
#undef PG8_LDB
#undef PG8_MMA
#undef PG8_WAIT_V
#undef PG8_WAIT_L
#undef PG8_BAR
#undef PG8_SCHED
}
}

constexpr int NWAVES = 8, NT = 512;
constexpr int DM = 1024, M_CTX = 4096, M_LAT = 8192, MTOK = 12288, DEPTH = 2;
constexpr int ZP = 2816, FF = 2816, NGU = 5632, IN_COLS = 2736;
constexpr int Z_AQ = 0, Z_AK = 256, Z_AV = 384, Z_BQ = 512, Z_BK = 768, Z_BV = 1024, Z_CQKV = 1280, Z_CG = 2048, Z_CA = 2304, Z_CB = 2312, Z_DCQ = 2320, Z_DCKV = 2576, Z_DKR = 2704;
constexpr int NCACHE = 4096;
constexpr int KVROWS = MTOK + NCACHE;
constexpr float LOG2E = 1.4426950408889634f;
constexpr float MLA_SCALE = 0.10206207261596577f;
enum { I_XP = 0, I_XS, I_CGK, I_CGV, I_CNK, I_CNV, I_SDN, I_CCKV, I_CKR, I_C, I_CCTX, I_N1G, I_N2G, I_WMOD, I_BMOD, I_WIN, I_WOUT, I_QNG, I_KNG, I_NAB,
       I_CONV, I_ALOG, I_DTB, I_DNOG, I_MQNG, I_WQUP, I_MKVNG, I_WKVUP, I_WG, I_WU, I_WD, I_FG, N_IN };
constexpr size_t O_YP = 0, O_YS = 4194304, O_GK = 12582912, O_GV = 13631488, O_NK = 14680064, O_NV = 16777216, O_DS = 18874368, O_CKV = 19922944, O_KR = 20971520, O_END = 21233664;

constexpr size_t MiB = 1u << 20;
constexpr size_t WS_CTL = 0, CTL_ZERO_BYTES = 1 * MiB;
constexpr size_t WS_MODS = 1 * MiB;
constexpr size_t WS_ROPE = 1 * MiB + 512 * 1024;
constexpr size_t WS_W = 2 * MiB;
constexpr size_t W_IN = 0, W_OUT = W_IN + (size_t)ZP * 1024 * 2, W_GU = W_OUT + (size_t)1024 * 1024 * 2, W_D = W_GU + (size_t)NGU * 1024 * 2,
                 W_Q = W_D + (size_t)1024 * FF * 2, W_KV = W_Q + (size_t)512 * 256 * 2, W_LEND = W_KV + (size_t)512 * 256 * 2;
static_assert(W_LEND <= 25 * MiB, "weights per layer");
constexpr size_t WS_XN = 27 * MiB;
constexpr size_t WS_UT = 27 * MiB, WS_WN = 39 * MiB;
constexpr size_t WS_Z = 51 * MiB;
constexpr size_t WS_O = 117 * MiB;
constexpr size_t WS_QA = 141 * MiB, WS_KA = 147 * MiB, WS_VA = 151 * MiB;
constexpr size_t WS_DQ = 155 * MiB, WS_DK = 161 * MiB, WS_DV = 167 * MiB;
constexpr size_t WS_BG = 173 * MiB;
constexpr size_t WS_QN = 174 * MiB;
constexpr size_t WS_CKV = 180 * MiB;
constexpr size_t WS_KR = 188 * MiB;
constexpr size_t WS_QM = 189 * MiB;
constexpr size_t WS_KV = 201 * MiB;
constexpr size_t WS_NKB = 217 * MiB, WS_NVB = 219 * MiB;
constexpr size_t WS_ODN = 221 * MiB;
constexpr size_t WS_QKG = 233 * MiB;
constexpr size_t WS_KT = 245 * MiB;
constexpr size_t WS_GC = 251 * MiB;
constexpr size_t WS_END = 252 * MiB;
constexpr int CW_BAR = 4096;

constexpr int RING_BYTES = 131072, LDSCTL_OFF = RING_BYTES, MISC_OFF = LDSCTL_OFF + 320, LDS_BYTES = 147456;

#define GAS __attribute__((address_space(1)))
#define LAS __attribute__((address_space(3)))
typedef unsigned short bf16;
typedef unsigned v4u __attribute__((ext_vector_type(4)));
typedef unsigned v2u __attribute__((ext_vector_type(2)));
typedef float f32x4 __attribute__((ext_vector_type(4)));
__device__ __forceinline__ unsigned f2bf(float f) { unsigned u = __builtin_bit_cast(unsigned, f); return (u + 0x7fffu + ((u >> 16) & 1u)) >> 16; }
__device__ __forceinline__ unsigned pk2(float lo, float hi) { return f2bf(lo) | (f2bf(hi) << 16); }
__device__ __forceinline__ float bf2f(bf16 h) { return __uint_as_float((unsigned)h << 16); }
__device__ __forceinline__ float bflo(unsigned u) { return __uint_as_float(u << 16); }
__device__ __forceinline__ float bfhi(unsigned u) { return __uint_as_float(u & 0xffff0000u); }
#define LDS_WAIT() asm volatile("s_waitcnt lgkmcnt(0)" ::: "memory")

#define XB_TMO      128
#define XB_XCNT(j)  (256  + 64 * (j))
#define XB_XSUB(j)  (1280 + 64 * (j))
#define XB_XGEN(j)  (2304 + 64 * (j))
#define XB_TOP      3328
#define XB_TOPGEN   3392
#define XCD_BAR_WORDS 3456
#define XB_SPIN_CAP (1u << 18)
__device__ __forceinline__ unsigned xb_ld(unsigned* p)              { return __hip_atomic_load(p, __ATOMIC_RELAXED, __HIP_MEMORY_SCOPE_AGENT); }
__device__ __forceinline__ unsigned xb_add(unsigned* p, unsigned v) { return __hip_atomic_fetch_add(p, v, __ATOMIC_RELAXED, __HIP_MEMORY_SCOPE_AGENT); }
__device__ __forceinline__ unsigned xb_xcc_id() { return (unsigned)__builtin_amdgcn_s_getreg((3 << 11) | 20) & 0xFu; }
#define XB_SPIN(cond, bar) do { unsigned _sp = 0; while (cond) { __builtin_amdgcn_s_sleep(1); \
    if ((++_sp & 255u) == 0u) { if (xb_ld(&(bar)[XB_TMO])) break; if (_sp > XB_SPIN_CAP) { atomicAdd(&(bar)[XB_TMO], 1u); break; } } } } while (0)
struct XcdBarrier { unsigned* bar; unsigned x; volatile LAS unsigned* st; };
__device__ __forceinline__ XcdBarrier xcd_barrier_post(unsigned* bar, volatile LAS unsigned* st) {
    XcdBarrier b; b.bar = bar; b.x = xb_xcc_id(); b.st = st;
    if (threadIdx.x == 0) (void)xb_add(&bar[XB_XCNT(b.x)], 1u);
    return b;
}
__device__ __forceinline__ void xcd_barrier_complete(unsigned* bar, unsigned x, unsigned& nloc, unsigned& nx) {
    const unsigned G = gridDim.x * gridDim.y * gridDim.z;
    unsigned sum, cnt, mine, sp = 0u;
    for (;;) {
        sum = 0u; cnt = 0u; mine = 0u;
#pragma unroll
        for (unsigned j = 0; j < 16; ++j) { const unsigned c = xb_ld(&bar[XB_XCNT(j)]); sum += c; cnt += (c > 0u) ? 1u : 0u; mine = (j == x) ? c : mine; }
        if (sum == G) break;
        __builtin_amdgcn_s_sleep(1);
        if ((++sp & 255u) == 0u) { if (xb_ld(&bar[XB_TMO])) break; if (sp > XB_SPIN_CAP) { atomicAdd(&bar[XB_TMO], 1u); break; } }
    }
    nloc = mine > 0u ? mine : 1u; nx = cnt > 0u ? cnt : 1u;
}
__device__ __forceinline__ void xcd_barrier(const XcdBarrier& b) {
    asm volatile("s_waitcnt vmcnt(0)" ::: "memory");
    __syncthreads();
    if (threadIdx.x == 0) {
        unsigned* bar = b.bar;
        __builtin_amdgcn_s_waitcnt(0);
        unsigned nloc = b.st[0], nx = b.st[1];
        if (nloc == 0u) { xcd_barrier_complete(bar, b.x, nloc, nx); b.st[0] = nloc; b.st[1] = nx; }
        const unsigned old = xb_add(&bar[XB_XSUB(b.x)], 1u);
        const unsigned gen = old / nloc;
        if (old + 1u == (gen + 1u) * nloc) {
            __builtin_amdgcn_fence(__ATOMIC_RELEASE, "agent");
            asm volatile("s_waitcnt vmcnt(0)" ::: "memory");
            const unsigned og = xb_add(&bar[XB_TOP], 1u);
            const unsigned tg = og / nx;
            if (og + 1u == (tg + 1u) * nx) xb_add(&bar[XB_TOPGEN], 1u);
            else XB_SPIN(xb_ld(&bar[XB_TOPGEN]) == tg, bar);
            __builtin_amdgcn_fence(__ATOMIC_ACQUIRE, "agent");
            xb_add(&bar[XB_XGEN(b.x)], 1u);
            asm volatile("s_waitcnt vmcnt(0)" ::: "memory");
        } else {
            XB_SPIN(xb_ld(&bar[XB_XGEN(b.x)]) == gen, bar);
            __builtin_amdgcn_fence(__ATOMIC_ACQUIRE, "agent");
            asm volatile("s_waitcnt vmcnt(0)" ::: "memory");
        }
    }
    __syncthreads();
}

struct Args { const float* in[N_IN]; float* out; unsigned char* ws; int ph_lo, ph_hi; };
struct Frame {
    LAS unsigned char* lds;
    int tid, lane, wave, G, bid;
    const float* const* in; float* out; unsigned char* ws;
};
__device__ __forceinline__ float wave_sum(float v) {
#pragma unroll
    for (int o = 1; o < 64; o <<= 1) v += __shfl_xor(v, o);
    return v;
}
__device__ __forceinline__ float silu_f(float x) { return x / (1.0f + __expf(-x)); }

__device__ __forceinline__ void p0_transpose_item(const float* W, int K, int Nsrc, int Npad, int KP, bf16* WT, int row_off, int rmul, LAS float* scr, int item, int lane) {
    const int nblk = Npad / 32, kb = item / nblk, nb = item % nblk, k0 = 64 * kb, n0 = 32 * nb;
    const int nn = n0 + (lane & 31);
#pragma unroll 8
    for (int i = 0; i < 32; ++i) { const int kk = 2 * i + (lane >> 5); scr[kk * 33 + (lane & 31)] = (nn < Nsrc && (k0 + kk) < K) ? W[(size_t)(k0 + kk) * Nsrc + nn] : 0.f; }
    LDS_WAIT(); asm volatile("" ::: "memory");
    const int c = lane & 7;
#pragma unroll
    for (int j = 0; j < 4; ++j) { const int n = (lane >> 3) + 8 * j; const LAS float* s = scr + (8 * c) * 33 + n;
        v4u o; o.x = pk2(s[0 * 33], s[1 * 33]); o.y = pk2(s[2 * 33], s[3 * 33]); o.z = pk2(s[4 * 33], s[5 * 33]); o.w = pk2(s[6 * 33], s[7 * 33]);
        *(v4u*)(WT + (size_t)(row_off + rmul * (n0 + n)) * KP + k0 + 8 * c) = o; }
    LDS_WAIT(); asm volatile("" ::: "memory");
}
__device__ __forceinline__ void p0a(Frame& F) {
    {
        LAS float* sc = (LAS float*)(F.lds);
        LAS float* part = (LAS float*)(F.lds + 9 * 1024 * 4);
        for (int e = F.tid; e < 9 * 1024; e += NT) { const int r = e >> 10, k = e & 1023; const float c = (r == 0) ? F.in[I_CCTX][k] : F.in[I_C][(r - 1) * 1024 + k]; sc[e] = silu_f(c); }
        __syncthreads();
        for (int it = F.bid; it < 2 * 96; it += F.G) {
            const int l = it / 96, n0 = (it % 96) * 64;
            const float* w = F.in[I_WMOD] + (size_t)l * 1024 * 6144 + n0 + F.lane;
            float acc[9];
#pragma unroll
            for (int r = 0; r < 9; ++r) acc[r] = 0.f;
            const int kb = F.wave * 128;
#pragma unroll 8
            for (int k = 0; k < 128; ++k) { const float wv = w[(size_t)(kb + k) * 6144];
#pragma unroll
                for (int r = 0; r < 9; ++r) acc[r] += sc[r * 1024 + kb + k] * wv; }
#pragma unroll
            for (int r = 0; r < 9; ++r) part[(F.wave * 9 + r) * 64 + F.lane] = acc[r];
            __syncthreads();
            for (int e = F.tid; e < 9 * 64; e += NT) { const int r = e >> 6, c = e & 63; float s = 0.f;
#pragma unroll
                for (int w8 = 0; w8 < 8; ++w8) s += part[(w8 * 9 + r) * 64 + c];
                ((float*)(F.ws + WS_MODS))[(size_t)(l * 9 + r) * 6144 + n0 + c] = s + F.in[I_BMOD][l * 6144 + n0 + c]; }
            __syncthreads();
        }
    }
    if (F.bid == F.G - 1) {
        float* tab = (float*)(F.ws + WS_ROPE);
        for (int e = F.tid; e < 64 * 16 + 64 * 8; e += NT) {
            int pos, i, half; float* dst;
            if (e < 1024) { pos = e >> 4; i = e & 15; half = 16; dst = tab + 2 * e; } else { const int e2 = e - 1024; pos = e2 >> 3; i = e2 & 7; half = 8; dst = tab + 2048 + 2 * e2; }
            const float inv = exp2f(-(float)i / (float)half * 13.287712379549449f);
            const float ang = (float)pos * inv;
            const double twopi = 6.283185307179586476925; const double a = (double)ang; const double kq = __builtin_rint(a / twopi); const float rr = (float)(a - kq * twopi);
            dst[0] = __builtin_cosf(rr); dst[1] = __builtin_sinf(rr);
        }
    }
    __syncthreads();
}
__device__ __forceinline__ void convert_weights(Frame& F, int l) {
    LAS float* scr = (LAS float*)(F.lds + F.wave * 16384);
    const int gw = F.bid * NWAVES + F.wave, NGW = F.G * NWAVES;
    constexpr int I_IN = 16 * 88, I_OUT = 16 * 32, I_G = 16 * 88, I_U = 16 * 88, I_D = 44 * 32, I_Q = 4 * 16, I_KV = 4 * 16;
    constexpr int PER_L = I_IN + I_OUT + I_G + I_U + I_D + I_Q + I_KV;
    unsigned char* wl = F.ws + WS_W;
    for (int it = gw; it < PER_L; it += NGW) {
        int r = it;
        if (r < I_IN) { p0_transpose_item(F.in[I_WIN] + (size_t)l * 1024 * IN_COLS, 1024, IN_COLS, ZP, 1024, (bf16*)(wl + W_IN), 0, 1, scr, r, F.lane); continue; } r -= I_IN;
        if (r < I_OUT) { p0_transpose_item(F.in[I_WOUT] + (size_t)l * 1024 * 1024, 1024, 1024, 1024, 1024, (bf16*)(wl + W_OUT), 0, 1, scr, r, F.lane); continue; } r -= I_OUT;
        if (r < I_G) { p0_transpose_item(F.in[I_WG] + (size_t)l * 1024 * FF, 1024, FF, FF, 1024, (bf16*)(wl + W_GU), 0, 2, scr, r, F.lane); continue; } r -= I_G;
        if (r < I_U) { p0_transpose_item(F.in[I_WU] + (size_t)l * 1024 * FF, 1024, FF, FF, 1024, (bf16*)(wl + W_GU), 1, 2, scr, r, F.lane); continue; } r -= I_U;
        if (r < I_D) { p0_transpose_item(F.in[I_WD] + (size_t)l * FF * 1024, FF, 1024, 1024, FF, (bf16*)(wl + W_D), 0, 1, scr, r, F.lane); continue; } r -= I_D;
        if (r < I_Q) { p0_transpose_item(F.in[I_WQUP] + (size_t)l * 256 * 384, 256, 384, 512, 256, (bf16*)(wl + W_Q), 0, 1, scr, r, F.lane); continue; } r -= I_Q;
        p0_transpose_item(F.in[I_WKVUP] + (size_t)l * 128 * 512, 128, 512, 512, 256, (bf16*)(wl + W_KV), 0, 1, scr, r, F.lane);
    }
}

__device__ __forceinline__ const float* xrow_ptr(Frame& F, int m, bool from_in) {
    if (from_in) return m < M_CTX ? F.in[I_XP] + (size_t)m * DM : F.in[I_XS] + (size_t)(m - M_CTX) * DM;
    return F.out + (size_t)m * DM;
}
template <int MODE> __device__ __forceinline__ void norm_rows(Frame& F, bool from_in, const float* g, const float* mods_l  , int sh_off, int sc_off) {
    const int gw = F.bid * NWAVES + F.wave, NGW = F.G * NWAVES;
    for (int m = gw; m < MTOK; m += NGW) {
        const f32x4* xr = (const f32x4*)xrow_ptr(F, m, from_in) + F.lane;
        f32x4 v[4]; float s = 0.f;
#pragma unroll
        for (int j = 0; j < 4; ++j) { v[j] = xr[64 * j]; s += (v[j].x * v[j].x + v[j].y * v[j].y) + (v[j].z * v[j].z + v[j].w * v[j].w); }
        const float rstd = 1.0f / sqrtf(wave_sum(s) * (1.f / DM) + 1e-6f);
        if (MODE == 0) {
            const int rmod = m < M_CTX ? 0 : 1 + ((m - M_CTX) >> 10);
            const float* mr = mods_l + (size_t)rmod * 6144;
            unsigned long long* o8 = (unsigned long long*)((bf16*)(F.ws + WS_XN) + (size_t)m * DM) + F.lane;
#pragma unroll
            for (int j = 0; j < 4; ++j) { const int c = 4 * F.lane + 256 * j; const f32x4 gg = *(const f32x4*)(g + c), sh = *(const f32x4*)(mr + sh_off + c), sc = *(const f32x4*)(mr + sc_off + c);
                const f32x4 y = (v[j] * rstd * gg) * (sc + 1.0f) + sh;
                o8[64 * j] = (unsigned long long)pk2(y.x, y.y) | ((unsigned long long)pk2(y.z, y.w) << 32); }
        } else {
            f32x4* yo = (f32x4*)(F.out + (size_t)m * DM) + F.lane;
#pragma unroll
            for (int j = 0; j < 4; ++j) { const int c = 4 * F.lane + 256 * j; const f32x4 gg = *(const f32x4*)(g + c); yo[64 * j] = v[j] * rstd * gg; }
        }
    }
}

typedef float f32x2_t __attribute__((ext_vector_type(2))); typedef __bf16 bf16x2_t __attribute__((ext_vector_type(2)));
__device__ __forceinline__ unsigned cvtpk(float lo, float hi) { f32x2_t v = {lo, hi}; bf16x2_t b = __builtin_convertvector(v, bf16x2_t); return __builtin_bit_cast(unsigned, b); }
struct F8 { float v[8]; };
__device__ __forceinline__ F8 bf8f(const v4u w) { F8 r; r.v[0] = bflo(w.x); r.v[1] = bfhi(w.x); r.v[2] = bflo(w.y); r.v[3] = bfhi(w.y); r.v[4] = bflo(w.z); r.v[5] = bfhi(w.z); r.v[6] = bflo(w.w); r.v[7] = bfhi(w.w); return r; }
__device__ __forceinline__ v4u fbf8(const F8& x) { v4u w; w.x = cvtpk(x.v[0], x.v[1]); w.y = cvtpk(x.v[2], x.v[3]); w.z = cvtpk(x.v[4], x.v[5]); w.w = cvtpk(x.v[6], x.v[7]); return w; }
__device__ __forceinline__ F8 ldf8(const float* p) { const f32x4 a = *(const f32x4*)p, b = *(const f32x4*)(p + 4); F8 r; r.v[0] = a.x; r.v[1] = a.y; r.v[2] = a.z; r.v[3] = a.w; r.v[4] = b.x; r.v[5] = b.y; r.v[6] = b.z; r.v[7] = b.w; return r; }
__device__ __forceinline__ void stf8(float* p, const F8& x) { *(f32x4*)p = (f32x4){x.v[0], x.v[1], x.v[2], x.v[3]}; *(f32x4*)(p + 4) = (f32x4){x.v[4], x.v[5], x.v[6], x.v[7]}; }
template <int K> __device__ __forceinline__ float shx(float v) { return __int_as_float(__builtin_amdgcn_ds_swizzle(__float_as_int(v), (K << 10) | 0x1f)); }
__device__ __forceinline__ float ssq8(const F8& x) { return (x.v[0] * x.v[0] + x.v[1] * x.v[1]) + (x.v[2] * x.v[2] + x.v[3] * x.v[3]) + (x.v[4] * x.v[4] + x.v[5] * x.v[5]) + (x.v[6] * x.v[6] + x.v[7] * x.v[7]); }
__device__ __forceinline__ float red8(float s) { s += shx<1>(s); s += shx<2>(s); s += shx<4>(s); return s; }
__device__ __forceinline__ void prep_phase(Frame& F, int l) {
    const int gw = F.bid * NWAVES + F.wave, NGW = F.G * NWAVES, lane = F.lane;
    const bf16* Z = (const bf16*)(F.ws + WS_Z);
    bf16* QA = (bf16*)(F.ws + WS_QA); bf16* KA = (bf16*)(F.ws + WS_KA); bf16* VA = (bf16*)(F.ws + WS_VA);
    bf16* DQ = (bf16*)(F.ws + WS_DQ); bf16* DK = (bf16*)(F.ws + WS_DK); bf16* DV = (bf16*)(F.ws + WS_DV);
    float* BG = (float*)(F.ws + WS_BG);
    bf16* QN = (bf16*)(F.ws + WS_QN); bf16* CKV = (bf16*)(F.ws + WS_CKV); bf16* KR = (bf16*)(F.ws + WS_KR);
    const float* tabA = (const float*)(F.ws + WS_ROPE); const float* tabM = tabA + 2048;
    const int j8 = lane & 7;
    for (int it = gw; it < MTOK + NCACHE; it += NGW) {
        if (it >= MTOK) {
            const int cr = it - MTOK, b = cr >> 9, j = cr & 511; const size_t src = (size_t)((b * 2 + l) * 512 + j);
            const int krow = M_CTX + b * 1536 + j;
            { const float* g = (lane < 32 ? F.in[I_CGK] : F.in[I_CGV]) + src * 128 + (lane & 31) * 4; const f32x4 v = *(const f32x4*)g;
              v2u w; w.x = cvtpk(v.x, v.y); w.y = cvtpk(v.z, v.w); *(v2u*)((lane < 32 ? KA : VA) + (size_t)krow * 128 + (lane & 31) * 4) = w; }
            if (lane < 40) { const float* g = lane < 32 ? F.in[I_CCKV] + src * 128 + lane * 4 : F.in[I_CKR] + src * 32 + (lane - 32) * 4; const f32x4 v = *(const f32x4*)g;
              v2u w; w.x = cvtpk(v.x, v.y); w.y = cvtpk(v.z, v.w); *(v2u*)(lane < 32 ? CKV + (size_t)it * 256 + lane * 4 : KR + (size_t)it * 32 + (lane - 32) * 4) = w; }
            else if (lane >= 48) *(v4u*)(CKV + (size_t)it * 256 + 128 + (lane - 48) * 8) = (v4u){0u, 0u, 0u, 0u};
            { const f32x4 a = *(const f32x4*)(F.in[I_CNK] + src * 256 + lane * 4), c = *(const f32x4*)(F.in[I_CNV] + src * 256 + lane * 4);
              v2u w; w.x = cvtpk(a.x, a.y); w.y = cvtpk(a.z, a.w); *(v2u*)((bf16*)(F.ws + WS_NKB) + (size_t)cr * 256 + lane * 4) = w;
              v2u u; u.x = cvtpk(c.x, c.y); u.y = cvtpk(c.z, c.w); *(v2u*)((bf16*)(F.ws + WS_NVB) + (size_t)cr * 256 + lane * 4) = u; }
            continue;
        }
        const int m = it; const bool lat = m >= M_CTX;
        const int b = lat ? (m - M_CTX) >> 10 : m >> 8, t = lat ? (m - M_CTX) & 1023 : m & 255, L = lat ? 1024 : 256;
        const int pr = t >> 6, pc = t & 63;
        const bf16* zr = Z + (size_t)m * ZP;
        const size_t orow = (size_t)((b * 2 + l) * 256 + t);
        const int krow = lat ? M_CTX + b * 1536 + 512 + t : m;
        {
            const v4u raw = *(const v4u*)(zr + 8 * lane); F8 x = bf8f(raw);
            const float ss = red8(ssq8(x)); const float rstd = 1.0f / sqrtf(ss * (1.f / 64.f) + 1e-6f);
            if (lane < 48) {
                const F8 g = ldf8((lane < 32 ? F.in[I_QNG] : F.in[I_KNG]) + l * 64 + 8 * j8);
#pragma unroll
                for (int e = 0; e < 8; ++e) x.v[e] = x.v[e] * rstd * g.v[e];
                if (!lat && lane >= 32) stf8(F.out + O_GK + orow * 128 + (lane - 32) * 8, x);
            } else if (!lat) stf8(F.out + O_GV + orow * 128 + (lane - 48) * 8, x);
            if (lat) {
                const int pos = (j8 < 4) ? pr : pc; const float* cs = tabA + (pos * 16 + 8 * (j8 & 1)) * 2; const bool second = (j8 & 2) != 0;
                const F8 c0 = ldf8(cs), c1 = ldf8(cs + 8);
#pragma unroll
                for (int e = 0; e < 8; ++e) { const float yp = shx<2>(x.v[e]); const float c = (e < 4 ? c0 : c1).v[2 * (e & 3)], sn = (e < 4 ? c0 : c1).v[2 * (e & 3) + 1];
                    const float r = second ? x.v[e] * c + yp * sn : x.v[e] * c - yp * sn; if (lane < 48) x.v[e] = r; }
            }
            if (lane < 32) *(v4u*)(QA + (size_t)m * 256 + 8 * lane) = fbf8(x);
            else if (lane < 48) *(v4u*)(KA + (size_t)krow * 128 + 8 * (lane - 32)) = fbf8(x);
            else *(v4u*)(VA + (size_t)krow * 128 + 8 * (lane - 48)) = raw;
        }
        if (!lat) { const F8 x = bf8f(*(const v4u*)(zr + Z_BK + 8 * lane)); stf8(F.out + (lane < 32 ? O_NK : O_NV) + orow * 256 + (lane & 31) * 8, x); }
#pragma unroll
        for (int pass = 0; pass < 2; ++pass) {
            if (pass == 0 || lane < 32) {
                const int lc = pass * 64 + lane, ch = 8 * lc; F8 acc;
#pragma unroll
                for (int e = 0; e < 8; ++e) acc.v[e] = 0.f;
#pragma unroll
                for (int j = 0; j < 4; ++j) { const int tt = t + j - 1;
                    if (tt >= 0 && tt < L) { const F8 w = ldf8(F.in[I_CONV] + (size_t)(l * 4 + j) * 768 + ch); const F8 xz = bf8f(*(const v4u*)(zr + (ptrdiff_t)(j - 1) * ZP + Z_CQKV + ch));
#pragma unroll
                        for (int e = 0; e < 8; ++e) acc.v[e] += w.v[e] * xz.v[e]; } }
#pragma unroll
                for (int e = 0; e < 8; ++e) acc.v[e] = silu_f(acc.v[e]);
                if (pass == 0) { const float ss = red8(ssq8(acc)); const float sc = (1.0f / sqrtf(ss + 1e-6f)) * (lane < 32 ? 0.125f : 1.0f);
#pragma unroll
                    for (int e = 0; e < 8; ++e) acc.v[e] *= sc;
                    *(v4u*)((lane < 32 ? DQ : DK) + (size_t)m * 256 + 8 * (lane & 31)) = fbf8(acc);
                } else *(v4u*)(DV + (size_t)m * 256 + 8 * lane) = fbf8(acc);
            }
        }
        if (lane < 8) {
            const float a = bf2f(zr[Z_CA + lane]), bb = bf2f(zr[Z_CB + lane]);
            const float beta = 1.0f / (1.0f + __expf(-bb));
            const float xx = a + F.in[I_DTB][l * 8 + lane];
            const float sp = fmaxf(xx, 0.f) + log1pf(__expf(-fabsf(xx)));
            BG[(size_t)m * 16 + lane] = beta; BG[(size_t)m * 16 + 8 + lane] = -__expf(F.in[I_ALOG][l * 8 + lane]) * sp;
        }
        {
            F8 x = bf8f(*(const v4u*)(zr + Z_DCQ + 8 * (lane < 52 ? lane : 51)));
            float s4 = red8(ssq8(x)); s4 += shx<8>(s4);
            const float s5 = s4 + shx<16>(s4);
            if (lane < 32) { const float rstd = 1.0f / sqrtf(s5 * (1.f / 256.f) + 1e-6f); const F8 g = ldf8(F.in[I_MQNG] + l * 256 + 8 * lane);
#pragma unroll
                for (int e = 0; e < 8; ++e) x.v[e] = x.v[e] * rstd * g.v[e];
                *(v4u*)(QN + (size_t)m * 256 + 8 * lane) = fbf8(x);
            } else if (lane < 48) { const float rstd = 1.0f / sqrtf(s4 * (1.f / 128.f) + 1e-6f); const F8 g = ldf8(F.in[I_MKVNG] + l * 128 + 8 * (lane - 32));
#pragma unroll
                for (int e = 0; e < 8; ++e) x.v[e] = x.v[e] * rstd * g.v[e];
                *(v4u*)(CKV + (size_t)m * 256 + 8 * (lane - 32)) = fbf8(x);
                if (!lat) stf8(F.out + O_CKV + orow * 128 + 8 * (lane - 32), x);
            }
            {
                const int q4 = lane & 3; const int pos = (q4 < 2) ? pr : pc; const float* cs = tabM + (pos * 8) * 2; const bool second = (q4 & 1) != 0;
                F8 r = x;
                if (lat) { const F8 c0 = ldf8(cs), c1 = ldf8(cs + 8);
#pragma unroll
                    for (int e = 0; e < 8; ++e) { const float yp = shx<1>(x.v[e]); const float c = (e < 4 ? c0 : c1).v[2 * (e & 3)], sn = (e < 4 ? c0 : c1).v[2 * (e & 3) + 1];
                        r.v[e] = second ? x.v[e] * c + yp * sn : x.v[e] * c - yp * sn; } }
                if (lane >= 48 && lane < 52) { *(v4u*)(KR + (size_t)m * 32 + 8 * (lane - 48)) = fbf8(r); if (!lat) stf8(F.out + O_KR + orow * 32 + 8 * (lane - 48), x); }
                if (lane >= 48) *(v4u*)(CKV + (size_t)m * 256 + 128 + 8 * (lane - 48)) = (v4u){0u, 0u, 0u, 0u};
            }
        }
    }
}

typedef short bf16x8 __attribute__((ext_vector_type(8)));
typedef float f32x16 __attribute__((ext_vector_type(16)));
struct AttDesc {
    const bf16* Q; int qs; int qrow0;
    const bf16 *K0, *K1, *R0, *R1, *V0, *V1; int ks0, ks1, rs0, rs1, vs0, vs1;
    int row00, row01, nt0, nt;
    bf16* O; float scale;
    int qpos0;
    int rlo; const float* nab;
};
constexpr int ATT_KT = 0, ATT_VT = 16384, ATT_NB = 28672, ATT_VROW = 68;
template <int DK, bool NA, bool QROPE>
__device__ __forceinline__ void attn_block(Frame& F, const AttDesc& D) {
    constexpr int KROWB = (DK + 8) * 2, NS = DK / 16;
    const int tid = F.tid, lane = F.lane, w = F.wave, lq = lane & 31, hh = lane >> 5;
    LAS unsigned char* lds = F.lds;
    __syncthreads();
    if constexpr (NA) { for (int e = tid; e < 465; e += NT) ((LAS float*)(lds + ATT_NB))[e] = D.nab[e] * LOG2E; }
    const int qrow = D.qrow0 + 32 * w + lq;
    bf16x8 qf[NS];
#pragma unroll
    for (int s = 0; s < NS; ++s) qf[s] = *(const bf16x8*)(D.Q + (size_t)qrow * D.qs + 16 * s + 8 * hh);
    if constexpr (QROPE) {
        const float* tabM = (const float*)(F.ws + WS_ROPE) + 2048; const int n = D.qpos0 + 32 * w + lq;
#pragma unroll
        for (int sx = 4; sx < 6; ++sx) { const int pos = sx == 4 ? (n >> 6) : (n & 63); const v4u qw = __builtin_bit_cast(v4u, qf[sx]); float res[8];
#pragma unroll
            for (int j = 0; j < 8; ++j) { const unsigned dw = qw[j >> 1]; const float own = (j & 1) ? bfhi(dw) : bflo(dw); const float oth = __shfl_xor(own, 32);
                const float c = tabM[(pos * 8 + j) * 2], sn = tabM[(pos * 8 + j) * 2 + 1]; res[j] = hh ? own * c + oth * sn : own * c - oth * sn; }
            v4u nw; nw.x = cvtpk(res[0], res[1]); nw.y = cvtpk(res[2], res[3]); nw.z = cvtpk(res[4], res[5]); nw.w = cvtpk(res[6], res[7]); qf[sx] = __builtin_bit_cast(bf16x8, nw); }
    }
    const int na_r = (D.qpos0 >> 6) + (w >> 1), na_c = (w & 1) * 32 + lq, na_r0 = min(max(na_r - 4, 0), 8), na_c0 = min(max(na_c - 8, 0), 48);
    f32x16 o0, o1;
#pragma unroll
    for (int r = 0; r < 16; ++r) { o0[r] = 0.f; o1[r] = 0.f; }
    float m = -1e30f, lsum = 0.f;
    v4u kreg, rreg = (v4u){0u, 0u, 0u, 0u}, vreg;
#define ATT_LOAD(t_) do { const int t__ = (t_); const bool sg = t__ >= D.nt0; const int r0_ = sg ? D.row01 + 64 * (t__ - D.nt0) : D.row00 + 64 * t__; \
        const bf16* Kb = sg ? D.K1 : D.K0; const bf16* Vb = sg ? D.V1 : D.V0; const int ks_ = sg ? D.ks1 : D.ks0, vs_ = sg ? D.vs1 : D.vs0; \
        kreg = *(const v4u*)(Kb + (size_t)(r0_ + (tid >> 3)) * ks_ + (tid & 7) * 8); \
        if constexpr (DK == 96) { if (tid < 256) { const bf16* Rb = sg ? D.R1 : D.R0; const int rs_ = sg ? D.rs1 : D.rs0; rreg = *(const v4u*)(Rb + (size_t)(r0_ + (tid >> 2)) * rs_ + (tid & 3) * 8); } } \
        vreg = *(const v4u*)(Vb + (size_t)(r0_ + lane) * vs_ + w * 8); } while (0)
    ATT_LOAD(0);
    for (int t = 0; t < D.nt; ++t) {
        __syncthreads();
        *(LAS v4u*)(lds + ATT_KT + (tid >> 3) * KROWB + (tid & 7) * 16) = kreg;
        if constexpr (DK == 96) { if (tid < 256) *(LAS v4u*)(lds + ATT_KT + (tid >> 2) * KROWB + 128 + (tid & 3) * 16) = rreg; }
        { LAS bf16* vt = (LAS bf16*)(lds + ATT_VT) + (8 * w) * ATT_VROW + lane;
#pragma unroll
          for (int i = 0; i < 8; ++i) { const unsigned dw = vreg[i >> 1]; vt[i * ATT_VROW] = (bf16)((i & 1) ? (dw >> 16) : (dw & 0xffffu)); } }
        __syncthreads();
        if (t + 1 < D.nt) ATT_LOAD(t + 1);
        bool rel = true; int kr = 0; bool local = false;
        if constexpr (NA) { if (t >= D.nt0) { local = true; kr = D.rlo + (t - D.nt0); rel = (kr >= na_r0) && (kr < na_r0 + 8); } }
        if (rel) {
            f32x16 s0, s1;
#pragma unroll
            for (int r = 0; r < 16; ++r) { s0[r] = 0.f; s1[r] = 0.f; }
#pragma unroll
            for (int s = 0; s < NS; ++s) {
                const bf16x8 a0 = *(const LAS bf16x8*)(lds + ATT_KT + lq * KROWB + 32 * s + 16 * hh);
                const bf16x8 a1 = *(const LAS bf16x8*)(lds + ATT_KT + (32 + lq) * KROWB + 32 * s + 16 * hh);
                s0 = __builtin_amdgcn_mfma_f32_32x32x16_bf16(a0, qf[s], s0, 0, 0, 0);
                s1 = __builtin_amdgcn_mfma_f32_32x32x16_bf16(a1, qf[s], s1, 0, 0, 0);
            }
            float tmax = -1e30f;
            if (NA && local) {
                const LAS float* nbp = (const LAS float*)(lds + ATT_NB) + (kr - na_r + 7) * 31 + 15 - na_c;
#pragma unroll
                for (int r = 0; r < 16; ++r) { const int kc0 = (r & 3) + 8 * (r >> 2) + 4 * hh, kc1 = kc0 + 32;
                    const bool al0 = (unsigned)(kc0 - na_c0) < 16u, al1 = (unsigned)(kc1 - na_c0) < 16u;
                    const float b0 = nbp[al0 ? kc0 : na_c], b1 = nbp[al1 ? kc1 : na_c];
                    s0[r] = al0 ? s0[r] * D.scale + b0 : -1e30f; s1[r] = al1 ? s1[r] * D.scale + b1 : -1e30f;
                    tmax = fmaxf(tmax, fmaxf(s0[r], s1[r])); }
            } else {
#pragma unroll
                for (int r = 0; r < 16; ++r) { s0[r] *= D.scale; s1[r] *= D.scale; tmax = fmaxf(tmax, fmaxf(s0[r], s1[r])); }
            }
            tmax = fmaxf(tmax, __shfl_xor(tmax, 32));
            const float mn = fmaxf(m, tmax); const float corr = __builtin_amdgcn_exp2f(m - mn); m = mn;
            float ps = 0.f;
#pragma unroll
            for (int r = 0; r < 16; ++r) { s0[r] = __builtin_amdgcn_exp2f(s0[r] - mn); s1[r] = __builtin_amdgcn_exp2f(s1[r] - mn); ps += s0[r] + s1[r]; }
            lsum = lsum * corr + ps;
#pragma unroll
            for (int r = 0; r < 16; ++r) { o0[r] *= corr; o1[r] *= corr; }
            bf16x8 pf[2][2];
#pragma unroll
            for (int s = 0; s < 2; ++s) { v4u p0, p1;
                p0.x = cvtpk(s0[8 * s + 0], s0[8 * s + 1]); p0.y = cvtpk(s0[8 * s + 2], s0[8 * s + 3]); p0.z = cvtpk(s0[8 * s + 4], s0[8 * s + 5]); p0.w = cvtpk(s0[8 * s + 6], s0[8 * s + 7]);
                p1.x = cvtpk(s1[8 * s + 0], s1[8 * s + 1]); p1.y = cvtpk(s1[8 * s + 2], s1[8 * s + 3]); p1.z = cvtpk(s1[8 * s + 4], s1[8 * s + 5]); p1.w = cvtpk(s1[8 * s + 6], s1[8 * s + 7]);
                pf[0][s] = __builtin_bit_cast(bf16x8, p0); pf[1][s] = __builtin_bit_cast(bf16x8, p1); }
#pragma unroll
            for (int kt = 0; kt < 2; ++kt)
#pragma unroll
                for (int s = 0; s < 2; ++s) {
                    const LAS unsigned char* vb0 = lds + ATT_VT + lq * (ATT_VROW * 2) + 8 * hh + 64 * kt + 32 * s;
                    const LAS unsigned char* vb1 = vb0 + 32 * (ATT_VROW * 2);
                    const v2u l0 = *(const LAS v2u*)(vb0), h0 = *(const LAS v2u*)(vb0 + 16), l1 = *(const LAS v2u*)(vb1), h1 = *(const LAS v2u*)(vb1 + 16);
                    const v4u a0 = {l0.x, l0.y, h0.x, h0.y}, a1 = {l1.x, l1.y, h1.x, h1.y};
                    o0 = __builtin_amdgcn_mfma_f32_32x32x16_bf16(__builtin_bit_cast(bf16x8, a0), pf[kt][s], o0, 0, 0, 0);
                    o1 = __builtin_amdgcn_mfma_f32_32x32x16_bf16(__builtin_bit_cast(bf16x8, a1), pf[kt][s], o1, 0, 0, 0);
                }
        }
    }
#undef ATT_LOAD
    lsum += __shfl_xor(lsum, 32);
    const float rl = 1.0f / lsum;
    bf16* orow = D.O + (size_t)qrow * 1024 + 4 * hh;
#pragma unroll
    for (int g = 0; g < 4; ++g) {
        v2u w0, w1; w0.x = cvtpk(o0[4 * g] * rl, o0[4 * g + 1] * rl); w0.y = cvtpk(o0[4 * g + 2] * rl, o0[4 * g + 3] * rl);
        w1.x = cvtpk(o1[4 * g] * rl, o1[4 * g + 1] * rl); w1.y = cvtpk(o1[4 * g + 2] * rl, o1[4 * g + 3] * rl);
        *(v2u*)(orow + 8 * g) = w0; *(v2u*)(orow + 32 + 8 * g) = w1;
    }
}
__device__ __forceinline__ void att_task(Frame& F, int ly, int mixer, bool lat, int b, int h, int qb) {
    const bf16* Z = (const bf16*)(F.ws + WS_Z);
    AttDesc D;
    D.qrow0 = lat ? M_CTX + b * 1024 + qb * 256 : b * 256; D.qpos0 = qb * 256; D.rlo = 0; D.nab = nullptr;
    D.R0 = nullptr; D.R1 = nullptr; D.rs0 = 0; D.rs1 = 0;
    if (mixer == 0) {
        D.Q = (const bf16*)(F.ws + WS_QA) + h * 64; D.qs = 256;
        D.K0 = D.K1 = (const bf16*)(F.ws + WS_KA) + (h >> 1) * 64; D.V0 = D.V1 = (const bf16*)(F.ws + WS_VA) + (h >> 1) * 64; D.ks0 = D.ks1 = D.vs0 = D.vs1 = 128;
        D.row00 = lat ? M_CTX + b * 1536 : b * 256; D.row01 = 0; D.nt0 = D.nt = lat ? 24 : 4;
        D.O = (bf16*)(F.ws + WS_O) + h * 64; D.scale = 0.125f * LOG2E;
        attn_block<64, false, false>(F, D);
    } else if (mixer == 1) {
        D.Q = Z + Z_BQ + h * 64; D.qs = ZP; D.O = (bf16*)(F.ws + WS_O) + 256 + h * 64; D.scale = 0.125f * LOG2E;
        D.K1 = Z + Z_BK + h * 64; D.V1 = Z + Z_BV + h * 64; D.ks1 = D.vs1 = ZP;
        if (!lat) { D.K0 = D.K1; D.V0 = D.V1; D.ks0 = D.vs0 = ZP; D.row00 = b * 256; D.row01 = 0; D.nt0 = D.nt = 4; attn_block<64, false, false>(F, D); }
        else {
            D.K0 = (const bf16*)(F.ws + WS_NKB) + h * 64; D.V0 = (const bf16*)(F.ws + WS_NVB) + h * 64; D.ks0 = D.vs0 = 256; D.row00 = b * 512; D.nt0 = 8;
            const int r_first = qb * 4, rlo = min(max(r_first - 4, 0), 8), rhi = min(max(r_first + 3 - 4, 0), 8) + 7;
            D.rlo = rlo; D.row01 = M_CTX + b * 1024 + rlo * 64; D.nt = 8 + (rhi - rlo + 1);
            D.nab = F.in[I_NAB] + (size_t)((ly * 4 + h) * 15) * 31;
            attn_block<64, true, false>(F, D);
        }
    } else {
        D.Q = (const bf16*)(F.ws + WS_QM) + h * 96; D.qs = 512; D.O = (bf16*)(F.ws + WS_O) + 768 + h * 64; D.scale = MLA_SCALE * LOG2E;
        D.K0 = D.K1 = (const bf16*)(F.ws + WS_KV) + h * 128; D.V0 = D.V1 = (const bf16*)(F.ws + WS_KV) + h * 128 + 64; D.R0 = D.R1 = (const bf16*)(F.ws + WS_KR);
        D.ks0 = D.ks1 = D.vs0 = D.vs1 = 512; D.rs0 = D.rs1 = 32;
        if (lat) { D.row00 = MTOK + b * 512; D.nt0 = 8; D.row01 = M_CTX + b * 1024; D.nt = 24; attn_block<96, false, true>(F, D); }
        else { D.row00 = b * 256; D.row01 = 0; D.nt0 = D.nt = 4; attn_block<96, false, false>(F, D); }
    }
}

constexpr int DN_KROW = 72, DN_AROW = 68;
constexpr int DNG_K = 0, DNG_Q = 9216, DNG_V = 18432, DNG_A = 27648, DNG_G = 27648 + 64 * DN_AROW * 4, DNG_BYTES = DNG_G + 1024;
static_assert(2 * DNG_BYTES <= RING_BYTES, "DeltaNet phase A LDS");
__device__ __forceinline__ int crow16(int r, int hh) { return (r & 3) + 8 * (r >> 2) + 4 * hh; }
__device__ __forceinline__ void dn_phase_a(Frame& F, int l) {
    const int tid = F.tid, lane = F.lane, lq = lane & 31, hh = lane >> 5, grp = tid >> 8, gt = tid & 255, gw = F.wave & 3;
    LAS unsigned char* gl = F.lds + grp * DNG_BYTES;
    LAS float* gsm = (LAS float*)(gl + DNG_G);
    const bf16* DQ = (const bf16*)(F.ws + WS_DQ); const bf16* DK = (const bf16*)(F.ws + WS_DK); const bf16* DV = (const bf16*)(F.ws + WS_DV); const float* BG = (const float*)(F.ws + WS_BG);
    for (int tp = F.bid; tp < 768; tp += F.G) {
        const int ta = 2 * tp + grp; const bool lat = ta < 1024;
        const int seq = lat ? ta >> 4 : 64 + ((ta - 1024) >> 2), n = lat ? ta & 15 : (ta - 1024) & 3, s2 = lat ? seq : seq - 64;
        const int b = s2 >> 3, h = (s2 >> 1) & 3, dir = s2 & 1, L = lat ? 1024 : 256, row0 = lat ? M_CTX + b * 1024 : b * 256;
        __syncthreads();
#pragma unroll
        for (int i = 0; i < 2; ++i) { const int idx = gt + 256 * i, c = idx >> 3, ch = idx & 7; const int step = 64 * n + c, t = dir ? L - 1 - step : step;
            const size_t src = (size_t)(row0 + t) * 256 + h * 64 + ch * 8;
            *(LAS v4u*)(gl + DNG_Q + c * (DN_KROW * 2) + ch * 16) = *(const v4u*)(DQ + src);
            *(LAS v4u*)(gl + DNG_K + c * (DN_KROW * 2) + ch * 16) = *(const v4u*)(DK + src);
            *(LAS v4u*)(gl + DNG_V + c * (DN_KROW * 2) + ch * 16) = *(const v4u*)(DV + src); }
        if (gw == 0) {
            const int step = 64 * n + lane, t = dir ? L - 1 - step : step; const size_t r = (size_t)(row0 + t) * 16;
            float val = BG[r + 8 + dir * 4 + h];
#pragma unroll
            for (int o = 1; o < 64; o <<= 1) { const float tt = __shfl_up(val, o); if (lane >= o) val += tt; }
            gsm[lane] = val; gsm[64 + lane] = BG[r + dir * 4 + h]; gsm[128 + lane] = __expf(val);
            ((float*)(F.ws + WS_GC))[(size_t)ta * 64 + lane] = val;
        }
        __syncthreads();
        {
            const int mat = gw >> 1, ti = gw & 1;
            const LAS unsigned char* xs = gl + (mat ? DNG_Q : DNG_K);
            const float gj0 = gsm[lq], gj1 = gsm[32 + lq];
#pragma unroll
            for (int tj = 0; tj < 2; ++tj) {
                f32x16 acc;
#pragma unroll
                for (int r = 0; r < 16; ++r) acc[r] = 0.f;
#pragma unroll
                for (int s = 0; s < 4; ++s) {
                    const bf16x8 av = *(const LAS bf16x8*)(xs + (32 * ti + lq) * (DN_KROW * 2) + 32 * s + 16 * hh);
                    const bf16x8 bv = *(const LAS bf16x8*)(gl + DNG_K + (32 * tj + lq) * (DN_KROW * 2) + 32 * s + 16 * hh);
                    acc = __builtin_amdgcn_mfma_f32_32x32x16_bf16(av, bv, acc, 0, 0, 0);
                }
                const int j = 32 * tj + lq; const float gj = tj ? gj1 : gj0;
                if (mat == 0) {
#pragma unroll
                    for (int r = 0; r < 16; ++r) { const int i = 32 * ti + crow16(r, hh); const float v = (j < i) ? gsm[64 + i] * acc[r] * __expf(gsm[i] - gj) : 0.f;
                        ((LAS float*)(gl + DNG_A))[i * DN_AROW + j] = v; }
                } else {
                    bf16* qkg = (bf16*)(F.ws + WS_QKG) + (size_t)ta * 4096;
#pragma unroll
                    for (int r = 0; r < 16; ++r) { const int i = 32 * ti + crow16(r, hh); const float v = (j <= i) ? acc[r] * __expf(gsm[i] - gj) : 0.f;
                        qkg[i * 64 + j] = (bf16)f2bf(v); }
                }
            }
        }
        __syncthreads();
        if (gw < 2) {
            const int cc = gt & 63; const bool isw = gt >= 64;
            const LAS bf16* src = (const LAS bf16*)(gl + (isw ? DNG_K : DNG_V)) + cc;
            const LAS float* As = (const LAS float*)(gl + DNG_A);
            float x[64];
#pragma unroll
            for (int i = 0; i < 64; ++i) x[i] = 0.f;
#pragma unroll
            for (int i = 0; i < 64; ++i) {
                float rv = bf2f(src[i * DN_KROW]) * gsm[64 + i]; if (isw) rv *= gsm[128 + i];
#pragma unroll
                for (int j4 = 0; j4 < (i + 3) / 4; ++j4) { const f32x4 a4 = *(const LAS f32x4*)(As + i * DN_AROW + 4 * j4);
                    rv -= a4.x * x[4 * j4]; rv -= a4.y * x[4 * j4 + 1]; rv -= a4.z * x[4 * j4 + 2]; rv -= a4.w * x[4 * j4 + 3]; }
                x[i] = rv;
                asm volatile("" : "+v"(x[i]) :: "memory");
            }
            if (!isw) {
                v4u* dst = (v4u*)((bf16*)(F.ws + WS_UT) + (size_t)ta * 4096 + cc * 64);
#pragma unroll
                for (int q8 = 0; q8 < 8; ++q8) { v4u w; w.x = pk2(x[8 * q8], x[8 * q8 + 1]); w.y = pk2(x[8 * q8 + 2], x[8 * q8 + 3]); w.z = pk2(x[8 * q8 + 4], x[8 * q8 + 5]); w.w = pk2(x[8 * q8 + 6], x[8 * q8 + 7]); dst[q8] = w; }
            } else {
                bf16* dst = (bf16*)(F.ws + WS_WN) + (size_t)ta * 4096 + cc;
#pragma unroll
                for (int i = 0; i < 64; ++i) dst[i * 64] = (bf16)f2bf(-x[i]);
            }
        } else if (dir == 0) {
            const int u = gt - 128, dk = u & 63, half = u >> 6;
            const int slot = lat ? (seq >> 1) * 16 + n : 512 + ((seq - 64) >> 1) * 4 + n;
            v4u* dst = (v4u*)((bf16*)(F.ws + WS_KT) + (size_t)slot * 4096 + dk * 64 + 32 * half);
            const LAS bf16* ks = (const LAS bf16*)(gl + DNG_K) + (32 * half) * DN_KROW + dk;
#pragma unroll
            for (int q8 = 0; q8 < 4; ++q8) { v4u w;
                w.x = (unsigned)ks[(8 * q8 + 0) * DN_KROW] | ((unsigned)ks[(8 * q8 + 1) * DN_KROW] << 16); w.y = (unsigned)ks[(8 * q8 + 2) * DN_KROW] | ((unsigned)ks[(8 * q8 + 3) * DN_KROW] << 16);
                w.z = (unsigned)ks[(8 * q8 + 4) * DN_KROW] | ((unsigned)ks[(8 * q8 + 5) * DN_KROW] << 16); w.w = (unsigned)ks[(8 * q8 + 6) * DN_KROW] | ((unsigned)ks[(8 * q8 + 7) * DN_KROW] << 16);
                dst[q8] = w; }
        }
    }
    __syncthreads();
}
__device__ __forceinline__ bf16x8 pack8(const f32x16& x, int s) {
    v4u p; p.x = cvtpk(x[8 * s + 0], x[8 * s + 1]); p.y = cvtpk(x[8 * s + 2], x[8 * s + 3]); p.z = cvtpk(x[8 * s + 4], x[8 * s + 5]); p.w = cvtpk(x[8 * s + 6], x[8 * s + 7]);
    return __builtin_bit_cast(bf16x8, p);
}
constexpr int SC_ROWB = 136, SC_TILE = 64 * SC_ROWB, SC_STAGE = 5 * SC_TILE, SC_GC = MISC_OFF + 192;
static_assert(3 * SC_STAGE <= RING_BYTES && SC_GC + 768 <= LDS_BYTES, "scan LDS");
__device__ __forceinline__ bf16x8 lds_frag(const LAS unsigned char* p) {
    const v2u lo = *(const LAS v2u*)p, hi = *(const LAS v2u*)(p + 16); const v4u a = {lo.x, lo.y, hi.x, hi.y}; return __builtin_bit_cast(bf16x8, a);
}
__device__ __forceinline__ unsigned rot16(unsigned x) { return (x >> 16) | (x << 16); }
struct ScanSeq { int b, h, dir, L, row0, nch, seq; bool lat; };
__device__ __forceinline__ void scan_ld_init(Frame& F, const ScanSeq& Q, int lt, const bf16* (&p)[7], int (&stride)[7], int (&dst)[7], const float*& gcp) {
    const int ta0 = Q.lat ? Q.seq * 16 : 1024 + (Q.seq - 64) * 4;
    const int ks0 = (Q.lat ? (Q.seq >> 1) * 16 : 512 + ((Q.seq - 64) >> 1) * 4) + (Q.dir ? Q.nch - 1 : 0);
#pragma unroll
    for (int i = 0; i < 7; ++i) {
        const int it = lt + 384 * i, tile = (it >> 9) > 4 ? 4 : (it >> 9), row = (it >> 3) & 63, ch = it & 7;
        const bf16* src; int st;
        if (tile == 0) { src = (const bf16*)(F.ws + WS_WN) + (size_t)ta0 * 4096 + row * 64 + ch * 8; st = 4096; }
        else if (tile == 1) { const int t = Q.dir ? Q.L - 1 - row : row; src = (const bf16*)(F.ws + WS_DQ) + Q.h * 64 + (size_t)(Q.row0 + t) * 256 + ch * 8; st = Q.dir ? -64 * 256 : 64 * 256; }
        else if (tile == 2) { src = (const bf16*)(F.ws + WS_QKG) + (size_t)ta0 * 4096 + row * 64 + ch * 8; st = 4096; }
        else if (tile == 3) { src = (const bf16*)(F.ws + WS_KT) + (size_t)ks0 * 4096 + row * 64 + (Q.dir ? 7 - ch : ch) * 8; st = Q.dir ? -4096 : 4096; }
        else { src = (const bf16*)(F.ws + WS_UT) + (size_t)ta0 * 4096 + row * 64 + ch * 8; st = 4096; }
        p[i] = src; stride[i] = st; dst[i] = tile * SC_TILE + row * SC_ROWB + ch * 16 + ((tile == 3 && Q.dir) ? (1 << 30) : 0);
    }
    gcp = (const float*)(F.ws + WS_GC) + (size_t)ta0 * 64 + (lt & 63);
}
__device__ __forceinline__ void scan_fetch(int lt, const bf16* (&p)[7], const int (&stride)[7], const int (&dst)[7], const float*& gcp, v4u (&r)[7], float& gcv) {
#pragma unroll
    for (int i = 0; i < 7; ++i) {
        if (i < 6 || lt < 256) {
            v4u w = *(const v4u*)p[i];
            if (dst[i] >> 30) w = (v4u){rot16(w.w), rot16(w.z), rot16(w.y), rot16(w.x)};
            r[i] = w; p[i] += stride[i];
        }
    }
    if (lt < 64) { gcv = *gcp; gcp += 64; }
}
__device__ __forceinline__ void scan_put(Frame& F, int stage, int lt, const int (&dst)[7], const v4u (&r)[7], float gcv) {
    LAS unsigned char* st = F.lds + stage * SC_STAGE;
#pragma unroll
    for (int i = 0; i < 7; ++i) { if (i < 6 || lt < 256) *(LAS v4u*)(st + (dst[i] & 0xfffffff)) = r[i]; }
    if (lt < 64) ((LAS float*)(F.lds + SC_GC))[stage * 64 + lt] = gcv;
}
__device__ __forceinline__ void scan_chunk(Frame& F, const ScanSeq& Q, int n, int stage, int ds, f32x16& S0, f32x16& S1, bf16* ODN) {
    const int lane = F.lane, lq = lane & 31, hh = lane >> 5;
    const LAS unsigned char* st = F.lds + stage * SC_STAGE;
    const LAS float* gc = (const LAS float*)(F.lds + SC_GC) + stage * 64;
    const LAS unsigned char* r0p = st + lq * SC_ROWB + 8 * hh;
    const float gl = gc[63];
    bf16x8 sb[4]; sb[0] = pack8(S0, 0); sb[1] = pack8(S0, 1); sb[2] = pack8(S1, 0); sb[3] = pack8(S1, 1);
    f32x16 vn0, vn1;
    { const LAS unsigned char* up = st + 4 * SC_TILE + (32 * ds + lq) * SC_ROWB + 8 * hh;
#pragma unroll
      for (int g = 0; g < 4; ++g) { const v2u a = *(const LAS v2u*)(up + 16 * g), c2 = *(const LAS v2u*)(up + 64 + 16 * g);
        vn0[4 * g] = bflo(a.x); vn0[4 * g + 1] = bfhi(a.x); vn0[4 * g + 2] = bflo(a.y); vn0[4 * g + 3] = bfhi(a.y);
        vn1[4 * g] = bflo(c2.x); vn1[4 * g + 1] = bfhi(c2.x); vn1[4 * g + 2] = bflo(c2.y); vn1[4 * g + 3] = bfhi(c2.y); } }
    f32x16 o0, o1;
#pragma unroll
    for (int r = 0; r < 16; ++r) { o0[r] = 0.f; o1[r] = 0.f; }
#pragma unroll
    for (int s = 0; s < 4; ++s) {
        vn0 = __builtin_amdgcn_mfma_f32_32x32x16_bf16(lds_frag(r0p + 32 * s), sb[s], vn0, 0, 0, 0);
        vn1 = __builtin_amdgcn_mfma_f32_32x32x16_bf16(lds_frag(r0p + 32 * SC_ROWB + 32 * s), sb[s], vn1, 0, 0, 0);
        o0 = __builtin_amdgcn_mfma_f32_32x32x16_bf16(lds_frag(r0p + SC_TILE + 32 * s), sb[s], o0, 0, 0, 0);
        o1 = __builtin_amdgcn_mfma_f32_32x32x16_bf16(lds_frag(r0p + SC_TILE + 32 * SC_ROWB + 32 * s), sb[s], o1, 0, 0, 0);
    }
    asm volatile("" : "+v"(vn0), "+v"(vn1), "+v"(o0), "+v"(o1) :: "memory");
#pragma unroll
    for (int g = 0; g < 4; ++g) { const f32x4 a = *(const LAS f32x4*)(gc + 8 * g + 4 * hh), c2 = *(const LAS f32x4*)(gc + 32 + 8 * g + 4 * hh);
        o0[4 * g] *= __expf(a.x); o0[4 * g + 1] *= __expf(a.y); o0[4 * g + 2] *= __expf(a.z); o0[4 * g + 3] *= __expf(a.w);
        o1[4 * g] *= __expf(c2.x); o1[4 * g + 1] *= __expf(c2.y); o1[4 * g + 2] *= __expf(c2.z); o1[4 * g + 3] *= __expf(c2.w); }
    {
        bf16x8 vb[4]; vb[0] = pack8(vn0, 0); vb[1] = pack8(vn0, 1); vb[2] = pack8(vn1, 0); vb[3] = pack8(vn1, 1);
#pragma unroll
        for (int s = 0; s < 4; ++s) {
            o0 = __builtin_amdgcn_mfma_f32_32x32x16_bf16(lds_frag(r0p + 2 * SC_TILE + 32 * s), vb[s], o0, 0, 0, 0);
            o1 = __builtin_amdgcn_mfma_f32_32x32x16_bf16(lds_frag(r0p + 2 * SC_TILE + 32 * SC_ROWB + 32 * s), vb[s], o1, 0, 0, 0);
        }
    }
    asm volatile("" : "+v"(o0), "+v"(o1) :: "memory");
    {
        const ptrdiff_t rs = Q.dir ? -256 : 256;
        bf16* op = ODN + (ptrdiff_t)(Q.row0 + (Q.dir ? Q.L - 1 - 64 * n : 64 * n)) * 256 + rs * (4 * hh);
#pragma unroll
        for (int r = 0; r < 16; ++r) { op[0] = (bf16)f2bf(o0[r]); op[rs * 32] = (bf16)f2bf(o1[r]); op += ((r & 3) == 3) ? rs * 5 : rs; asm volatile("" : "+v"(op)); }
    }
#pragma unroll
    for (int g = 0; g < 4; ++g) { const f32x4 a = *(const LAS f32x4*)(gc + 8 * g + 4 * hh), c2 = *(const LAS f32x4*)(gc + 32 + 8 * g + 4 * hh);
        vn0[4 * g] *= __expf(gl - a.x); vn0[4 * g + 1] *= __expf(gl - a.y); vn0[4 * g + 2] *= __expf(gl - a.z); vn0[4 * g + 3] *= __expf(gl - a.w);
        vn1[4 * g] *= __expf(gl - c2.x); vn1[4 * g + 1] *= __expf(gl - c2.y); vn1[4 * g + 2] *= __expf(gl - c2.z); vn1[4 * g + 3] *= __expf(gl - c2.w); }
    {
        bf16x8 vb[4]; vb[0] = pack8(vn0, 0); vb[1] = pack8(vn0, 1); vb[2] = pack8(vn1, 0); vb[3] = pack8(vn1, 1);
        const float egl = __expf(gl);
#pragma unroll
        for (int r = 0; r < 16; ++r) { S0[r] *= egl; S1[r] *= egl; }
#pragma unroll
        for (int s = 0; s < 4; ++s) {
            S0 = __builtin_amdgcn_mfma_f32_32x32x16_bf16(lds_frag(r0p + 3 * SC_TILE + 32 * s), vb[s], S0, 0, 0, 0);
            S1 = __builtin_amdgcn_mfma_f32_32x32x16_bf16(lds_frag(r0p + 3 * SC_TILE + 32 * SC_ROWB + 32 * s), vb[s], S1, 0, 0, 0);
        }
    }
}
__device__ __forceinline__ void dn_scan_task(Frame& F, int l, int seq) {
    ScanSeq Q; Q.seq = seq; Q.lat = seq < 64; const int s2 = Q.lat ? seq : seq - 64;
    Q.b = s2 >> 3; Q.h = (s2 >> 1) & 3; Q.dir = s2 & 1; Q.L = Q.lat ? 1024 : 256; Q.row0 = Q.lat ? M_CTX + Q.b * 1024 : Q.b * 256; Q.nch = Q.L >> 6;
    const int lane = F.lane, lq = lane & 31, hh = lane >> 5, w = F.wave, lt = F.tid - 128;
    const bool loader = w >= 2;
    const int dv = 32 * (w & 1) + lq;
    bf16* ODN = (bf16*)(F.ws + WS_ODN) + (size_t)Q.dir * MTOK * 256 + Q.h * 64 + dv;
    __syncthreads();
    if (loader) {
        v4u ra[7], rb[7]; float ga = 0.f, gb = 0.f;
        const bf16* lp[7]; int lstride[7], ldst[7]; const float* gcp;
        scan_ld_init(F, Q, lt, lp, lstride, ldst, gcp);
#pragma unroll
        for (int i = 0; i < 7; ++i) { ra[i] = (v4u){0u, 0u, 0u, 0u}; rb[i] = (v4u){0u, 0u, 0u, 0u}; }
        scan_fetch(lt, lp, lstride, ldst, gcp, ra, ga); scan_fetch(lt, lp, lstride, ldst, gcp, rb, gb);
        scan_put(F, 0, lt, ldst, ra, ga); scan_put(F, 1, lt, ldst, rb, gb);
        scan_fetch(lt, lp, lstride, ldst, gcp, ra, ga); scan_fetch(lt, lp, lstride, ldst, gcp, rb, gb);
        __syncthreads();
        for (int n = 0; n < Q.nch; n += 2) {
            if (n + 2 < Q.nch) scan_put(F, (n + 2) % 3, lt, ldst, ra, ga);
            if (n + 4 < Q.nch) scan_fetch(lt, lp, lstride, ldst, gcp, ra, ga);
            __syncthreads();
            if (n + 3 < Q.nch) scan_put(F, (n + 3) % 3, lt, ldst, rb, gb);
            if (n + 5 < Q.nch) scan_fetch(lt, lp, lstride, ldst, gcp, rb, gb);
            __syncthreads();
        }
    } else {
        f32x16 S0, S1;
#pragma unroll
        for (int r = 0; r < 16; ++r) { S0[r] = 0.f; S1[r] = 0.f; }
        if (Q.lat) {
            const float* s0p = F.in[I_SDN] + ((size_t)(((Q.b * 2 + l) * 2 + Q.dir) * 4 + Q.h) * 64) * 64 + dv + 4 * hh * 64;
#pragma unroll
            for (int r = 0; r < 16; ++r) { S0[r] = s0p[0]; S1[r] = s0p[32 * 64]; s0p += ((r & 3) == 3) ? 5 * 64 : 64; asm volatile("" : "+v"(s0p)); }
        }
        __syncthreads();
        for (int n = 0; n < Q.nch; n += 2) {
            scan_chunk(F, Q, n, n % 3, w, S0, S1, ODN);
            __syncthreads();
            scan_chunk(F, Q, n + 1, (n + 1) % 3, w, S0, S1, ODN);
            __syncthreads();
        }
        if (!Q.lat) {
            float* dst = F.out + O_DS + ((size_t)(((Q.b * 2 + l) * 2 + Q.dir) * 4 + Q.h) * 64) * 64 + dv + 4 * hh * 64;
#pragma unroll
            for (int r = 0; r < 16; ++r) { dst[0] = S0[r]; dst[32 * 64] = S1[r]; dst += ((r & 3) == 3) ? 5 * 64 : 64; asm volatile("" : "+v"(dst)); }
        }
    }
}

__device__ __forceinline__ void mixer_phase(Frame& F, int l) {
    for (int task = F.bid; task < 768; task += F.G) if (task >= 384 && task < 576) dn_scan_task(F, l, task - 384);
    for (int task = F.bid; task < 768; task += F.G) {
        if (task >= 384 && task < 576) continue;
        int mixer, b, h, qb = 0; bool lat = true;
        if (task < 128) { mixer = 2; b = task >> 4; h = (task >> 2) & 3; qb = task & 3; }
        else if (task < 256) { const int t = task - 128; mixer = 0; b = t >> 4; h = (t >> 2) & 3; qb = t & 3; }
        else if (task < 384) { const int t = task - 256; mixer = 1; b = t >> 4; h = (t >> 2) & 3; qb = t & 3; }
        else { const int t = (task - 576) & 63; mixer = (task - 576) >> 6; lat = false; b = t >> 2; h = t & 3; }
        att_task(F, l, mixer, lat, b, h, qb);
    }
}

__device__ __forceinline__ void dn_combine(Frame& F, int l) {
    const int gw = F.bid * NWAVES + F.wave, NGW = F.G * NWAVES, lane = F.lane;
    const bf16* Z = (const bf16*)(F.ws + WS_Z); bf16* O = (bf16*)(F.ws + WS_O);
    const bf16* O0 = (const bf16*)(F.ws + WS_ODN); const bf16* O1 = O0 + (size_t)MTOK * 256;
    const float g = F.in[I_DNOG][l * 64 + lane];
    for (int m = gw; m < MTOK; m += NGW) {
#pragma unroll
        for (int h = 0; h < 4; ++h) {
            const float v = bf2f(O0[(size_t)m * 256 + h * 64 + lane]) + bf2f(O1[(size_t)m * 256 + h * 64 + lane]);
            const float ss = wave_sum(v * v);
            const float y = v * (1.0f / sqrtf(ss * (1.f / 64.f) + 1e-6f)) * g * silu_f(bf2f(Z[(size_t)m * ZP + Z_CG + h * 64 + lane]));
            O[(size_t)m * 1024 + 512 + h * 64 + lane] = (bf16)f2bf(y);
        }
    }
}

constexpr int N_PHASES = 2 + 10 * DEPTH;
__global__ void __launch_bounds__(NT, 2) hybrid_fwd(Args args) {
    extern __shared__ __attribute__((aligned(16))) unsigned char lds_raw[];
    Frame F;
    F.lds = (LAS unsigned char*)lds_raw;
    F.tid = threadIdx.x; F.lane = F.tid & 63; F.wave = __builtin_amdgcn_readfirstlane(F.tid >> 6);
    F.G = gridDim.x; F.bid = blockIdx.x;
    F.in = args.in; F.out = args.out; F.ws = args.ws;
    volatile LAS unsigned* MISC = (volatile LAS unsigned*)(F.lds + MISC_OFF);
    for (int u = F.tid; u < (LDS_BYTES - LDSCTL_OFF) / 4; u += NT) ((LAS unsigned*)(F.lds + LDSCTL_OFF))[u] = 0u;
    __syncthreads();
    XcdBarrier bar; bar.bar = (unsigned*)(F.ws + WS_CTL) + CW_BAR; bar.x = 0; bar.st = nullptr;
#if !MK_PER_PHASE
    bar = xcd_barrier_post((unsigned*)(F.ws + WS_CTL) + CW_BAR, MISC + 8);
#endif
    int redo = 0;
    for (int ph = args.ph_lo; ph < args.ph_hi; ++ph) {
        {
            int tid_ = threadIdx.x, bid_ = blockIdx.x; unsigned char* ws_ = args.ws; float* out_ = args.out;
            asm volatile("" : "+v"(tid_)); asm volatile("" : "+s"(bid_)); asm volatile("" : "+s"(ws_)); asm volatile("" : "+s"(out_));
            F.tid = tid_; F.lane = tid_ & 63; F.wave = __builtin_amdgcn_readfirstlane(tid_ >> 6); F.bid = bid_; F.ws = ws_; F.out = out_;
        }
        const float* mods = (const float*)(F.ws + WS_MODS);
        if (ph == 0) { p0a(F); convert_weights(F, 0); }
        else if (ph == 1) norm_rows<0>(F, true, F.in[I_N1G], mods, 0, 1024);
        else {
            const int l = (ph - 2) / 10, sp = (ph - 2) % 10;
            unsigned char* wl = F.ws + WS_W;
            const float* mods_l = mods + (size_t)l * 9 * 6144;
            if (sp == 0) {
                pg8::Gemm g{(const bf16*)(F.ws + WS_XN), (const bf16*)(wl + W_IN), MTOK, ZP, 1024}; pg8::StaticOrder S; S.init(MTOK, ZP, F.G, F.bid);
                pg8::EpiBf16 E{(bf16*)(F.ws + WS_Z), ZP};
                pg8::gemm_phase<pg8::EpiBf16, pg8::StaticOrder, true, true>(F.lds, g, S, E, F.tid);
            } else if (sp == 1) prep_phase(F, l);
            else if (sp == 2) {
                { pg8::Gemm g{(const bf16*)(F.ws + WS_QN), (const bf16*)(wl + W_Q), MTOK, 512, 256}; pg8::StaticOrder S; S.init(MTOK, 512, F.G, F.bid);
                  pg8::EpiBf16 E{(bf16*)(F.ws + WS_QM), 512};
                  pg8::gemm_phase<pg8::EpiBf16, pg8::StaticOrder, true, true>(F.lds, g, S, E, F.tid); }
                { pg8::Gemm g{(const bf16*)(F.ws + WS_CKV), (const bf16*)(wl + W_KV), KVROWS, 512, 256}; pg8::StaticOrder S; S.init(KVROWS, 512, F.G, (F.bid + F.G - 96) % F.G);
                  pg8::EpiBf16 E{(bf16*)(F.ws + WS_KV), 512};
                  pg8::gemm_phase<pg8::EpiBf16, pg8::StaticOrder, true, true>(F.lds, g, S, E, F.tid); }
                dn_phase_a(F, l);
            } else if (sp == 3) mixer_phase(F, l);
            else if (sp == 4) dn_combine(F, l);
            else if (sp == 5) {
                pg8::Gemm g{(const bf16*)(F.ws + WS_O), (const bf16*)(wl + W_OUT), MTOK, 1024, 1024}; pg8::StaticOrder S; S.init(MTOK, 1024, F.G, F.bid);
                pg8::EpiRes E{l == 0 ? F.in[I_XP] : F.out, l == 0 ? F.in[I_XS] : F.out + (size_t)M_CTX * DM, F.out, mods_l + 2 * 1024};
                pg8::gemm_phase<pg8::EpiRes, pg8::StaticOrder, true, true>(F.lds, g, S, E, F.tid);
            } else if (sp == 6) norm_rows<0>(F, false, F.in[I_N2G] + l * 1024, mods_l, 3 * 1024, 4 * 1024);
            else if (sp == 7) {
                pg8::Gemm g{(const bf16*)(F.ws + WS_XN), (const bf16*)(wl + W_GU), MTOK, NGU, 1024}; pg8::StaticOrder S; S.init(MTOK, NGU, F.G, F.bid);
                pg8::EpiSwiglu E{(bf16*)(F.ws + WS_Z), FF};
                pg8::gemm_phase<pg8::EpiSwiglu, pg8::StaticOrder, true, true>(F.lds, g, S, E, F.tid);
            } else if (sp == 8) {
                pg8::Gemm g{(const bf16*)(F.ws + WS_Z), (const bf16*)(wl + W_D), MTOK, 1024, FF}; pg8::StaticOrder S; S.init(MTOK, 1024, F.G, F.bid);
                pg8::EpiRes E{F.out, F.out + (size_t)M_CTX * DM, F.out, mods_l + 5 * 1024};
                pg8::gemm_phase<pg8::EpiRes, pg8::StaticOrder, true, true>(F.lds, g, S, E, F.tid);
            } else {
                if (l + 1 < DEPTH) { norm_rows<0>(F, false, F.in[I_N1G] + (l + 1) * 1024, mods_l + 9 * 6144, 0, 1024); convert_weights(F, l + 1); }
                else norm_rows<1>(F, false, F.in[I_FG], nullptr, 0, 0);
            }
        }
#if !MK_PER_PHASE
        if (ph + 1 < args.ph_hi) xcd_barrier(bar);
#endif
        if (REPEAT_MASK) { const int bit = ph == 0 ? 10 : (ph == 1 ? 11 : (ph - 2) % 10); if ((REPEAT_MASK >> bit) & 1) { if (!redo) { redo = 1; --ph; } else redo = 0; } }
    }
}

extern "C" void kernel_launch(void* const* d_in, const int* in_sizes, int n_in, void* d_out, int out_size, void* d_ws, size_t ws_size, hipStream_t stream) {
    static int grid = 0;
    if (grid == 0) {
        if (n_in != N_IN || out_size != (int)O_END || ws_size < WS_END) { fprintf(stderr, "kernel_launch: unexpected shapes: n_in %d out %d ws %zu\n", n_in, out_size, ws_size); grid = -1; return; }
        int dev = 0, cus = 0, per_cu = 0;
        if (hipGetDevice(&dev) != hipSuccess || hipDeviceGetAttribute(&cus, hipDeviceAttributeMultiprocessorCount, dev) != hipSuccess) { grid = -1; return; }
        if (hipFuncSetAttribute((const void*)hybrid_fwd, hipFuncAttributeMaxDynamicSharedMemorySize, LDS_BYTES) != hipSuccess) { fprintf(stderr, "kernel_launch: hipFuncSetAttribute failed\n"); grid = -1; return; }
        if (hipOccupancyMaxActiveBlocksPerMultiprocessor(&per_cu, (const void*)hybrid_fwd, NT, LDS_BYTES) != hipSuccess || per_cu < 1) { fprintf(stderr, "kernel_launch: occupancy query says %d\n", per_cu); }
        (void)hipGetLastError();
        grid = cus;
    }
    if (grid < 0) return;
    (void)hipMemsetAsync((char*)d_ws + WS_CTL, 0, CTL_ZERO_BYTES, stream);
    Args a{};
    for (int i = 0; i < N_IN; ++i) a.in[i] = (const float*)d_in[i];
    a.out = (float*)d_out; a.ws = (unsigned char*)d_ws;
#if MK_PER_PHASE
    for (int ph = 0; ph < N_PHASES; ++ph) { a.ph_lo = ph; a.ph_hi = ph + 1; hipLaunchKernelGGL(hybrid_fwd, dim3(grid), dim3(NT), LDS_BYTES, stream, a); }
#else
    a.ph_lo = 0; a.ph_hi = N_PHASES;
    void* kargs[] = {&a};
    hipError_t e = hipLaunchCooperativeKernel((const void*)hybrid_fwd, dim3(grid), dim3(NT), kargs, LDS_BYTES, stream);
    if (e != hipSuccess) fprintf(stderr, "kernel_launch: cooperative launch failed: %s (grid %d)\n", hipGetErrorString(e), grid);
#endif
}
```

```cpp
#include <hip/hip_runtime.h>
#include <cstdio>
#include <cstdint>

#ifndef REPEAT_MASK
#define REPEAT_MASK 0
#endif
#ifndef MK_PER_PHASE
#define MK_PER_PHASE 0
#endif

namespace pg8 {
#define PG8_LAS __attribute__((address_space(3)))
typedef unsigned short bf16_t;
typedef short bf16x8 __attribute__((ext_vector_type(8)));
typedef float f32x4 __attribute__((ext_vector_type(4)));
typedef unsigned u32x4 __attribute__((ext_vector_type(4)));
typedef unsigned u32x2 __attribute__((ext_vector_type(2)));
constexpr int BM = 256, BK = 64, HALF = 128, HTB = HALF * BK * 2, STAGE_BYTES = 8 * HTB, NXCD = 8, WGM = 8;

__host__ __device__ __forceinline__ int lds_byte(int r, int c) { const int st = (r >> 4) * 2 + (c >> 5), rr = r & 15, cc = c & 31, ob = rr * 64 + cc * 2; return st * 1024 + (ob ^ (((ob >> 9) & 1) << 5)); }
__host__ __device__ __forceinline__ void stage_rc(int b, int& R, int& C) { const int st = b / 1024, sb = b % 1024, swz = sb ^ (((sb >> 9) & 1) << 5); R = (st >> 1) * 16 + swz / 64; C = (st & 1) * 32 + (swz % 64) / 2; }
__host__ __device__ __forceinline__ int perm32(int rho) { const int n = rho >> 4, i = rho & 15; return 8 * (i >> 2) + 4 * n + (i & 3); }

struct Unit { int pm, pn; };
struct Gemm { const bf16_t* A; const bf16_t* Bt; int M, N, K; };

struct StaticOrder {
    int nM, nN, nwg, G, c;
    __host__ __device__ void init(int M, int N, int G_, int c_) { nM = M / BM; nN = N / BM; nwg = nM * nN; G = G_; c = c_; }
    __host__ __device__ bool next(int i, Unit& u) const {
        const long L = (long)i * G + c; if (L >= nwg) return false;
        int wgid = (int)L; { const int q = nwg / NXCD, r = nwg % NXCD, xcd = wgid % NXCD, off = wgid / NXCD; wgid = (xcd < r ? xcd * (q + 1) : r * (q + 1) + (xcd - r) * q) + off; }
        const int nig = WGM * nN, gid = wgid / nig, fm = gid * WGM, gsz = (nM - fm) < WGM ? (nM - fm) : WGM;
        u.pm = fm + ((wgid % nig) % gsz); u.pn = (wgid % nig) / gsz; return true;
    }
    __device__ __forceinline__ void a_ready(const Unit&) const {}
    __device__ __forceinline__ void done(const Unit&) const {}
};

__device__ __forceinline__ unsigned cvt_pk_bf16(float lo, float hi) { unsigned r; asm volatile("v_cvt_pk_bf16_f32 %0, %1, %2" : "=v"(r) : "v"(lo), "v"(hi)); return r; }

struct EpiBf16 {
    static constexpr bool PERM = true, AFTER_DRAIN = false;
    bf16_t* O; int ldc;
    __device__ __forceinline__ void operator()(const f32x4 (&acc)[2][2][4][2], const Unit& u, int wr, int wc, int fr, int fq) const {
        const int row0 = u.pm * BM + wr * 64 + fr; const int col0 = u.pn * BM + wc * 32 + 8 * fq;
#pragma unroll
        for (int ai = 0; ai < 2; ++ai)
#pragma unroll
            for (int m = 0; m < 4; ++m) { bf16_t* rowp = O + (size_t)(row0 + ai * HALF + m * 16) * ldc + col0;
#pragma unroll
                for (int bj = 0; bj < 2; ++bj) { const f32x4 v0 = acc[ai][bj][m][0], v1 = acc[ai][bj][m][1];
                    u32x4 w; w.x = cvt_pk_bf16(v0[0], v0[1]); w.y = cvt_pk_bf16(v0[2], v0[3]); w.z = cvt_pk_bf16(v1[0], v1[1]); w.w = cvt_pk_bf16(v1[2], v1[3]);
                    *(u32x4*)(rowp + bj * HALF) = w; } }
    }
};
struct EpiSwiglu {
    static constexpr bool PERM = true, AFTER_DRAIN = false;
    bf16_t* O; int ldc;
    __device__ __forceinline__ static float sw(float g, float u) { return g * u / (1.0f + __expf(-g)); }
    __device__ __forceinline__ void operator()(const f32x4 (&acc)[2][2][4][2], const Unit& u, int wr, int wc, int fr, int fq) const {
        const int row0 = u.pm * BM + wr * 64 + fr; const int col0 = (u.pn * BM + wc * 32 + 8 * fq) >> 1;
#pragma unroll
        for (int ai = 0; ai < 2; ++ai)
#pragma unroll
            for (int m = 0; m < 4; ++m) { bf16_t* rowp = O + (size_t)(row0 + ai * HALF + m * 16) * ldc + col0;
#pragma unroll
                for (int bj = 0; bj < 2; ++bj) { const f32x4 v0 = acc[ai][bj][m][0], v1 = acc[ai][bj][m][1];
                    u32x2 w; w.x = cvt_pk_bf16(sw(v0[0], v0[1]), sw(v0[2], v0[3])); w.y = cvt_pk_bf16(sw(v1[0], v1[1]), sw(v1[2], v1[3]));
                    *(u32x2*)(rowp + bj * (HALF / 2)) = w; } }
    }
};
struct EpiRes {
    static constexpr bool PERM = false, AFTER_DRAIN = false;
    const float* base_a; const float* base_b; float* out; const float* gate;
    __device__ __forceinline__ void operator()(const f32x4 (&acc)[2][2][4][2], const Unit& u, int wr, int wc, int fr, int fq) const {
        const int col0 = u.pn * BM + wc * 32 + 4 * fq;
        const int rmod = u.pm < 16 ? 0 : 1 + ((u.pm - 16) >> 2);
        const float* g = gate + (size_t)rmod * 6144 + col0;
        const float* bp = u.pm < 16 ? base_a + (size_t)u.pm * BM * 1024 : base_b + (size_t)(u.pm - 16) * BM * 1024;
        float* op = out + (size_t)u.pm * BM * 1024;
        f32x4 gv[2][2];
#pragma unroll
        for (int bj = 0; bj < 2; ++bj)
#pragma unroll
            for (int n = 0; n < 2; ++n) gv[bj][n] = *(const f32x4*)(g + bj * HALF + n * 16);
#pragma unroll
        for (int ai = 0; ai < 2; ++ai)
#pragma unroll
            for (int m = 0; m < 4; ++m) { const size_t off = (size_t)(ai * HALF + wr * 64 + m * 16 + fr) * 1024 + col0;
#pragma unroll
                for (int bj = 0; bj < 2; ++bj)
#pragma unroll
                    for (int n = 0; n < 2; ++n) { const f32x4 bs = *(const f32x4*)(bp + off + bj * HALF + n * 16);
                        *(f32x4*)(op + off + bj * HALF + n * 16) = bs + gv[bj][n] * acc[ai][bj][m][n]; } }
    }
};

template <class Epi, class Sched, bool ALIGN_EPI = false, bool SP2 = false>
__device__ __forceinline__ void gemm_phase(PG8_LAS unsigned char* lds, const Gemm g, const Sched& S, const Epi& E, const int tid) {
    const int wid = __builtin_amdgcn_readfirstlane(tid >> 6), lane = tid & 63, wr = wid >> 2, wc = wid & 3, fr = lane & 15, fq = lane >> 4;
    const int K = g.K, nt = K / BK;
    unsigned voffA[2], voffB[2];
#pragma unroll
    for (int i = 0; i < 2; ++i) { int R, C; stage_rc(tid * 16 + i * 8192, R, C); const int Rb = Epi::PERM ? ((R & ~31) + perm32(R & 31)) : R;
        voffA[i] = (unsigned)(R * K + C) * 2u; voffB[i] = (unsigned)(Rb * K + C) * 2u; }
    const size_t kstep = (size_t)(BK * 2);
    const size_t hstep = (size_t)HALF * K * 2;
    const size_t tstep = 2 * hstep;
    const unsigned ldsw = (unsigned)wid * 1024u;
    const int aoff = lds_byte(wr * 64 + fr, fq * 8), boff = lds_byte(wc * 32 + fr, fq * 8);
#define PG8_SA(b, h) (((b) * 2 + (h)) * HTB)
#define PG8_SB(b, h) ((4 + (b) * 2 + (h)) * HTB)
#define PG8_STAGE(bufoff, gbase, voff) do { _Pragma("unroll") for (int _i = 0; _i < 2; ++_i) \
        __builtin_amdgcn_global_load_lds((const unsigned*)((const char*)(gbase) + (voff)[_i]), (PG8_LAS unsigned*)(lds + (bufoff) + ldsw + _i * 8192), 16, 0, 0); } while (0)
#define PG8_LDA(dst, b, h) do { _Pragma("unroll") for (int m = 0; m < 4; ++m) _Pragma("unroll") for (int k = 0; k < 2; ++k) dst[m][k] = *(const PG8_LAS bf16x8*)(lds + PG8_SA(b, h) + aoff + m * 2048 + k * 1024); } while (0)
#define PG8_LDB(dst, b, h) do { _Pragma("unroll") for (int n = 0; n < 2; ++n) _Pragma("unroll") for (int k = 0; k < 2; ++k) dst[n][k] = *(const PG8_LAS bf16x8*)(lds + PG8_SB(b, h) + boff + n * 2048 + k * 1024); } while (0)
#define PG8_MMA(ai, bj, At, Bt) do { __builtin_amdgcn_s_setprio(1); _Pragma("unroll") for (int m = 0; m < 4; ++m) _Pragma("unroll") for (int n = 0; n < 2; ++n) _Pragma("unroll") for (int k = 0; k < 2; ++k) \
        acc[ai][bj][m][n] = __builtin_amdgcn_mfma_f32_16x16x32_bf16(Bt[n][k], At[m][k], acc[ai][bj][m][n], 0, 0, 0); __builtin_amdgcn_s_setprio(0); } while (0)
#define PG8_WAIT_V(n) asm volatile("s_waitcnt vmcnt(" #n ")" ::: "memory")
#define PG8_WAIT_L(n) asm volatile("s_waitcnt lgkmcnt(" #n ")" ::: "memory")
#define PG8_BAR __builtin_amdgcn_s_barrier()
#define PG8_SCHED __builtin_amdgcn_sched_barrier(0)
    Unit cur, nxt; int ui = 0;
    if (!S.next(0, cur)) return;
    f32x4 acc[2][2][4][2];
#pragma unroll
    for (int a = 0; a < 2; ++a)
#pragma unroll
        for (int b = 0; b < 2; ++b)
#pragma unroll
            for (int m = 0; m < 4; ++m)
#pragma unroll
                for (int n = 0; n < 2; ++n) acc[a][b][m][n] = (f32x4){0.f, 0.f, 0.f, 0.f};
    bf16x8 At[4][2], B0[2][2], B1[2][2];
    const char* cA = (const char*)g.A + (size_t)cur.pm * tstep; const char* cB = (const char*)g.Bt + (size_t)cur.pn * tstep;
    S.a_ready(cur);
    if constexpr (SP2) {
        PG8_STAGE(PG8_SB(0, 0), cB, voffB); PG8_STAGE(PG8_SB(0, 1), cB + hstep, voffB); PG8_STAGE(PG8_SA(0, 0), cA, voffA); PG8_STAGE(PG8_SA(0, 1), cA + hstep, voffA);
        if (wr == 1) PG8_BAR;
        PG8_WAIT_V(2); PG8_BAR;
        PG8_STAGE(PG8_SB(1, 0), cB + kstep, voffB); PG8_STAGE(PG8_SA(1, 0), cA + kstep, voffA); PG8_STAGE(PG8_SB(1, 1), cB + hstep + kstep, voffB);
        PG8_WAIT_V(6); PG8_BAR;
    } else {
        PG8_STAGE(PG8_SB(0, 0), cB, voffB); PG8_STAGE(PG8_SA(0, 0), cA, voffA); PG8_STAGE(PG8_SB(0, 1), cB + hstep, voffB); PG8_STAGE(PG8_SA(0, 1), cA + hstep, voffA);
        if (wr == 1) PG8_BAR;
        PG8_WAIT_V(4); PG8_BAR;
        PG8_STAGE(PG8_SB(1, 0), cB + kstep, voffB); PG8_STAGE(PG8_SA(1, 0), cA + kstep, voffA); PG8_STAGE(PG8_SB(1, 1), cB + hstep + kstep, voffB);
        PG8_WAIT_V(6); PG8_BAR;
    }
    for (;;) {
        const bool has_next = S.next(ui + 1, nxt);
        const char* nA = has_next ? (const char*)g.A + (size_t)nxt.pm * tstep : cA; const char* nB = has_next ? (const char*)g.Bt + (size_t)nxt.pn * tstep : cB;
        for (int t = 0; t < nt; t += 2) {
            const bool last = (t == nt - 2);
            const char* a1 = cA + (size_t)(t + 1) * kstep;
            const char* a2 = last ? nA : cA + (size_t)(t + 2) * kstep; const char* b2 = last ? nB : cB + (size_t)(t + 2) * kstep;
            const char* a3 = a2 + kstep; const char* b3 = b2 + kstep;
            if (last && has_next) S.a_ready(nxt);
            if constexpr (SP2) {
            PG8_LDB(B0, 0, 0); PG8_LDB(B1, 0, 1); PG8_SCHED; PG8_LDA(At, 0, 0); PG8_STAGE(PG8_SA(1, 1), a1 + hstep, voffA);
            PG8_WAIT_V(8); PG8_WAIT_L(0); PG8_BAR; PG8_MMA(0, 0, At, B0); PG8_MMA(0, 1, At, B1); PG8_BAR; PG8_SCHED;
            PG8_LDA(At, 0, 1); PG8_STAGE(PG8_SB(0, 0), b2, voffB); PG8_STAGE(PG8_SB(0, 1), b2 + hstep, voffB); PG8_STAGE(PG8_SA(0, 0), a2, voffA);
            PG8_WAIT_V(8); PG8_WAIT_L(0); PG8_BAR; PG8_MMA(1, 0, At, B0); PG8_MMA(1, 1, At, B1); PG8_BAR; PG8_SCHED;
            PG8_LDB(B0, 1, 0); PG8_LDB(B1, 1, 1); PG8_SCHED; PG8_LDA(At, 1, 0); PG8_STAGE(PG8_SA(0, 1), a2 + hstep, voffA);
            PG8_WAIT_V(8); PG8_WAIT_L(0); PG8_BAR; PG8_MMA(0, 0, At, B0); PG8_MMA(0, 1, At, B1); PG8_BAR; PG8_SCHED;
            PG8_LDA(At, 1, 1); PG8_STAGE(PG8_SB(1, 0), b3, voffB); PG8_STAGE(PG8_SB(1, 1), b3 + hstep, voffB); PG8_STAGE(PG8_SA(1, 0), a3, voffA);
            PG8_WAIT_V(8); PG8_WAIT_L(0); PG8_BAR; PG8_MMA(1, 0, At, B0); PG8_MMA(1, 1, At, B1); PG8_BAR; PG8_SCHED;
            } else {
            PG8_LDB(B0, 0, 0); PG8_SCHED; PG8_LDA(At, 0, 0); PG8_STAGE(PG8_SA(1, 1), a1 + hstep, voffA);
            PG8_WAIT_L(8); PG8_BAR; PG8_WAIT_L(0); PG8_MMA(0, 0, At, B0); PG8_BAR; PG8_SCHED;
            PG8_LDB(B1, 0, 1); PG8_STAGE(PG8_SB(0, 0), b2, voffB);
            PG8_BAR; PG8_WAIT_L(0); PG8_MMA(0, 1, At, B1); PG8_BAR;
            PG8_LDA(At, 0, 1); PG8_STAGE(PG8_SA(0, 0), a2, voffA);
            PG8_BAR; PG8_WAIT_L(0); PG8_MMA(1, 0, At, B0); PG8_BAR; PG8_SCHED;
            PG8_STAGE(PG8_SB(0, 1), b2 + hstep, voffB);
            PG8_WAIT_V(6); PG8_BAR; PG8_MMA(1, 1, At, B1); PG8_BAR;
            PG8_LDB(B0, 1, 0); PG8_SCHED; PG8_LDA(At, 1, 0); PG8_STAGE(PG8_SA(0, 1), a2 + hstep, voffA);
            PG8_WAIT_L(8); PG8_BAR; PG8_WAIT_L(0); PG8_MMA(0, 0, At, B0); PG8_BAR; PG8_SCHED;
            PG8_LDB(B1, 1, 1); PG8_STAGE(PG8_SB(1, 0), b3, voffB);
            PG8_BAR; PG8_WAIT_L(0); PG8_MMA(0, 1, At, B1); PG8_BAR;
            PG8_LDA(At, 1, 1); PG8_STAGE(PG8_SA(1, 0), a3, voffA);
            PG8_BAR; PG8_WAIT_L(0); PG8_MMA(1, 0, At, B0); PG8_BAR; PG8_SCHED;
            PG8_STAGE(PG8_SB(1, 1), b3 + hstep, voffB);
            PG8_WAIT_V(6); PG8_BAR; PG8_MMA(1, 1, At, B1); PG8_BAR;
            }
        }
        if constexpr (ALIGN_EPI) { if (wr == 0) PG8_BAR; }
        if constexpr (!Epi::AFTER_DRAIN) { E(acc, cur, wr, wc, fr, fq); S.done(cur); }
        if (!has_next) break;
#pragma unroll
        for (int a = 0; a < 2; ++a)
#pragma unroll
            for (int b = 0; b < 2; ++b)
#pragma unroll
                for (int m = 0; m < 4; ++m)
#pragma unroll
                    for (int n = 0; n < 2; ++n) acc[a][b][m][n] = (f32x4){0.f, 0.f, 0.f, 0.f};
        cur = nxt; cA = nA; cB = nB; ++ui;
        if constexpr (ALIGN_EPI) { if (wr == 1) PG8_BAR; }
    }
    PG8_WAIT_V(0);
    if constexpr (!ALIGN_EPI) { if (wr == 0) PG8_BAR; }
    PG8_BAR;
#undef PG8_SA
#undef PG8_SB
#undef PG8_STAGE
#undef PG8_LDA
#undef PG8_LDB
#undef PG8_MMA
#undef PG8_WAIT_V
#undef PG8_WAIT_L
#undef PG8_BAR
#undef PG8_SCHED
}
}

constexpr int NWAVES = 8, NT = 512;
constexpr int DM = 1024, M_CTX = 4096, M_LAT = 8192, MTOK = 12288, DEPTH = 2;
constexpr int ZP = 2816, FF = 2816, NGU = 5632, IN_COLS = 2736;
constexpr int Z_AQ = 0, Z_AK = 256, Z_AV = 384, Z_BQ = 512, Z_BK = 768, Z_BV = 1024, Z_CQKV = 1280, Z_CG = 2048, Z_CA = 2304, Z_CB = 2312, Z_DCQ = 2320, Z_DCKV = 2576, Z_DKR = 2704;
constexpr int NCACHE = 4096;
constexpr int KVROWS = MTOK + NCACHE;
constexpr float LOG2E = 1.4426950408889634f;
constexpr float MLA_SCALE = 0.10206207261596577f;
enum { I_XP = 0, I_XS, I_CGK, I_CGV, I_CNK, I_CNV, I_SDN, I_CCKV, I_CKR, I_C, I_CCTX, I_N1G, I_N2G, I_WMOD, I_BMOD, I_WIN, I_WOUT, I_QNG, I_KNG, I_NAB,
       I_CONV, I_ALOG, I_DTB, I_DNOG, I_MQNG, I_WQUP, I_MKVNG, I_WKVUP, I_WG, I_WU, I_WD, I_FG, N_IN };
constexpr size_t O_YP = 0, O_YS = 4194304, O_GK = 12582912, O_GV = 13631488, O_NK = 14680064, O_NV = 16777216, O_DS = 18874368, O_CKV = 19922944, O_KR = 20971520, O_END = 21233664;

constexpr size_t MiB = 1u << 20;
constexpr size_t WS_CTL = 0, CTL_ZERO_BYTES = 1 * MiB;
constexpr size_t WS_MODS = 1 * MiB;
constexpr size_t WS_ROPE = 1 * MiB + 512 * 1024;
constexpr size_t WS_W = 2 * MiB;
constexpr size_t W_IN = 0, W_OUT = W_IN + (size_t)ZP * 1024 * 2, W_GU = W_OUT + (size_t)1024 * 1024 * 2, W_D = W_GU + (size_t)NGU * 1024 * 2,
                 W_Q = W_D + (size_t)1024 * FF * 2, W_KV = W_Q + (size_t)512 * 256 * 2, W_LEND = W_KV + (size_t)512 * 256 * 2;
static_assert(W_LEND <= 25 * MiB, "weights per layer");
constexpr size_t WS_XN = 27 * MiB;
constexpr size_t WS_UT = 27 * MiB, WS_WN = 39 * MiB;
constexpr size_t WS_Z = 51 * MiB;
constexpr size_t WS_O = 117 * MiB;
constexpr size_t WS_QA = 141 * MiB, WS_KA = 147 * MiB, WS_VA = 151 * MiB;
constexpr size_t WS_DQ = 155 * MiB, WS_DK = 161 * MiB, WS_DV = 167 * MiB;
constexpr size_t WS_BG = 173 * MiB;
constexpr size_t WS_QN = 174 * MiB;
constexpr size_t WS_CKV = 180 * MiB;
constexpr size_t WS_KR = 188 * MiB;
constexpr size_t WS_QM = 189 * MiB;
constexpr size_t WS_KV = 201 * MiB;
constexpr size_t WS_NKB = 217 * MiB, WS_NVB = 219 * MiB;
constexpr size_t WS_ODN = 221 * MiB;
constexpr size_t WS_QKG = 233 * MiB;
constexpr size_t WS_KT = 245 * MiB;
constexpr size_t WS_GC = 251 * MiB;
constexpr size_t WS_END = 252 * MiB;
constexpr int CW_BAR = 4096;

constexpr int RING_BYTES = 131072, LDSCTL_OFF = RING_BYTES, MISC_OFF = LDSCTL_OFF + 320, LDS_BYTES = 147456;

#define GAS __attribute__((address_space(1)))
#define LAS __attribute__((address_space(3)))
typedef unsigned short bf16;
typedef unsigned v4u __attribute__((ext_vector_type(4)));
typedef unsigned v2u __attribute__((ext_vector_type(2)));
typedef float f32x4 __attribute__((ext_vector_type(4)));
__device__ __forceinline__ unsigned f2bf(float f) { unsigned u = __builtin_bit_cast(unsigned, f); return (u + 0x7fffu + ((u >> 16) & 1u)) >> 16; }
__device__ __forceinline__ unsigned pk2(float lo, float hi) { return f2bf(lo) | (f2bf(hi) << 16); }
__device__ __forceinline__ float bf2f(bf16 h) { return __uint_as_float((unsigned)h << 16); }
__device__ __forceinline__ float bflo(unsigned u) { return __uint_as_float(u << 16); }
__device__ __forceinline__ float bfhi(unsigned u) { return __uint_as_float(u & 0xffff0000u); }
#define LDS_WAIT() asm volatile("s_waitcnt lgkmcnt(0)" ::: "memory")

#define XB_TMO      128
#define XB_XCNT(j)  (256  + 64 * (j))
#define XB_XSUB(j)  (1280 + 64 * (j))
#define XB_XGEN(j)  (2304 + 64 * (j))
#define XB_TOP      3328
#define XB_TOPGEN   3392
#define XCD_BAR_WORDS 3456
#define XB_SPIN_CAP (1u << 18)
__device__ __forceinline__ unsigned xb_ld(unsigned* p)              { return __hip_atomic_load(p, __ATOMIC_RELAXED, __HIP_MEMORY_SCOPE_AGENT); }
__device__ __forceinline__ unsigned xb_add(unsigned* p, unsigned v) { return __hip_atomic_fetch_add(p, v, __ATOMIC_RELAXED, __HIP_MEMORY_SCOPE_AGENT); }
__device__ __forceinline__ unsigned xb_xcc_id() { return (unsigned)__builtin_amdgcn_s_getreg((3 << 11) | 20) & 0xFu; }
#define XB_SPIN(cond, bar) do { unsigned _sp = 0; while (cond) { __builtin_amdgcn_s_sleep(1); \
    if ((++_sp & 255u) == 0u) { if (xb_ld(&(bar)[XB_TMO])) break; if (_sp > XB_SPIN_CAP) { atomicAdd(&(bar)[XB_TMO], 1u); break; } } } } while (0)
struct XcdBarrier { unsigned* bar; unsigned x; volatile LAS unsigned* st; };
__device__ __forceinline__ XcdBarrier xcd_barrier_post(unsigned* bar, volatile LAS unsigned* st) {
    XcdBarrier b; b.bar = bar; b.x = xb_xcc_id(); b.st = st;
    if (threadIdx.x == 0) (void)xb_add(&bar[XB_XCNT(b.x)], 1u);
    return b;
}
__device__ __forceinline__ void xcd_barrier_complete(unsigned* bar, unsigned x, unsigned& nloc, unsigned& nx) {
    const unsigned G = gridDim.x * gridDim.y * gridDim.z;
    unsigned sum, cnt, mine, sp = 0u;
    for (;;) {
        sum = 0u; cnt = 0u; mine = 0u;
#pragma unroll
        for (unsigned j = 0; j < 16; ++j) { const unsigned c = xb_ld(&bar[XB_XCNT(j)]); sum += c; cnt += (c > 0u) ? 1u : 0u; mine = (j == x) ? c : mine; }
        if (sum == G) break;
        __builtin_amdgcn_s_sleep(1);
        if ((++sp & 255u) == 0u) { if (xb_ld(&bar[XB_TMO])) break; if (sp > XB_SPIN_CAP) { atomicAdd(&bar[XB_TMO], 1u); break; } }
    }
    nloc = mine > 0u ? mine : 1u; nx = cnt > 0u ? cnt : 1u;
}
__device__ __forceinline__ void xcd_barrier(const XcdBarrier& b) {
    asm volatile("s_waitcnt vmcnt(0)" ::: "memory");
    __syncthreads();
    if (threadIdx.x == 0) {
        unsigned* bar = b.bar;
        __builtin_amdgcn_s_waitcnt(0);
        unsigned nloc = b.st[0], nx = b.st[1];
        if (nloc == 0u) { xcd_barrier_complete(bar, b.x, nloc, nx); b.st[0] = nloc; b.st[1] = nx; }
        const unsigned old = xb_add(&bar[XB_XSUB(b.x)], 1u);
        const unsigned gen = old / nloc;
        if (old + 1u == (gen + 1u) * nloc) {
            __builtin_amdgcn_fence(__ATOMIC_RELEASE, "agent");
            asm volatile("s_waitcnt vmcnt(0)" ::: "memory");
            const unsigned og = xb_add(&bar[XB_TOP], 1u);
            const unsigned tg = og / nx;
            if (og + 1u == (tg + 1u) * nx) xb_add(&bar[XB_TOPGEN], 1u);
            else XB_SPIN(xb_ld(&bar[XB_TOPGEN]) == tg, bar);
            __builtin_amdgcn_fence(__ATOMIC_ACQUIRE, "agent");
            xb_add(&bar[XB_XGEN(b.x)], 1u);
            asm volatile("s_waitcnt vmcnt(0)" ::: "memory");
        } else {
            XB_SPIN(xb_ld(&bar[XB_XGEN(b.x)]) == gen, bar);
            __builtin_amdgcn_fence(__ATOMIC_ACQUIRE, "agent");
            asm volatile("s_waitcnt vmcnt(0)" ::: "memory");
        }
    }
    __syncthreads();
}

struct Args { const float* in[N_IN]; float* out; unsigned char* ws; int ph_lo, ph_hi; };
struct Frame {
    LAS unsigned char* lds;
    int tid, lane, wave, G, bid;
    const float* const* in; float* out; unsigned char* ws;
};
__device__ __forceinline__ float wave_sum(float v) {
#pragma unroll
    for (int o = 1; o < 64; o <<= 1) v += __shfl_xor(v, o);
    return v;
}
__device__ __forceinline__ float silu_f(float x) { return x / (1.0f + __expf(-x)); }

__device__ __forceinline__ void p0_transpose_item(const float* W, int K, int Nsrc, int Npad, int KP, bf16* WT, int row_off, int rmul, LAS float* scr, int item, int lane) {
    const int nblk = Npad / 32, kb = item / nblk, nb = item % nblk, k0 = 64 * kb, n0 = 32 * nb;
    const int nn = n0 + (lane & 31);
#pragma unroll 8
    for (int i = 0; i < 32; ++i) { const int kk = 2 * i + (lane >> 5); scr[kk * 33 + (lane & 31)] = (nn < Nsrc && (k0 + kk) < K) ? W[(size_t)(k0 + kk) * Nsrc + nn] : 0.f; }
    LDS_WAIT(); asm volatile("" ::: "memory");
    const int c = lane & 7;
#pragma unroll
    for (int j = 0; j < 4; ++j) { const int n = (lane >> 3) + 8 * j; const LAS float* s = scr + (8 * c) * 33 + n;
        v4u o; o.x = pk2(s[0 * 33], s[1 * 33]); o.y = pk2(s[2 * 33], s[3 * 33]); o.z = pk2(s[4 * 33], s[5 * 33]); o.w = pk2(s[6 * 33], s[7 * 33]);
        *(v4u*)(WT + (size_t)(row_off + rmul * (n0 + n)) * KP + k0 + 8 * c) = o; }
    LDS_WAIT(); asm volatile("" ::: "memory");
}
__device__ __forceinline__ void p0a(Frame& F) {
    {
        LAS float* sc = (LAS float*)(F.lds);
        LAS float* part = (LAS float*)(F.lds + 9 * 1024 * 4);
        for (int e = F.tid; e < 9 * 1024; e += NT) { const int r = e >> 10, k = e & 1023; const float c = (r == 0) ? F.in[I_CCTX][k] : F.in[I_C][(r - 1) * 1024 + k]; sc[e] = silu_f(c); }
        __syncthreads();
        for (int it = F.bid; it < 2 * 96; it += F.G) {
            const int l = it / 96, n0 = (it % 96) * 64;
            const float* w = F.in[I_WMOD] + (size_t)l * 1024 * 6144 + n0 + F.lane;
            float acc[9];
#pragma unroll
            for (int r = 0; r < 9; ++r) acc[r] = 0.f;
            const int kb = F.wave * 128;
#pragma unroll 8
            for (int k = 0; k < 128; ++k) { const float wv = w[(size_t)(kb + k) * 6144];
#pragma unroll
                for (int r = 0; r < 9; ++r) acc[r] += sc[r * 1024 + kb + k] * wv; }
#pragma unroll
            for (int r = 0; r < 9; ++r) part[(F.wave * 9 + r) * 64 + F.lane] = acc[r];
            __syncthreads();
            for (int e = F.tid; e < 9 * 64; e += NT) { const int r = e >> 6, c = e & 63; float s = 0.f;
#pragma unroll
                for (int w8 = 0; w8 < 8; ++w8) s += part[(w8 * 9 + r) * 64 + c];
                ((float*)(F.ws + WS_MODS))[(size_t)(l * 9 + r) * 6144 + n0 + c] = s + F.in[I_BMOD][l * 6144 + n0 + c]; }
            __syncthreads();
        }
    }
    if (F.bid == F.G - 1) {
        float* tab = (float*)(F.ws + WS_ROPE);
        for (int e = F.tid; e < 64 * 16 + 64 * 8; e += NT) {
            int pos, i, half; float* dst;
            if (e < 1024) { pos = e >> 4; i = e & 15; half = 16; dst = tab + 2 * e; } else { const int e2 = e - 1024; pos = e2 >> 3; i = e2 & 7; half = 8; dst = tab + 2048 + 2 * e2; }
            const float inv = exp2f(-(float)i / (float)half * 13.287712379549449f);
            const float ang = (float)pos * inv;
            const double twopi = 6.283185307179586476925; const double a = (double)ang; const double kq = __builtin_rint(a / twopi); const float rr = (float)(a - kq * twopi);
            dst[0] = __builtin_cosf(rr); dst[1] = __builtin_sinf(rr);
        }
    }
    __syncthreads();
}
constexpr int CW_ALL = 6272;
__device__ __forceinline__ void convert_weights(Frame& F, int l, int lo, int hi, int gw, int NGW) {
    LAS float* scr = (LAS float*)(F.lds + F.wave * 16384);
    constexpr int I_IN = 16 * 88, I_OUT = 16 * 32, I_G = 16 * 88, I_U = 16 * 88, I_D = 44 * 32, I_Q = 4 * 16, I_KV = 4 * 16;
    static_assert(I_IN + I_OUT + I_G + I_U + I_D + I_Q + I_KV == CW_ALL, "weight conversion items");
    unsigned char* wl = F.ws + WS_W;
    for (int it = lo + gw; it < hi; it += NGW) {
        int r = it;
        if (r < I_IN) { p0_transpose_item(F.in[I_WIN] + (size_t)l * 1024 * IN_COLS, 1024, IN_COLS, ZP, 1024, (bf16*)(wl + W_IN), 0, 1, scr, r, F.lane); continue; } r -= I_IN;
        if (r < I_OUT) { p0_transpose_item(F.in[I_WOUT] + (size_t)l * 1024 * 1024, 1024, 1024, 1024, 1024, (bf16*)(wl + W_OUT), 0, 1, scr, r, F.lane); continue; } r -= I_OUT;
        if (r < I_G) { p0_transpose_item(F.in[I_WG] + (size_t)l * 1024 * FF, 1024, FF, FF, 1024, (bf16*)(wl + W_GU), 0, 2, scr, r, F.lane); continue; } r -= I_G;
        if (r < I_U) { p0_transpose_item(F.in[I_WU] + (size_t)l * 1024 * FF, 1024, FF, FF, 1024, (bf16*)(wl + W_GU), 1, 2, scr, r, F.lane); continue; } r -= I_U;
        if (r < I_D) { p0_transpose_item(F.in[I_WD] + (size_t)l * FF * 1024, FF, 1024, 1024, FF, (bf16*)(wl + W_D), 0, 1, scr, r, F.lane); continue; } r -= I_D;
        if (r < I_Q) { p0_transpose_item(F.in[I_WQUP] + (size_t)l * 256 * 384, 256, 384, 512, 256, (bf16*)(wl + W_Q), 0, 1, scr, r, F.lane); continue; } r -= I_Q;
        p0_transpose_item(F.in[I_WKVUP] + (size_t)l * 128 * 512, 128, 512, 512, 256, (bf16*)(wl + W_KV), 0, 1, scr, r, F.lane);
    }
}

__device__ __forceinline__ const float* xrow_ptr(Frame& F, int m, bool from_in) {
    if (from_in) return m < M_CTX ? F.in[I_XP] + (size_t)m * DM : F.in[I_XS] + (size_t)(m - M_CTX) * DM;
    return F.out + (size_t)m * DM;
}
template <int MODE> __device__ __forceinline__ void norm_rows(Frame& F, bool from_in, const float* g, const float* mods_l  , int sh_off, int sc_off) {
    const int gw = F.bid * NWAVES + F.wave, NGW = F.G * NWAVES;
    for (int m = gw; m < MTOK; m += NGW) {
        const f32x4* xr = (const f32x4*)xrow_ptr(F, m, from_in) + F.lane;
        f32x4 v[4]; float s = 0.f;
#pragma unroll
        for (int j = 0; j < 4; ++j) { v[j] = xr[64 * j]; s += (v[j].x * v[j].x + v[j].y * v[j].y) + (v[j].z * v[j].z + v[j].w * v[j].w); }
        const float rstd = 1.0f / sqrtf(wave_sum(s) * (1.f / DM) + 1e-6f);
        if (MODE == 0) {
            const int rmod = m < M_CTX ? 0 : 1 + ((m - M_CTX) >> 10);
            const float* mr = mods_l + (size_t)rmod * 6144;
            unsigned long long* o8 = (unsigned long long*)((bf16*)(F.ws + WS_XN) + (size_t)m * DM) + F.lane;
#pragma unroll
            for (int j = 0; j < 4; ++j) { const int c = 4 * F.lane + 256 * j; const f32x4 gg = *(const f32x4*)(g + c), sh = *(const f32x4*)(mr + sh_off + c), sc = *(const f32x4*)(mr + sc_off + c);
                const f32x4 y = (v[j] * rstd * gg) * (sc + 1.0f) + sh;
                o8[64 * j] = (unsigned long long)pk2(y.x, y.y) | ((unsigned long long)pk2(y.z, y.w) << 32); }
        } else {
            f32x4* yo = (f32x4*)(F.out + (size_t)m * DM) + F.lane;
#pragma unroll
            for (int j = 0; j < 4; ++j) { const int c = 4 * F.lane + 256 * j; const f32x4 gg = *(const f32x4*)(g + c); yo[64 * j] = v[j] * rstd * gg; }
        }
    }
}

typedef float f32x2_t __attribute__((ext_vector_type(2))); typedef __bf16 bf16x2_t __attribute__((ext_vector_type(2)));
__device__ __forceinline__ unsigned cvtpk(float lo, float hi) { f32x2_t v = {lo, hi}; bf16x2_t b = __builtin_convertvector(v, bf16x2_t); return __builtin_bit_cast(unsigned, b); }
struct F8 { float v[8]; };
__device__ __forceinline__ F8 bf8f(const v4u w) { F8 r; r.v[0] = bflo(w.x); r.v[1] = bfhi(w.x); r.v[2] = bflo(w.y); r.v[3] = bfhi(w.y); r.v[4] = bflo(w.z); r.v[5] = bfhi(w.z); r.v[6] = bflo(w.w); r.v[7] = bfhi(w.w); return r; }
__device__ __forceinline__ v4u fbf8(const F8& x) { v4u w; w.x = cvtpk(x.v[0], x.v[1]); w.y = cvtpk(x.v[2], x.v[3]); w.z = cvtpk(x.v[4], x.v[5]); w.w = cvtpk(x.v[6], x.v[7]); return w; }
__device__ __forceinline__ F8 ldf8(const float* p) { const f32x4 a = *(const f32x4*)p, b = *(const f32x4*)(p + 4); F8 r; r.v[0] = a.x; r.v[1] = a.y; r.v[2] = a.z; r.v[3] = a.w; r.v[4] = b.x; r.v[5] = b.y; r.v[6] = b.z; r.v[7] = b.w; return r; }
__device__ __forceinline__ void stf8(float* p, const F8& x) { *(f32x4*)p = (f32x4){x.v[0], x.v[1], x.v[2], x.v[3]}; *(f32x4*)(p + 4) = (f32x4){x.v[4], x.v[5], x.v[6], x.v[7]}; }
template <int K> __device__ __forceinline__ float shx(float v) { return __int_as_float(__builtin_amdgcn_ds_swizzle(__float_as_int(v), (K << 10) | 0x1f)); }
__device__ __forceinline__ float ssq8(const F8& x) { return (x.v[0] * x.v[0] + x.v[1] * x.v[1]) + (x.v[2] * x.v[2] + x.v[3] * x.v[3]) + (x.v[4] * x.v[4] + x.v[5] * x.v[5]) + (x.v[6] * x.v[6] + x.v[7] * x.v[7]); }
__device__ __forceinline__ float red8(float s) { s += shx<1>(s); s += shx<2>(s); s += shx<4>(s); return s; }
__device__ __forceinline__ void prep_phase(Frame& F, int l) {
    const int gw = F.bid * NWAVES + F.wave, NGW = F.G * NWAVES, lane = F.lane;
    const bf16* Z = (const bf16*)(F.ws + WS_Z);
    bf16* QA = (bf16*)(F.ws + WS_QA); bf16* KA = (bf16*)(F.ws + WS_KA); bf16* VA = (bf16*)(F.ws + WS_VA);
    bf16* DQ = (bf16*)(F.ws + WS_DQ); bf16* DK = (bf16*)(F.ws + WS_DK); bf16* DV = (bf16*)(F.ws + WS_DV);
    float* BG = (float*)(F.ws + WS_BG);
    bf16* QN = (bf16*)(F.ws + WS_QN); bf16* CKV = (bf16*)(F.ws + WS_CKV); bf16* KR = (bf16*)(F.ws + WS_KR);
    const float* tabA = (const float*)(F.ws + WS_ROPE); const float* tabM = tabA + 2048;
    const int j8 = lane & 7;
    for (int it = gw; it < MTOK + NCACHE; it += NGW) {
        if (it >= MTOK) {
            const int cr = it - MTOK, b = cr >> 9, j = cr & 511; const size_t src = (size_t)((b * 2 + l) * 512 + j);
            const int krow = M_CTX + b * 1536 + j;
            { const float* g = (lane < 32 ? F.in[I_CGK] : F.in[I_CGV]) + src * 128 + (lane & 31) * 4; const f32x4 v = *(const f32x4*)g;
              v2u w; w.x = cvtpk(v.x, v.y); w.y = cvtpk(v.z, v.w); *(v2u*)((lane < 32 ? KA : VA) + (size_t)krow * 128 + (lane & 31) * 4) = w; }
            if (lane < 40) { const float* g = lane < 32 ? F.in[I_CCKV] + src * 128 + lane * 4 : F.in[I_CKR] + src * 32 + (lane - 32) * 4; const f32x4 v = *(const f32x4*)g;
              v2u w; w.x = cvtpk(v.x, v.y); w.y = cvtpk(v.z, v.w); *(v2u*)(lane < 32 ? CKV + (size_t)it * 256 + lane * 4 : KR + (size_t)it * 32 + (lane - 32) * 4) = w; }
            else if (lane >= 48) *(v4u*)(CKV + (size_t)it * 256 + 128 + (lane - 48) * 8) = (v4u){0u, 0u, 0u, 0u};
            { const f32x4 a = *(const f32x4*)(F.in[I_CNK] + src * 256 + lane * 4), c = *(const f32x4*)(F.in[I_CNV] + src * 256 + lane * 4);
              v2u w; w.x = cvtpk(a.x, a.y); w.y = cvtpk(a.z, a.w); *(v2u*)((bf16*)(F.ws + WS_NKB) + (size_t)cr * 256 + lane * 4) = w;
              v2u u; u.x = cvtpk(c.x, c.y); u.y = cvtpk(c.z, c.w); *(v2u*)((bf16*)(F.ws + WS_NVB) + (size_t)cr * 256 + lane * 4) = u; }
            continue;
        }
        const int m = it; const bool lat = m >= M_CTX;
        const int b = lat ? (m - M_CTX) >> 10 : m >> 8, t = lat ? (m - M_CTX) & 1023 : m & 255, L = lat ? 1024 : 256;
        const int pr = t >> 6, pc = t & 63;
        const bf16* zr = Z + (size_t)m * ZP;
        const size_t orow = (size_t)((b * 2 + l) * 256 + t);
        const int krow = lat ? M_CTX + b * 1536 + 512 + t : m;
        {
            const v4u raw = *(const v4u*)(zr + 8 * lane); F8 x = bf8f(raw);
            const float ss = red8(ssq8(x)); const float rstd = 1.0f / sqrtf(ss * (1.f / 64.f) + 1e-6f);
            if (lane < 48) {
                const F8 g = ldf8((lane < 32 ? F.in[I_QNG] : F.in[I_KNG]) + l * 64 + 8 * j8);
#pragma unroll
                for (int e = 0; e < 8; ++e) x.v[e] = x.v[e] * rstd * g.v[e];
                if (!lat && lane >= 32) stf8(F.out + O_GK + orow * 128 + (lane - 32) * 8, x);
            } else if (!lat) stf8(F.out + O_GV + orow * 128 + (lane - 48) * 8, x);
            if (lat) {
                const int pos = (j8 < 4) ? pr : pc; const float* cs = tabA + (pos * 16 + 8 * (j8 & 1)) * 2; const bool second = (j8 & 2) != 0;
                const F8 c0 = ldf8(cs), c1 = ldf8(cs + 8);
#pragma unroll
                for (int e = 0; e < 8; ++e) { const float yp = shx<2>(x.v[e]); const float c = (e < 4 ? c0 : c1).v[2 * (e & 3)], sn = (e < 4 ? c0 : c1).v[2 * (e & 3) + 1];
                    const float r = second ? x.v[e] * c + yp * sn : x.v[e] * c - yp * sn; if (lane < 48) x.v[e] = r; }
            }
            if (lane < 32) *(v4u*)(QA + (size_t)m * 256 + 8 * lane) = fbf8(x);
            else if (lane < 48) *(v4u*)(KA + (size_t)krow * 128 + 8 * (lane - 32)) = fbf8(x);
            else *(v4u*)(VA + (size_t)krow * 128 + 8 * (lane - 48)) = raw;
        }
        if (!lat) { const F8 x = bf8f(*(const v4u*)(zr + Z_BK + 8 * lane)); stf8(F.out + (lane < 32 ? O_NK : O_NV) + orow * 256 + (lane & 31) * 8, x); }
#pragma unroll
        for (int pass = 0; pass < 2; ++pass) {
            if (pass == 0 || lane < 32) {
                const int lc = pass * 64 + lane, ch = 8 * lc; F8 acc;
#pragma unroll
                for (int e = 0; e < 8; ++e) acc.v[e] = 0.f;
#pragma unroll
                for (int j = 0; j < 4; ++j) { const int tt = t + j - 1;
                    if (tt >= 0 && tt < L) { const F8 w = ldf8(F.in[I_CONV] + (size_t)(l * 4 + j) * 768 + ch); const F8 xz = bf8f(*(const v4u*)(zr + (ptrdiff_t)(j - 1) * ZP + Z_CQKV + ch));
#pragma unroll
                        for (int e = 0; e < 8; ++e) acc.v[e] += w.v[e] * xz.v[e]; } }
#pragma unroll
                for (int e = 0; e < 8; ++e) acc.v[e] = silu_f(acc.v[e]);
                if (pass == 0) { const float ss = red8(ssq8(acc)); const float sc = (1.0f / sqrtf(ss + 1e-6f)) * (lane < 32 ? 0.125f : 1.0f);
#pragma unroll
                    for (int e = 0; e < 8; ++e) acc.v[e] *= sc;
                    *(v4u*)((lane < 32 ? DQ : DK) + (size_t)m * 256 + 8 * (lane & 31)) = fbf8(acc);
                } else *(v4u*)(DV + (size_t)m * 256 + 8 * lane) = fbf8(acc);
            }
        }
        if (lane < 8) {
            const float a = bf2f(zr[Z_CA + lane]), bb = bf2f(zr[Z_CB + lane]);
            const float beta = 1.0f / (1.0f + __expf(-bb));
            const float xx = a + F.in[I_DTB][l * 8 + lane];
            const float sp = fmaxf(xx, 0.f) + log1pf(__expf(-fabsf(xx)));
            BG[(size_t)m * 16 + lane] = beta; BG[(size_t)m * 16 + 8 + lane] = -__expf(F.in[I_ALOG][l * 8 + lane]) * sp;
        }
        {
            F8 x = bf8f(*(const v4u*)(zr + Z_DCQ + 8 * (lane < 52 ? lane : 51)));
            float s4 = red8(ssq8(x)); s4 += shx<8>(s4);
            const float s5 = s4 + shx<16>(s4);
            if (lane < 32) { const float rstd = 1.0f / sqrtf(s5 * (1.f / 256.f) + 1e-6f); const F8 g = ldf8(F.in[I_MQNG] + l * 256 + 8 * lane);
#pragma unroll
                for (int e = 0; e < 8; ++e) x.v[e] = x.v[e] * rstd * g.v[e];
                *(v4u*)(QN + (size_t)m * 256 + 8 * lane) = fbf8(x);
            } else if (lane < 48) { const float rstd = 1.0f / sqrtf(s4 * (1.f / 128.f) + 1e-6f); const F8 g = ldf8(F.in[I_MKVNG] + l * 128 + 8 * (lane - 32));
#pragma unroll
                for (int e = 0; e < 8; ++e) x.v[e] = x.v[e] * rstd * g.v[e];
                *(v4u*)(CKV + (size_t)m * 256 + 8 * (lane - 32)) = fbf8(x);
                if (!lat) stf8(F.out + O_CKV + orow * 128 + 8 * (lane - 32), x);
            }
            {
                const int q4 = lane & 3; const int pos = (q4 < 2) ? pr : pc; const float* cs = tabM + (pos * 8) * 2; const bool second = (q4 & 1) != 0;
                F8 r = x;
                if (lat) { const F8 c0 = ldf8(cs), c1 = ldf8(cs + 8);
#pragma unroll
                    for (int e = 0; e < 8; ++e) { const float yp = shx<1>(x.v[e]); const float c = (e < 4 ? c0 : c1).v[2 * (e & 3)], sn = (e < 4 ? c0 : c1).v[2 * (e & 3) + 1];
                        r.v[e] = second ? x.v[e] * c + yp * sn : x.v[e] * c - yp * sn; } }
                if (lane >= 48 && lane < 52) { *(v4u*)(KR + (size_t)m * 32 + 8 * (lane - 48)) = fbf8(r); if (!lat) stf8(F.out + O_KR + orow * 32 + 8 * (lane - 48), x); }
                if (lane >= 48) *(v4u*)(CKV + (size_t)m * 256 + 128 + 8 * (lane - 48)) = (v4u){0u, 0u, 0u, 0u};
            }
        }
    }
}

typedef short bf16x8 __attribute__((ext_vector_type(8)));
typedef float f32x16 __attribute__((ext_vector_type(16)));
struct AttDesc {
    const bf16* Q; int qs; int qrow0;
    const bf16 *K0, *K1, *R0, *R1, *V0, *V1; int ks0, ks1, rs0, rs1, vs0, vs1;
    int row00, row01, nt0, nt;
    bf16* O; float scale;
    int qpos0;
    int rlo; const float* nab;
};
constexpr int ATT_BUF = 26624, ATT_VOFF = 13312, ATT_VROWB = 192, ATT_NB = 2 * ATT_BUF;
typedef short v4i16_t __attribute__((ext_vector_type(4)));
__device__ __forceinline__ v2u lds_tr(const LAS unsigned char* p) { return __builtin_bit_cast(v2u, __builtin_amdgcn_ds_read_tr16_b64_v4i16((LAS v4i16_t*)p)); }
template <int DK, bool NA, bool QROPE>
__device__ __forceinline__ void attn_block(Frame& F, const AttDesc& D) {
    constexpr int KROWB = (DK + 8) * 2, NS = DK / 16;
    static_assert(64 * KROWB <= ATT_VOFF && ATT_VOFF + 64 * ATT_VROWB <= ATT_BUF, "attention LDS");
    constexpr float THR = 8.0f;
    const int tid = F.tid, lane = F.lane, w = F.wave, lq = lane & 31, hh = lane >> 5;
    LAS unsigned char* lds = F.lds;
    __syncthreads();
    if constexpr (NA) { for (int e = tid; e < 465; e += NT) ((LAS float*)(lds + ATT_NB))[e] = D.nab[e] * LOG2E; }
    const int qrow = D.qrow0 + 32 * w + lq;
    bf16x8 qf[NS];
#pragma unroll
    for (int s = 0; s < NS; ++s) qf[s] = *(const bf16x8*)(D.Q + (size_t)qrow * D.qs + 16 * s + 8 * hh);
    if constexpr (QROPE) {
        const float* tabM = (const float*)(F.ws + WS_ROPE) + 2048; const int n = D.qpos0 + 32 * w + lq;
#pragma unroll
        for (int sx = 4; sx < 6; ++sx) { const int pos = sx == 4 ? (n >> 6) : (n & 63); const v4u qw = __builtin_bit_cast(v4u, qf[sx]); float res[8];
#pragma unroll
            for (int j = 0; j < 8; ++j) { const unsigned dw = qw[j >> 1]; const float own = (j & 1) ? bfhi(dw) : bflo(dw); const float oth = __shfl_xor(own, 32);
                const float c = tabM[(pos * 8 + j) * 2], sn = tabM[(pos * 8 + j) * 2 + 1]; res[j] = hh ? own * c + oth * sn : own * c - oth * sn; }
            v4u nw; nw.x = cvtpk(res[0], res[1]); nw.y = cvtpk(res[2], res[3]); nw.z = cvtpk(res[4], res[5]); nw.w = cvtpk(res[6], res[7]); qf[sx] = __builtin_bit_cast(bf16x8, nw); }
    }
    const int na_r = (D.qpos0 >> 6) + (w >> 1), na_c = (w & 1) * 32 + lq, na_r0 = min(max(na_r - 4, 0), 8), na_c0 = min(max(na_c - 8, 0), 48);
    f32x16 o0, o1;
#pragma unroll
    for (int r = 0; r < 16; ++r) { o0[r] = 0.f; o1[r] = 0.f; }
    float m = -1e30f, lsum = 0.f;
    v4u kA, vA, rA = (v4u){0u, 0u, 0u, 0u}, kB, vB, rB = (v4u){0u, 0u, 0u, 0u};
#define ATT_LOAD(t_, kreg, vreg, rreg) do { const int t__ = (t_); if (t__ < D.nt) { const bool sg = t__ >= D.nt0; const int r0_ = sg ? D.row01 + 64 * (t__ - D.nt0) : D.row00 + 64 * t__; \
        const bf16* Kb = sg ? D.K1 : D.K0; const bf16* Vb = sg ? D.V1 : D.V0; const int ks_ = sg ? D.ks1 : D.ks0, vs_ = sg ? D.vs1 : D.vs0; \
        kreg = *(const v4u*)(Kb + (size_t)(r0_ + (tid >> 3)) * ks_ + (tid & 7) * 8); \
        vreg = *(const v4u*)(Vb + (size_t)(r0_ + (tid >> 3)) * vs_ + (tid & 7) * 8); \
        if constexpr (DK == 96) { if (tid < 256) { const bf16* Rb = sg ? D.R1 : D.R0; const int rs_ = sg ? D.rs1 : D.rs0; rreg = *(const v4u*)(Rb + (size_t)(r0_ + (tid >> 2)) * rs_ + (tid & 3) * 8); } } } } while (0)
#define ATT_PUT(buf_, kreg, vreg, rreg) do { LAS unsigned char* bb_ = lds + (buf_) * ATT_BUF; \
        *(LAS v4u*)(bb_ + (tid >> 3) * KROWB + (tid & 7) * 16) = kreg; *(LAS v4u*)(bb_ + ATT_VOFF + (tid >> 3) * ATT_VROWB + (tid & 7) * 16) = vreg; \
        if constexpr (DK == 96) { if (tid < 256) *(LAS v4u*)(bb_ + (tid >> 2) * KROWB + 128 + (tid & 3) * 16) = rreg; } } while (0)
    const int vtr_off = ATT_VOFF + (((lane & 15) >> 2) + 4 * hh) * ATT_VROWB + (16 * ((lane >> 4) & 1) + 4 * (lane & 3)) * 2;
    const int kfr_off = lq * KROWB + 16 * hh;
#define ATT_TILE(t_, buf_) do { const int tt_ = (t_); const LAS unsigned char* bb_ = lds + (buf_) * ATT_BUF; \
        bool rel = true; int kr = 0; bool local = false; \
        if constexpr (NA) { if (tt_ >= D.nt0) { local = true; kr = D.rlo + (tt_ - D.nt0); rel = (kr >= na_r0) && (kr < na_r0 + 8); } } \
        if (rel) { \
            f32x16 s0, s1; \
            _Pragma("unroll") for (int r = 0; r < 16; ++r) { s0[r] = 0.f; s1[r] = 0.f; } \
            _Pragma("unroll") for (int s = 0; s < NS; ++s) { \
                const bf16x8 a0 = *(const LAS bf16x8*)(bb_ + kfr_off + 32 * s); const bf16x8 a1 = *(const LAS bf16x8*)(bb_ + kfr_off + 32 * KROWB + 32 * s); \
                s0 = __builtin_amdgcn_mfma_f32_32x32x16_bf16(a0, qf[s], s0, 0, 0, 0); s1 = __builtin_amdgcn_mfma_f32_32x32x16_bf16(a1, qf[s], s1, 0, 0, 0); } \
            float tmax = -1e30f; \
            if (NA && local) { \
                const LAS float* nbp = (const LAS float*)(lds + ATT_NB) + (kr - na_r + 7) * 31 + 15 - na_c; \
                _Pragma("unroll") for (int r = 0; r < 16; ++r) { const int kc0 = (r & 3) + 8 * (r >> 2) + 4 * hh, kc1 = kc0 + 32; \
                    const bool al0 = (unsigned)(kc0 - na_c0) < 16u, al1 = (unsigned)(kc1 - na_c0) < 16u; \
                    const float b0 = nbp[al0 ? kc0 : na_c], b1 = nbp[al1 ? kc1 : na_c]; \
                    s0[r] = al0 ? s0[r] * D.scale + b0 : -1e30f; s1[r] = al1 ? s1[r] * D.scale + b1 : -1e30f; \
                    tmax = fmaxf(tmax, fmaxf(s0[r], s1[r])); } \
            } else { \
                _Pragma("unroll") for (int r = 0; r < 16; ++r) tmax = fmaxf(tmax, fmaxf(s0[r], s1[r])); \
                tmax *= D.scale; \
            } \
            tmax = fmaxf(tmax, __shfl_xor(tmax, 32)); \
            if (__any(tmax > m + THR)) { const float mn = fmaxf(m, tmax); const float corr = __builtin_amdgcn_exp2f(m - mn); m = mn; lsum *= corr; \
                _Pragma("unroll") for (int r = 0; r < 16; ++r) { o0[r] *= corr; o1[r] *= corr; } } \
            float ps = 0.f; \
            if (NA && local) { _Pragma("unroll") for (int r = 0; r < 16; ++r) { s0[r] = __builtin_amdgcn_exp2f(s0[r] - m); s1[r] = __builtin_amdgcn_exp2f(s1[r] - m); ps += s0[r] + s1[r]; } } \
            else { _Pragma("unroll") for (int r = 0; r < 16; ++r) { s0[r] = __builtin_amdgcn_exp2f(__builtin_fmaf(s0[r], D.scale, -m)); s1[r] = __builtin_amdgcn_exp2f(__builtin_fmaf(s1[r], D.scale, -m)); ps += s0[r] + s1[r]; } } \
            lsum += ps; \
            bf16x8 pf[2][2]; \
            _Pragma("unroll") for (int s = 0; s < 2; ++s) { v4u p0, p1; \
                p0.x = cvtpk(s0[8 * s + 0], s0[8 * s + 1]); p0.y = cvtpk(s0[8 * s + 2], s0[8 * s + 3]); p0.z = cvtpk(s0[8 * s + 4], s0[8 * s + 5]); p0.w = cvtpk(s0[8 * s + 6], s0[8 * s + 7]); \
                p1.x = cvtpk(s1[8 * s + 0], s1[8 * s + 1]); p1.y = cvtpk(s1[8 * s + 2], s1[8 * s + 3]); p1.z = cvtpk(s1[8 * s + 4], s1[8 * s + 5]); p1.w = cvtpk(s1[8 * s + 6], s1[8 * s + 7]); \
                pf[0][s] = __builtin_bit_cast(bf16x8, p0); pf[1][s] = __builtin_bit_cast(bf16x8, p1); } \
            _Pragma("unroll") for (int kt = 0; kt < 2; ++kt) \
                _Pragma("unroll") for (int s = 0; s < 2; ++s) { \
                    const LAS unsigned char* vb0 = bb_ + vtr_off + (32 * kt + 16 * s) * ATT_VROWB; \
                    const v2u l0 = lds_tr(vb0), h0 = lds_tr(vb0 + 8 * ATT_VROWB), l1 = lds_tr(vb0 + 64), h1 = lds_tr(vb0 + 8 * ATT_VROWB + 64); \
                    const v4u a0 = {l0.x, l0.y, h0.x, h0.y}, a1 = {l1.x, l1.y, h1.x, h1.y}; \
                    o0 = __builtin_amdgcn_mfma_f32_32x32x16_bf16(__builtin_bit_cast(bf16x8, a0), pf[kt][s], o0, 0, 0, 0); \
                    o1 = __builtin_amdgcn_mfma_f32_32x32x16_bf16(__builtin_bit_cast(bf16x8, a1), pf[kt][s], o1, 0, 0, 0); } \
        } } while (0)
    ATT_LOAD(0, kA, vA, rA); ATT_LOAD(1, kB, vB, rB);
    ATT_PUT(0, kA, vA, rA);
    __syncthreads();
    ATT_LOAD(2, kA, vA, rA);
    for (int t = 0; t < D.nt; t += 2) {
        ATT_TILE(t, 0);
        if (t + 1 < D.nt) ATT_PUT(1, kB, vB, rB);
        __syncthreads();
        ATT_LOAD(t + 3, kB, vB, rB);
        if (t + 1 < D.nt) {
            ATT_TILE(t + 1, 1);
            if (t + 2 < D.nt) ATT_PUT(0, kA, vA, rA);
        }
        __syncthreads();
        ATT_LOAD(t + 4, kA, vA, rA);
    }
#undef ATT_LOAD
#undef ATT_PUT
#undef ATT_TILE
    lsum += __shfl_xor(lsum, 32);
    const float rl = 1.0f / lsum;
    bf16* orow = D.O + (size_t)qrow * 1024 + 4 * hh;
#pragma unroll
    for (int g = 0; g < 4; ++g) {
        v2u w0, w1; w0.x = cvtpk(o0[4 * g] * rl, o0[4 * g + 1] * rl); w0.y = cvtpk(o0[4 * g + 2] * rl, o0[4 * g + 3] * rl);
        w1.x = cvtpk(o1[4 * g] * rl, o1[4 * g + 1] * rl); w1.y = cvtpk(o1[4 * g + 2] * rl, o1[4 * g + 3] * rl);
        *(v2u*)(orow + 8 * g) = w0; *(v2u*)(orow + 32 + 8 * g) = w1;
    }
}
__device__ __forceinline__ void att_task(Frame& F, int ly, int mixer, bool lat, int b, int h, int qb) {
    const bf16* Z = (const bf16*)(F.ws + WS_Z);
    AttDesc D;
    D.qrow0 = lat ? M_CTX + b * 1024 + qb * 256 : b * 256; D.qpos0 = qb * 256; D.rlo = 0; D.nab = nullptr;
    D.R0 = nullptr; D.R1 = nullptr; D.rs0 = 0; D.rs1 = 0;
    if (mixer == 0) {
        D.Q = (const bf16*)(F.ws + WS_QA) + h * 64; D.qs = 256;
        D.K0 = D.K1 = (const bf16*)(F.ws + WS_KA) + (h >> 1) * 64; D.V0 = D.V1 = (const bf16*)(F.ws + WS_VA) + (h >> 1) * 64; D.ks0 = D.ks1 = D.vs0 = D.vs1 = 128;
        D.row00 = lat ? M_CTX + b * 1536 : b * 256; D.row01 = 0; D.nt0 = D.nt = lat ? 24 : 4;
        D.O = (bf16*)(F.ws + WS_O) + h * 64; D.scale = 0.125f * LOG2E;
        attn_block<64, false, false>(F, D);
    } else if (mixer == 1) {
        D.Q = Z + Z_BQ + h * 64; D.qs = ZP; D.O = (bf16*)(F.ws + WS_O) + 256 + h * 64; D.scale = 0.125f * LOG2E;
        D.K1 = Z + Z_BK + h * 64; D.V1 = Z + Z_BV + h * 64; D.ks1 = D.vs1 = ZP;
        if (!lat) { D.K0 = D.K1; D.V0 = D.V1; D.ks0 = D.vs0 = ZP; D.row00 = b * 256; D.row01 = 0; D.nt0 = D.nt = 4; attn_block<64, false, false>(F, D); }
        else {
            D.K0 = (const bf16*)(F.ws + WS_NKB) + h * 64; D.V0 = (const bf16*)(F.ws + WS_NVB) + h * 64; D.ks0 = D.vs0 = 256; D.row00 = b * 512; D.nt0 = 8;
            const int r_first = qb * 4, rlo = min(max(r_first - 4, 0), 8), rhi = min(max(r_first + 3 - 4, 0), 8) + 7;
            D.rlo = rlo; D.row01 = M_CTX + b * 1024 + rlo * 64; D.nt = 8 + (rhi - rlo + 1);
            D.nab = F.in[I_NAB] + (size_t)((ly * 4 + h) * 15) * 31;
            attn_block<64, true, false>(F, D);
        }
    } else {
        D.Q = (const bf16*)(F.ws + WS_QM) + h * 96; D.qs = 512; D.O = (bf16*)(F.ws + WS_O) + 768 + h * 64; D.scale = MLA_SCALE * LOG2E;
        D.K0 = D.K1 = (const bf16*)(F.ws + WS_KV) + h * 128; D.V0 = D.V1 = (const bf16*)(F.ws + WS_KV) + h * 128 + 64; D.R0 = D.R1 = (const bf16*)(F.ws + WS_KR);
        D.ks0 = D.ks1 = D.vs0 = D.vs1 = 512; D.rs0 = D.rs1 = 32;
        if (lat) { D.row00 = MTOK + b * 512; D.nt0 = 8; D.row01 = M_CTX + b * 1024; D.nt = 24; attn_block<96, false, true>(F, D); }
        else { D.row00 = b * 256; D.row01 = 0; D.nt0 = D.nt = 4; attn_block<96, false, false>(F, D); }
    }
}

constexpr int DN_KROW = 72, DN_AROW = 68;
constexpr int DNG_K = 0, DNG_Q = 9216, DNG_V = 18432, DNG_A = 27648, DNG_G = 27648 + 64 * DN_AROW * 4, DNG_BYTES = DNG_G + 1024;
static_assert(2 * DNG_BYTES <= RING_BYTES, "DeltaNet phase A LDS");
__device__ __forceinline__ int crow16(int r, int hh) { return (r & 3) + 8 * (r >> 2) + 4 * hh; }
__device__ __forceinline__ void dn_phase_a(Frame& F, int l) {
    const int tid = F.tid, lane = F.lane, lq = lane & 31, hh = lane >> 5, grp = tid >> 8, gt = tid & 255, gw = F.wave & 3;
    LAS unsigned char* gl = F.lds + grp * DNG_BYTES;
    LAS float* gsm = (LAS float*)(gl + DNG_G);
    const bf16* DQ = (const bf16*)(F.ws + WS_DQ); const bf16* DK = (const bf16*)(F.ws + WS_DK); const bf16* DV = (const bf16*)(F.ws + WS_DV); const float* BG = (const float*)(F.ws + WS_BG);
    for (int tp = F.bid; tp < 768; tp += F.G) {
        const int ta = 2 * tp + grp; const bool lat = ta < 1024;
        const int seq = lat ? ta >> 4 : 64 + ((ta - 1024) >> 2), n = lat ? ta & 15 : (ta - 1024) & 3, s2 = lat ? seq : seq - 64;
        const int b = s2 >> 3, h = (s2 >> 1) & 3, dir = s2 & 1, L = lat ? 1024 : 256, row0 = lat ? M_CTX + b * 1024 : b * 256;
        __syncthreads();
#pragma unroll
        for (int i = 0; i < 2; ++i) { const int idx = gt + 256 * i, c = idx >> 3, ch = idx & 7; const int step = 64 * n + c, t = dir ? L - 1 - step : step;
            const size_t src = (size_t)(row0 + t) * 256 + h * 64 + ch * 8;
            *(LAS v4u*)(gl + DNG_Q + c * (DN_KROW * 2) + ch * 16) = *(const v4u*)(DQ + src);
            *(LAS v4u*)(gl + DNG_K + c * (DN_KROW * 2) + ch * 16) = *(const v4u*)(DK + src);
            *(LAS v4u*)(gl + DNG_V + c * (DN_KROW * 2) + ch * 16) = *(const v4u*)(DV + src); }
        if (gw == 0) {
            const int step = 64 * n + lane, t = dir ? L - 1 - step : step; const size_t r = (size_t)(row0 + t) * 16;
            float val = BG[r + 8 + dir * 4 + h];
#pragma unroll
            for (int o = 1; o < 64; o <<= 1) { const float tt = __shfl_up(val, o); if (lane >= o) val += tt; }
            gsm[lane] = val; gsm[64 + lane] = BG[r + dir * 4 + h]; gsm[128 + lane] = __expf(val);
            ((float*)(F.ws + WS_GC))[(size_t)ta * 64 + lane] = val;
        }
        __syncthreads();
        {
            const int mat = gw >> 1, ti = gw & 1;
            const LAS unsigned char* xs = gl + (mat ? DNG_Q : DNG_K);
            const float gj0 = gsm[lq], gj1 = gsm[32 + lq];
#pragma unroll
            for (int tj = 0; tj < 2; ++tj) {
                f32x16 acc;
#pragma unroll
                for (int r = 0; r < 16; ++r) acc[r] = 0.f;
#pragma unroll
                for (int s = 0; s < 4; ++s) {
                    const bf16x8 av = *(const LAS bf16x8*)(xs + (32 * ti + lq) * (DN_KROW * 2) + 32 * s + 16 * hh);
                    const bf16x8 bv = *(const LAS bf16x8*)(gl + DNG_K + (32 * tj + lq) * (DN_KROW * 2) + 32 * s + 16 * hh);
                    acc = __builtin_amdgcn_mfma_f32_32x32x16_bf16(av, bv, acc, 0, 0, 0);
                }
                const int j = 32 * tj + lq; const float gj = tj ? gj1 : gj0;
                if (mat == 0) {
#pragma unroll
                    for (int r = 0; r < 16; ++r) { const int i = 32 * ti + crow16(r, hh); const float v = (j < i) ? gsm[64 + i] * acc[r] * __expf(gsm[i] - gj) : 0.f;
                        ((LAS float*)(gl + DNG_A))[i * DN_AROW + j] = v; }
                } else {
                    bf16* qkg = (bf16*)(F.ws + WS_QKG) + (size_t)ta * 4096;
#pragma unroll
                    for (int r = 0; r < 16; ++r) { const int i = 32 * ti + crow16(r, hh); const float v = (j <= i) ? acc[r] * __expf(gsm[i] - gj) : 0.f;
                        qkg[i * 64 + j] = (bf16)f2bf(v); }
                }
            }
        }
        __syncthreads();
        if (gw < 2) {
            const int cc = gt & 63; const bool isw = gt >= 64;
            const LAS bf16* src = (const LAS bf16*)(gl + (isw ? DNG_K : DNG_V)) + cc;
            const LAS float* As = (const LAS float*)(gl + DNG_A);
            float x[64];
#pragma unroll
            for (int g = 0; g < 16; ++g) {
                const int i0 = 4 * g;
                float p00, p01, p10, p11, p20, p21, p30, p31;
                { float r0 = bf2f(src[(i0 + 0) * DN_KROW]) * gsm[64 + i0 + 0], r1 = bf2f(src[(i0 + 1) * DN_KROW]) * gsm[64 + i0 + 1], r2 = bf2f(src[(i0 + 2) * DN_KROW]) * gsm[64 + i0 + 2], r3 = bf2f(src[(i0 + 3) * DN_KROW]) * gsm[64 + i0 + 3];
                  if (isw) { r0 *= gsm[128 + i0 + 0]; r1 *= gsm[128 + i0 + 1]; r2 *= gsm[128 + i0 + 2]; r3 *= gsm[128 + i0 + 3]; }
                  p00 = r0; p10 = r1; p20 = r2; p30 = r3; p01 = 0.f; p11 = 0.f; p21 = 0.f; p31 = 0.f; }
#pragma unroll
                for (int c = 0; c < (g + 3) / 4; ++c) {
#pragma unroll
                    for (int jq = 4 * c; jq < 4 * c + 4; ++jq) if (jq < g) {
                        const f32x4 a0 = *(const LAS f32x4*)(As + (i0 + 0) * DN_AROW + 4 * jq), a1 = *(const LAS f32x4*)(As + (i0 + 1) * DN_AROW + 4 * jq),
                                    a2 = *(const LAS f32x4*)(As + (i0 + 2) * DN_AROW + 4 * jq), a3 = *(const LAS f32x4*)(As + (i0 + 3) * DN_AROW + 4 * jq);
                        const float x0 = x[4 * jq], x1 = x[4 * jq + 1], x2 = x[4 * jq + 2], x3 = x[4 * jq + 3];
                        if (jq & 1) { p01 -= a0.x * x0; p01 -= a0.y * x1; p01 -= a0.z * x2; p01 -= a0.w * x3; p11 -= a1.x * x0; p11 -= a1.y * x1; p11 -= a1.z * x2; p11 -= a1.w * x3;
                                      p21 -= a2.x * x0; p21 -= a2.y * x1; p21 -= a2.z * x2; p21 -= a2.w * x3; p31 -= a3.x * x0; p31 -= a3.y * x1; p31 -= a3.z * x2; p31 -= a3.w * x3; }
                        else        { p00 -= a0.x * x0; p00 -= a0.y * x1; p00 -= a0.z * x2; p00 -= a0.w * x3; p10 -= a1.x * x0; p10 -= a1.y * x1; p10 -= a1.z * x2; p10 -= a1.w * x3;
                                      p20 -= a2.x * x0; p20 -= a2.y * x1; p20 -= a2.z * x2; p20 -= a2.w * x3; p30 -= a3.x * x0; p30 -= a3.y * x1; p30 -= a3.z * x2; p30 -= a3.w * x3; }
                    }
                    asm volatile("" : "+v"(p00), "+v"(p01), "+v"(p10), "+v"(p11), "+v"(p20), "+v"(p21), "+v"(p30), "+v"(p31) :: "memory");
                }
                const f32x4 d1 = *(const LAS f32x4*)(As + (i0 + 1) * DN_AROW + i0), d2 = *(const LAS f32x4*)(As + (i0 + 2) * DN_AROW + i0), d3 = *(const LAS f32x4*)(As + (i0 + 3) * DN_AROW + i0);
                const float y0 = p00 + p01;
                const float y1 = (p10 + p11) - d1.x * y0;
                const float y2 = (p20 + p21) - d2.x * y0 - d2.y * y1;
                const float y3 = (p30 + p31) - d3.x * y0 - d3.y * y1 - d3.z * y2;
                x[i0] = y0; x[i0 + 1] = y1; x[i0 + 2] = y2; x[i0 + 3] = y3;
                asm volatile("" : "+v"(x[i0]), "+v"(x[i0 + 1]), "+v"(x[i0 + 2]), "+v"(x[i0 + 3]) :: "memory");
            }
            if (!isw) {
                v4u* dst = (v4u*)((bf16*)(F.ws + WS_UT) + (size_t)ta * 4096 + cc * 64);
#pragma unroll
                for (int q8 = 0; q8 < 8; ++q8) { v4u w; w.x = pk2(x[8 * q8], x[8 * q8 + 1]); w.y = pk2(x[8 * q8 + 2], x[8 * q8 + 3]); w.z = pk2(x[8 * q8 + 4], x[8 * q8 + 5]); w.w = pk2(x[8 * q8 + 6], x[8 * q8 + 7]); dst[q8] = w; }
            } else {
                bf16* dst = (bf16*)(F.ws + WS_WN) + (size_t)ta * 4096 + cc;
#pragma unroll
                for (int i = 0; i < 64; ++i) dst[i * 64] = (bf16)f2bf(-x[i]);
            }
        } else if (dir == 0) {
            const int u = gt - 128, dk = u & 63, half = u >> 6;
            const int slot = lat ? (seq >> 1) * 16 + n : 512 + ((seq - 64) >> 1) * 4 + n;
            v4u* dst = (v4u*)((bf16*)(F.ws + WS_KT) + (size_t)slot * 4096 + dk * 64 + 32 * half);
            const LAS bf16* ks = (const LAS bf16*)(gl + DNG_K) + (32 * half) * DN_KROW + dk;
#pragma unroll
            for (int q8 = 0; q8 < 4; ++q8) { v4u w;
                w.x = (unsigned)ks[(8 * q8 + 0) * DN_KROW] | ((unsigned)ks[(8 * q8 + 1) * DN_KROW] << 16); w.y = (unsigned)ks[(8 * q8 + 2) * DN_KROW] | ((unsigned)ks[(8 * q8 + 3) * DN_KROW] << 16);
                w.z = (unsigned)ks[(8 * q8 + 4) * DN_KROW] | ((unsigned)ks[(8 * q8 + 5) * DN_KROW] << 16); w.w = (unsigned)ks[(8 * q8 + 6) * DN_KROW] | ((unsigned)ks[(8 * q8 + 7) * DN_KROW] << 16);
                dst[q8] = w; }
        }
    }
    __syncthreads();
}
__device__ __forceinline__ bf16x8 pack8(const f32x16& x, int s) {
    v4u p; p.x = cvtpk(x[8 * s + 0], x[8 * s + 1]); p.y = cvtpk(x[8 * s + 2], x[8 * s + 3]); p.z = cvtpk(x[8 * s + 4], x[8 * s + 5]); p.w = cvtpk(x[8 * s + 6], x[8 * s + 7]);
    return __builtin_bit_cast(bf16x8, p);
}
constexpr int SC_ROWB = 136, SC_TILE = 64 * SC_ROWB, SC_STAGE = 5 * SC_TILE, SC_GC = MISC_OFF + 192;
static_assert(3 * SC_STAGE <= RING_BYTES && SC_GC + 768 <= LDS_BYTES, "scan LDS");
__device__ __forceinline__ bf16x8 lds_frag(const LAS unsigned char* p) {
    const v2u lo = *(const LAS v2u*)p, hi = *(const LAS v2u*)(p + 16); const v4u a = {lo.x, lo.y, hi.x, hi.y}; return __builtin_bit_cast(bf16x8, a);
}
__device__ __forceinline__ unsigned rot16(unsigned x) { return (x >> 16) | (x << 16); }
struct ScanSeq { int b, h, dir, L, row0, nch, seq; bool lat; };
__device__ __forceinline__ void scan_ld_init(Frame& F, const ScanSeq& Q, int lt, const bf16* (&p)[7], int (&stride)[7], int (&dst)[7], const float*& gcp) {
    const int ta0 = Q.lat ? Q.seq * 16 : 1024 + (Q.seq - 64) * 4;
    const int ks0 = (Q.lat ? (Q.seq >> 1) * 16 : 512 + ((Q.seq - 64) >> 1) * 4) + (Q.dir ? Q.nch - 1 : 0);
#pragma unroll
    for (int i = 0; i < 7; ++i) {
        const int it = lt + 384 * i, tile = (it >> 9) > 4 ? 4 : (it >> 9), row = (it >> 3) & 63, ch = it & 7;
        const bf16* src; int st;
        if (tile == 0) { src = (const bf16*)(F.ws + WS_WN) + (size_t)ta0 * 4096 + row * 64 + ch * 8; st = 4096; }
        else if (tile == 1) { const int t = Q.dir ? Q.L - 1 - row : row; src = (const bf16*)(F.ws + WS_DQ) + Q.h * 64 + (size_t)(Q.row0 + t) * 256 + ch * 8; st = Q.dir ? -64 * 256 : 64 * 256; }
        else if (tile == 2) { src = (const bf16*)(F.ws + WS_QKG) + (size_t)ta0 * 4096 + row * 64 + ch * 8; st = 4096; }
        else if (tile == 3) { src = (const bf16*)(F.ws + WS_KT) + (size_t)ks0 * 4096 + row * 64 + (Q.dir ? 7 - ch : ch) * 8; st = Q.dir ? -4096 : 4096; }
        else { src = (const bf16*)(F.ws + WS_UT) + (size_t)ta0 * 4096 + row * 64 + ch * 8; st = 4096; }
        p[i] = src; stride[i] = st; dst[i] = tile * SC_TILE + row * SC_ROWB + ch * 16 + ((tile == 3 && Q.dir) ? (1 << 30) : 0);
    }
    gcp = (const float*)(F.ws + WS_GC) + (size_t)ta0 * 64 + (lt & 63);
}
__device__ __forceinline__ void scan_fetch(int lt, const bf16* (&p)[7], const int (&stride)[7], const int (&dst)[7], const float*& gcp, v4u (&r)[7], float& gcv) {
#pragma unroll
    for (int i = 0; i < 7; ++i) {
        if (i < 6 || lt < 256) {
            v4u w = *(const v4u*)p[i];
            if (dst[i] >> 30) w = (v4u){rot16(w.w), rot16(w.z), rot16(w.y), rot16(w.x)};
            r[i] = w; p[i] += stride[i];
        }
    }
    if (lt < 64) { gcv = *gcp; gcp += 64; }
}
__device__ __forceinline__ void scan_put(Frame& F, int stage, int lt, const int (&dst)[7], const v4u (&r)[7], float gcv) {
    LAS unsigned char* st = F.lds + stage * SC_STAGE;
#pragma unroll
    for (int i = 0; i < 7; ++i) { if (i < 6 || lt < 256) *(LAS v4u*)(st + (dst[i] & 0xfffffff)) = r[i]; }
    if (lt < 64) ((LAS float*)(F.lds + SC_GC))[stage * 64 + lt] = gcv;
}
__device__ __forceinline__ void scan_chunk(Frame& F, const ScanSeq& Q, int n, int stage, int ds, f32x16& S0, f32x16& S1, bf16* ODN) {
    const int lane = F.lane, lq = lane & 31, hh = lane >> 5;
    const LAS unsigned char* st = F.lds + stage * SC_STAGE;
    const LAS float* gc = (const LAS float*)(F.lds + SC_GC) + stage * 64;
    const LAS unsigned char* r0p = st + lq * SC_ROWB + 8 * hh;
    const float gl = gc[63];
    bf16x8 sb[4]; sb[0] = pack8(S0, 0); sb[1] = pack8(S0, 1); sb[2] = pack8(S1, 0); sb[3] = pack8(S1, 1);
    f32x16 vn0, vn1;
    { const LAS unsigned char* up = st + 4 * SC_TILE + (32 * ds + lq) * SC_ROWB + 8 * hh;
#pragma unroll
      for (int g = 0; g < 4; ++g) { const v2u a = *(const LAS v2u*)(up + 16 * g), c2 = *(const LAS v2u*)(up + 64 + 16 * g);
        vn0[4 * g] = bflo(a.x); vn0[4 * g + 1] = bfhi(a.x); vn0[4 * g + 2] = bflo(a.y); vn0[4 * g + 3] = bfhi(a.y);
        vn1[4 * g] = bflo(c2.x); vn1[4 * g + 1] = bfhi(c2.x); vn1[4 * g + 2] = bflo(c2.y); vn1[4 * g + 3] = bfhi(c2.y); } }
    f32x16 o0, o1;
#pragma unroll
    for (int r = 0; r < 16; ++r) { o0[r] = 0.f; o1[r] = 0.f; }
#pragma unroll
    for (int s = 0; s < 4; ++s) {
        vn0 = __builtin_amdgcn_mfma_f32_32x32x16_bf16(lds_frag(r0p + 32 * s), sb[s], vn0, 0, 0, 0);
        vn1 = __builtin_amdgcn_mfma_f32_32x32x16_bf16(lds_frag(r0p + 32 * SC_ROWB + 32 * s), sb[s], vn1, 0, 0, 0);
        o0 = __builtin_amdgcn_mfma_f32_32x32x16_bf16(lds_frag(r0p + SC_TILE + 32 * s), sb[s], o0, 0, 0, 0);
        o1 = __builtin_amdgcn_mfma_f32_32x32x16_bf16(lds_frag(r0p + SC_TILE + 32 * SC_ROWB + 32 * s), sb[s], o1, 0, 0, 0);
    }
    asm volatile("" : "+v"(vn0), "+v"(vn1), "+v"(o0), "+v"(o1) :: "memory");
#pragma unroll
    for (int g = 0; g < 4; ++g) { const f32x4 a = *(const LAS f32x4*)(gc + 8 * g + 4 * hh), c2 = *(const LAS f32x4*)(gc + 32 + 8 * g + 4 * hh);
        o0[4 * g] *= __expf(a.x); o0[4 * g + 1] *= __expf(a.y); o0[4 * g + 2] *= __expf(a.z); o0[4 * g + 3] *= __expf(a.w);
        o1[4 * g] *= __expf(c2.x); o1[4 * g + 1] *= __expf(c2.y); o1[4 * g + 2] *= __expf(c2.z); o1[4 * g + 3] *= __expf(c2.w); }
    {
        bf16x8 vb[4]; vb[0] = pack8(vn0, 0); vb[1] = pack8(vn0, 1); vb[2] = pack8(vn1, 0); vb[3] = pack8(vn1, 1);
#pragma unroll
        for (int s = 0; s < 4; ++s) {
            o0 = __builtin_amdgcn_mfma_f32_32x32x16_bf16(lds_frag(r0p + 2 * SC_TILE + 32 * s), vb[s], o0, 0, 0, 0);
            o1 = __builtin_amdgcn_mfma_f32_32x32x16_bf16(lds_frag(r0p + 2 * SC_TILE + 32 * SC_ROWB + 32 * s), vb[s], o1, 0, 0, 0);
        }
    }
    asm volatile("" : "+v"(o0), "+v"(o1) :: "memory");
    {
        const ptrdiff_t rs = Q.dir ? -256 : 256;
        bf16* op = ODN + (ptrdiff_t)(Q.row0 + (Q.dir ? Q.L - 1 - 64 * n : 64 * n)) * 256 + rs * (4 * hh);
#pragma unroll
        for (int r = 0; r < 16; ++r) { op[0] = (bf16)f2bf(o0[r]); op[rs * 32] = (bf16)f2bf(o1[r]); op += ((r & 3) == 3) ? rs * 5 : rs; asm volatile("" : "+v"(op)); }
    }
#pragma unroll
    for (int g = 0; g < 4; ++g) { const f32x4 a = *(const LAS f32x4*)(gc + 8 * g + 4 * hh), c2 = *(const LAS f32x4*)(gc + 32 + 8 * g + 4 * hh);
        vn0[4 * g] *= __expf(gl - a.x); vn0[4 * g + 1] *= __expf(gl - a.y); vn0[4 * g + 2] *= __expf(gl - a.z); vn0[4 * g + 3] *= __expf(gl - a.w);
        vn1[4 * g] *= __expf(gl - c2.x); vn1[4 * g + 1] *= __expf(gl - c2.y); vn1[4 * g + 2] *= __expf(gl - c2.z); vn1[4 * g + 3] *= __expf(gl - c2.w); }
    {
        bf16x8 vb[4]; vb[0] = pack8(vn0, 0); vb[1] = pack8(vn0, 1); vb[2] = pack8(vn1, 0); vb[3] = pack8(vn1, 1);
        const float egl = __expf(gl);
#pragma unroll
        for (int r = 0; r < 16; ++r) { S0[r] *= egl; S1[r] *= egl; }
#pragma unroll
        for (int s = 0; s < 4; ++s) {
            S0 = __builtin_amdgcn_mfma_f32_32x32x16_bf16(lds_frag(r0p + 3 * SC_TILE + 32 * s), vb[s], S0, 0, 0, 0);
            S1 = __builtin_amdgcn_mfma_f32_32x32x16_bf16(lds_frag(r0p + 3 * SC_TILE + 32 * SC_ROWB + 32 * s), vb[s], S1, 0, 0, 0);
        }
    }
}
__device__ __forceinline__ void dn_scan_task(Frame& F, int l, int seq) {
    ScanSeq Q; Q.seq = seq; Q.lat = seq < 64; const int s2 = Q.lat ? seq : seq - 64;
    Q.b = s2 >> 3; Q.h = (s2 >> 1) & 3; Q.dir = s2 & 1; Q.L = Q.lat ? 1024 : 256; Q.row0 = Q.lat ? M_CTX + Q.b * 1024 : Q.b * 256; Q.nch = Q.L >> 6;
    const int lane = F.lane, lq = lane & 31, hh = lane >> 5, w = F.wave, lt = F.tid - 128;
    const bool loader = w >= 2;
    const int dv = 32 * (w & 1) + lq;
    bf16* ODN = (bf16*)(F.ws + WS_ODN) + (size_t)Q.dir * MTOK * 256 + Q.h * 64 + dv;
    __syncthreads();
    if (loader) {
        v4u ra[7], rb[7]; float ga = 0.f, gb = 0.f;
        const bf16* lp[7]; int lstride[7], ldst[7]; const float* gcp;
        scan_ld_init(F, Q, lt, lp, lstride, ldst, gcp);
#pragma unroll
        for (int i = 0; i < 7; ++i) { ra[i] = (v4u){0u, 0u, 0u, 0u}; rb[i] = (v4u){0u, 0u, 0u, 0u}; }
        scan_fetch(lt, lp, lstride, ldst, gcp, ra, ga); scan_fetch(lt, lp, lstride, ldst, gcp, rb, gb);
        scan_put(F, 0, lt, ldst, ra, ga); scan_put(F, 1, lt, ldst, rb, gb);
        scan_fetch(lt, lp, lstride, ldst, gcp, ra, ga); scan_fetch(lt, lp, lstride, ldst, gcp, rb, gb);
        __syncthreads();
        for (int n = 0; n < Q.nch; n += 2) {
            if (n + 2 < Q.nch) scan_put(F, (n + 2) % 3, lt, ldst, ra, ga);
            if (n + 4 < Q.nch) scan_fetch(lt, lp, lstride, ldst, gcp, ra, ga);
            __syncthreads();
            if (n + 3 < Q.nch) scan_put(F, (n + 3) % 3, lt, ldst, rb, gb);
            if (n + 5 < Q.nch) scan_fetch(lt, lp, lstride, ldst, gcp, rb, gb);
            __syncthreads();
        }
    } else {
        f32x16 S0, S1;
#pragma unroll
        for (int r = 0; r < 16; ++r) { S0[r] = 0.f; S1[r] = 0.f; }
        if (Q.lat) {
            const float* s0p = F.in[I_SDN] + ((size_t)(((Q.b * 2 + l) * 2 + Q.dir) * 4 + Q.h) * 64) * 64 + dv + 4 * hh * 64;
#pragma unroll
            for (int r = 0; r < 16; ++r) { S0[r] = s0p[0]; S1[r] = s0p[32 * 64]; s0p += ((r & 3) == 3) ? 5 * 64 : 64; asm volatile("" : "+v"(s0p)); }
        }
        __syncthreads();
        for (int n = 0; n < Q.nch; n += 2) {
            scan_chunk(F, Q, n, n % 3, w, S0, S1, ODN);
            __syncthreads();
            scan_chunk(F, Q, n + 1, (n + 1) % 3, w, S0, S1, ODN);
            __syncthreads();
        }
        if (!Q.lat) {
            float* dst = F.out + O_DS + ((size_t)(((Q.b * 2 + l) * 2 + Q.dir) * 4 + Q.h) * 64) * 64 + dv + 4 * hh * 64;
#pragma unroll
            for (int r = 0; r < 16; ++r) { dst[0] = S0[r]; dst[32 * 64] = S1[r]; dst += ((r & 3) == 3) ? 5 * 64 : 64; asm volatile("" : "+v"(dst)); }
        }
    }
}

__device__ __forceinline__ void mixer_phase(Frame& F, int l) {
    for (int task = F.bid; task < 768; task += F.G) if (task >= 384 && task < 576) dn_scan_task(F, l, task - 384);
    for (int task = F.bid; task < 768; task += F.G) {
        if (task >= 384 && task < 576) continue;
        int mixer, b, h, qb = 0; bool lat = true;
        if (task < 128) { mixer = 2; b = task >> 4; h = (task >> 2) & 3; qb = task & 3; }
        else if (task < 256) { const int t = task - 128; mixer = 0; b = t >> 4; h = (t >> 2) & 3; qb = t & 3; }
        else if (task < 384) { const int t = task - 256; mixer = 1; b = t >> 4; h = (t >> 2) & 3; qb = t & 3; }
        else { const int t = (task - 576) & 63; mixer = (task - 576) >> 6; lat = false; b = t >> 2; h = t & 3; }
        att_task(F, l, mixer, lat, b, h, qb);
    }
}

__device__ __forceinline__ void dn_combine(Frame& F, int l) {
    const int gw = F.bid * NWAVES + F.wave, NGW = F.G * NWAVES, lane = F.lane;
    const bf16* Z = (const bf16*)(F.ws + WS_Z); bf16* O = (bf16*)(F.ws + WS_O);
    const bf16* O0 = (const bf16*)(F.ws + WS_ODN); const bf16* O1 = O0 + (size_t)MTOK * 256;
    const float g = F.in[I_DNOG][l * 64 + lane];
    for (int m = gw; m < MTOK; m += NGW) {
#pragma unroll
        for (int h = 0; h < 4; ++h) {
            const float v = bf2f(O0[(size_t)m * 256 + h * 64 + lane]) + bf2f(O1[(size_t)m * 256 + h * 64 + lane]);
            const float ss = wave_sum(v * v);
            const float y = v * (1.0f / sqrtf(ss * (1.f / 64.f) + 1e-6f)) * g * silu_f(bf2f(Z[(size_t)m * ZP + Z_CG + h * 64 + lane]));
            O[(size_t)m * 1024 + 512 + h * 64 + lane] = (bf16)f2bf(y);
        }
    }
}

constexpr int N_PHASES = 2 + 10 * DEPTH;
__global__ void __launch_bounds__(NT, 2) hybrid_fwd(Args args) {
    extern __shared__ __attribute__((aligned(16))) unsigned char lds_raw[];
    Frame F;
    F.lds = (LAS unsigned char*)lds_raw;
    F.tid = threadIdx.x; F.lane = F.tid & 63; F.wave = __builtin_amdgcn_readfirstlane(F.tid >> 6);
    F.G = gridDim.x; F.bid = blockIdx.x;
    F.in = args.in; F.out = args.out; F.ws = args.ws;
    volatile LAS unsigned* MISC = (volatile LAS unsigned*)(F.lds + MISC_OFF);
    for (int u = F.tid; u < (LDS_BYTES - LDSCTL_OFF) / 4; u += NT) ((LAS unsigned*)(F.lds + LDSCTL_OFF))[u] = 0u;
    __syncthreads();
    XcdBarrier bar; bar.bar = (unsigned*)(F.ws + WS_CTL) + CW_BAR; bar.x = 0; bar.st = nullptr;
#if !MK_PER_PHASE
    bar = xcd_barrier_post((unsigned*)(F.ws + WS_CTL) + CW_BAR, MISC + 8);
#endif
    int redo = 0;
    for (int ph = args.ph_lo; ph < args.ph_hi; ++ph) {
        {
            int tid_ = threadIdx.x, bid_ = blockIdx.x; unsigned char* ws_ = args.ws; float* out_ = args.out;
            asm volatile("" : "+v"(tid_)); asm volatile("" : "+s"(bid_)); asm volatile("" : "+s"(ws_)); asm volatile("" : "+s"(out_));
            F.tid = tid_; F.lane = tid_ & 63; F.wave = __builtin_amdgcn_readfirstlane(tid_ >> 6); F.bid = bid_; F.ws = ws_; F.out = out_;
        }
        const float* mods = (const float*)(F.ws + WS_MODS);
        if (ph == 0) { p0a(F); convert_weights(F, 0, 0, CW_ALL, F.bid * NWAVES + F.wave, F.G * NWAVES); }
        else if (ph == 1) norm_rows<0>(F, true, F.in[I_N1G], mods, 0, 1024);
        else {
            const int l = (ph - 2) / 10, sp = (ph - 2) % 10;
            unsigned char* wl = F.ws + WS_W;
            const float* mods_l = mods + (size_t)l * 9 * 6144;
            if (sp == 0) {
                pg8::Gemm g{(const bf16*)(F.ws + WS_XN), (const bf16*)(wl + W_IN), MTOK, ZP, 1024}; pg8::StaticOrder S; S.init(MTOK, ZP, F.G, F.bid);
                pg8::EpiBf16 E{(bf16*)(F.ws + WS_Z), ZP};
                pg8::gemm_phase<pg8::EpiBf16, pg8::StaticOrder, true, true>(F.lds, g, S, E, F.tid);
            } else if (sp == 1) prep_phase(F, l);
            else if (sp == 2) {
                { pg8::Gemm g{(const bf16*)(F.ws + WS_QN), (const bf16*)(wl + W_Q), MTOK, 512, 256}; pg8::StaticOrder S; S.init(MTOK, 512, F.G, F.bid);
                  pg8::EpiBf16 E{(bf16*)(F.ws + WS_QM), 512};
                  pg8::gemm_phase<pg8::EpiBf16, pg8::StaticOrder, true, true>(F.lds, g, S, E, F.tid); }
                { pg8::Gemm g{(const bf16*)(F.ws + WS_CKV), (const bf16*)(wl + W_KV), KVROWS, 512, 256}; pg8::StaticOrder S; S.init(KVROWS, 512, F.G, (F.bid + F.G - 96) % F.G);
                  pg8::EpiBf16 E{(bf16*)(F.ws + WS_KV), 512};
                  pg8::gemm_phase<pg8::EpiBf16, pg8::StaticOrder, true, true>(F.lds, g, S, E, F.tid); }
                dn_phase_a(F, l);
            } else if (sp == 3) mixer_phase(F, l);
            else if (sp == 4) dn_combine(F, l);
            else if (sp == 5) {
                pg8::Gemm g{(const bf16*)(F.ws + WS_O), (const bf16*)(wl + W_OUT), MTOK, 1024, 1024}; pg8::StaticOrder S; S.init(MTOK, 1024, F.G, F.bid);
                pg8::EpiRes E{l == 0 ? F.in[I_XP] : F.out, l == 0 ? F.in[I_XS] : F.out + (size_t)M_CTX * DM, F.out, mods_l + 2 * 1024};
                pg8::gemm_phase<pg8::EpiRes, pg8::StaticOrder, true, true>(F.lds, g, S, E, F.tid);
                if (l + 1 < DEPTH && F.bid >= 192) {
                    const int gw = (F.bid - 192) * NWAVES + F.wave, NGW = (F.G - 192) * NWAVES;
                    convert_weights(F, l + 1, 0, 1408, gw, NGW); convert_weights(F, l + 1, 6144, CW_ALL, gw, NGW); }
            } else if (sp == 6) norm_rows<0>(F, false, F.in[I_N2G] + l * 1024, mods_l, 3 * 1024, 4 * 1024);
            else if (sp == 7) {
                pg8::Gemm g{(const bf16*)(F.ws + WS_XN), (const bf16*)(wl + W_GU), MTOK, NGU, 1024}; pg8::StaticOrder S; S.init(MTOK, NGU, F.G, F.bid);
                pg8::EpiSwiglu E{(bf16*)(F.ws + WS_Z), FF};
                pg8::gemm_phase<pg8::EpiSwiglu, pg8::StaticOrder, true, true>(F.lds, g, S, E, F.tid);
            } else if (sp == 8) {
                pg8::Gemm g{(const bf16*)(F.ws + WS_Z), (const bf16*)(wl + W_D), MTOK, 1024, FF}; pg8::StaticOrder S; S.init(MTOK, 1024, F.G, F.bid);
                pg8::EpiRes E{F.out, F.out + (size_t)M_CTX * DM, F.out, mods_l + 5 * 1024};
                pg8::gemm_phase<pg8::EpiRes, pg8::StaticOrder, true, true>(F.lds, g, S, E, F.tid);
                if (l + 1 < DEPTH && F.bid >= 192) {
                    const int gw = (F.bid - 192) * NWAVES + F.wave, NGW = (F.G - 192) * NWAVES;
                    convert_weights(F, l + 1, 1408, 4736, gw, NGW); }
            } else {
                if (l + 1 < DEPTH) { norm_rows<0>(F, false, F.in[I_N1G] + (l + 1) * 1024, mods_l + 9 * 6144, 0, 1024); convert_weights(F, l + 1, 4736, 6144, F.bid * NWAVES + F.wave, F.G * NWAVES); }
                else norm_rows<1>(F, false, F.in[I_FG], nullptr, 0, 0);
            }
        }
#if !MK_PER_PHASE
        if (ph + 1 < args.ph_hi) xcd_barrier(bar);
#endif
        if (REPEAT_MASK) { const int bit = ph == 0 ? 10 : (ph == 1 ? 11 : (ph - 2) % 10); if ((REPEAT_MASK >> bit) & 1) { if (!redo) { redo = 1; --ph; } else redo = 0; } }
    }
}

extern "C" void kernel_launch(void* const* d_in, const int* in_sizes, int n_in, void* d_out, int out_size, void* d_ws, size_t ws_size, hipStream_t stream) {
    static int grid = 0;
    if (grid == 0) {
        if (n_in != N_IN || out_size != (int)O_END || ws_size < WS_END) { fprintf(stderr, "kernel_launch: unexpected shapes: n_in %d out %d ws %zu\n", n_in, out_size, ws_size); grid = -1; return; }
        int dev = 0, cus = 0, per_cu = 0;
        if (hipGetDevice(&dev) != hipSuccess || hipDeviceGetAttribute(&cus, hipDeviceAttributeMultiprocessorCount, dev) != hipSuccess) { grid = -1; return; }
        if (hipFuncSetAttribute((const void*)hybrid_fwd, hipFuncAttributeMaxDynamicSharedMemorySize, LDS_BYTES) != hipSuccess) { fprintf(stderr, "kernel_launch: hipFuncSetAttribute failed\n"); grid = -1; return; }
        if (hipOccupancyMaxActiveBlocksPerMultiprocessor(&per_cu, (const void*)hybrid_fwd, NT, LDS_BYTES) != hipSuccess || per_cu < 1) { fprintf(stderr, "kernel_launch: occupancy query says %d\n", per_cu); }
        (void)hipGetLastError();
        grid = cus;
    }
    if (grid < 0) return;
    (void)hipMemsetAsync((char*)d_ws + WS_CTL, 0, CTL_ZERO_BYTES, stream);
    Args a{};
    for (int i = 0; i < N_IN; ++i) a.in[i] = (const float*)d_in[i];
    a.out = (float*)d_out; a.ws = (unsigned char*)d_ws;
#if MK_PER_PHASE
    for (int ph = 0; ph < N_PHASES; ++ph) { a.ph_lo = ph; a.ph_hi = ph + 1; hipLaunchKernelGGL(hybrid_fwd, dim3(grid), dim3(NT), LDS_BYTES, stream, a); }
#else
    a.ph_lo = 0; a.ph_hi = N_PHASES;
    void* kargs[] = {&a};
    hipError_t e = hipLaunchCooperativeKernel((const void*)hybrid_fwd, dim3(grid), dim3(NT), kargs, LDS_BYTES, stream);
    if (e != hipSuccess) fprintf(stderr, "kernel_launch: cooperative launch failed: %s (grid %d)\n", hipGetErrorString(e), grid);
#endif
}
```
